# Optimizing an MI355X kernel written in HIP

```python
import math
import jax, jax.numpy as jnp
from jax import lax
import numpy as np

D_MODEL = 1024
BATCH = 2
SEQ = 16384
DEPTH = 2

CTX_LEN = 256
GRID_W = 64
EPS = 1e-6
HEAD_DIM = 64
ATTN_Q_HEADS = 8
ATTN_KV_HEADS = 2
ATTN_GROUP = ATTN_Q_HEADS // ATTN_KV_HEADS
ATTN_Q_DIM = ATTN_Q_HEADS * HEAD_DIM
ATTN_KV_DIM = ATTN_KV_HEADS * HEAD_DIM
WINDOW = 128
BLOCK = 128
ROPE_BASE = 10000.0
GDN_HEADS = 4
GDN_DK = 128
GDN_DV = 128
GDN_QK_DIM = GDN_HEADS * GDN_DK
GDN_V_DIM = GDN_HEADS * GDN_DV
GDN_CONV = 3
CHUNK = 64
HY_SPLITS = (ATTN_Q_DIM, ATTN_KV_DIM, ATTN_KV_DIM, 2 * GDN_QK_DIM + GDN_V_DIM, GDN_V_DIM, 2 * GDN_HEADS, 2 * GDN_HEADS)
HY_IN = sum(HY_SPLITS)
MIX_WIDTH = ATTN_Q_DIM + GDN_V_DIM
SC_CONV = 3
FFN_HIDDEN = -(-8 * D_MODEL // (3 * 256)) * 256

kernel_name = 'hybrid_swa_gdn_shortconv_dit_block'


def rms_norm(x, g):
    xf = x.astype(jnp.float32)
    y = xf * lax.rsqrt(jnp.mean(xf * xf, axis=-1, keepdims=True) + EPS)
    return (y * g.astype(jnp.float32)).astype(x.dtype)


def l2_normalize(x):
    return x * lax.rsqrt(jnp.sum(x * x, axis=-1, keepdims=True) + EPS)


def modulate(h, shift, scale):
    return h * (1 + scale) + shift


def ada_params(cond, w, b):
    return jnp.split(jax.nn.silu(cond) @ w + b, 6, axis=-1)


def centred_depthwise_conv(x, w):
    pad = w.shape[0] // 2
    return lax.conv_general_dilated(x, w[:, None, :].astype(x.dtype), window_strides=(1,), padding=[(pad, pad)],
                                    dimension_numbers=('NWC', 'WIO', 'NWC'), feature_group_count=x.shape[-1])


def axial_rope(length):
    rows = length // GRID_W
    row = jnp.broadcast_to(jnp.arange(rows)[:, None], (rows, GRID_W)).reshape(length).astype(jnp.float32)
    col = jnp.broadcast_to(jnp.arange(GRID_W)[None, :], (rows, GRID_W)).reshape(length).astype(jnp.float32)
    n_freq = HEAD_DIM // 4
    inv_freq = ROPE_BASE ** (-jnp.arange(n_freq, dtype=jnp.float32) / n_freq)
    ang = jnp.concatenate([row[:, None] * inv_freq, col[:, None] * inv_freq], axis=-1)
    return jnp.cos(ang), jnp.sin(ang)


def apply_rope(x, cos, sin):
    half = HEAD_DIM // 2
    xf = x.astype(jnp.float32)
    x1, x2 = xf[..., :half], xf[..., half:]
    cs, sn = cos[None, :, None, :], sin[None, :, None, :]
    return jnp.concatenate([x1 * cs - x2 * sn, x2 * cs + x1 * sn], axis=-1).astype(x.dtype)


def windowed_attention(q, k, v, k_ctx, v_ctx, sink_logit):
    B, L = q.shape[:2]
    n_blocks = L // BLOCK
    span = BLOCK + 2 * WINDOW
    scale = HEAD_DIM ** -0.5
    pad = ((0, 0), (WINDOW, WINDOW), (0, 0), (0, 0))
    kp, vp = jnp.pad(k, pad), jnp.pad(v, pad)
    rel = jnp.arange(span)[None, :] - WINDOW - jnp.arange(BLOCK)[:, None]
    in_band = jnp.abs(rel) <= WINDOW
    s_sink = jnp.broadcast_to(sink_logit[None, :, :, None, None], (B, ATTN_KV_HEADS, ATTN_GROUP, BLOCK, 1))

    def one_block(blk):
        start = blk * BLOCK
        qb = lax.dynamic_slice_in_dim(q, start, BLOCK, axis=1)
        kb = lax.dynamic_slice_in_dim(kp, start, span, axis=1)
        vb = lax.dynamic_slice_in_dim(vp, start, span, axis=1)
        key_pos = start - WINDOW + jnp.arange(span)
        valid = in_band & ((key_pos >= 0) & (key_pos < L))[None, :]
        s_loc = jnp.einsum('bnkgd,bmkd->bkgnm', qb, kb).astype(jnp.float32) * scale
        s_loc = jnp.where(valid, s_loc, -jnp.inf)
        s_ctx = jnp.einsum('bnkgd,bckd->bkgnc', qb, k_ctx).astype(jnp.float32) * scale
        p = jax.nn.softmax(jnp.concatenate([s_loc, s_ctx, s_sink], axis=-1), axis=-1).astype(v.dtype)
        return (jnp.einsum('bkgnm,bmkd->bnkgd', p[..., :span], vb)
                + jnp.einsum('bkgnc,bckd->bnkgd', p[..., span:-1], v_ctx))

    out = lax.map(one_block, jnp.arange(n_blocks))
    return jnp.moveaxis(out, 0, 1).reshape(B, L, ATTN_Q_DIM)


def context_attention(q_ctx, k_ctx, v_ctx, sink_logit):
    B, Lc = q_ctx.shape[:2]
    s = jnp.einsum('bnkgd,bckd->bkgnc', q_ctx, k_ctx).astype(jnp.float32) * HEAD_DIM ** -0.5
    s_sink = jnp.broadcast_to(sink_logit[None, :, :, None, None], s.shape[:-1] + (1,))
    p = jax.nn.softmax(jnp.concatenate([s, s_sink], axis=-1), axis=-1).astype(v_ctx.dtype)
    return jnp.einsum('bkgnc,bckd->bnkgd', p[..., :-1], v_ctx).reshape(B, Lc, ATTN_Q_DIM)


def gated_delta_chunked(q, k, v, g, beta, state0):
    B, H, L, dk = q.shape
    dv = v.shape[-1]
    n = L // CHUNK
    q = q.reshape(B, H, n, CHUNK, dk)
    k = k.reshape(B, H, n, CHUNK, dk)
    v = v.reshape(B, H, n, CHUNK, dv)
    g = jnp.cumsum(g.reshape(B, H, n, CHUNK), axis=-1)
    beta = beta.reshape(B, H, n, CHUNK)
    row = jnp.arange(CHUNK)[:, None]
    col = jnp.arange(CHUNK)[None, :]
    decay = jnp.exp(jnp.where(row >= col, g[..., :, None] - g[..., None, :], -jnp.inf))
    k_beta = k * beta[..., None]
    strict = jnp.where(row > col, jnp.einsum('bhncd,bhnsd->bhncs', k_beta, k) * decay, 0.0)
    eye = jnp.broadcast_to(jnp.eye(CHUNK, dtype=q.dtype), strict.shape)
    t_mat = lax.linalg.triangular_solve(eye + strict, eye, left_side=True, lower=True, unit_diagonal=True)
    u = jnp.einsum('bhncs,bhnse->bhnce', t_mat, v * beta[..., None])
    w = jnp.einsum('bhncs,bhnsd->bhncd', t_mat, k_beta * jnp.exp(g)[..., None])
    qk = jnp.einsum('bhncd,bhnsd->bhncs', q, k) * decay
    q_g = q * jnp.exp(g)[..., None]
    g_last = g[..., -1]
    k_tail = k * jnp.exp(g_last[..., None] - g)[..., None]

    def step(S, xs):
        u_c, w_c, qk_c, qg_c, kt_c, gl_c = xs
        v_new = u_c - jnp.einsum('bhcd,bhde->bhce', w_c, S)
        o_c = jnp.einsum('bhcd,bhde->bhce', qg_c, S) + jnp.einsum('bhcs,bhse->bhce', qk_c, v_new)
        S = S * jnp.exp(gl_c)[..., None, None] + jnp.einsum('bhcd,bhce->bhde', kt_c, v_new)
        return S, o_c

    xs = tuple(jnp.moveaxis(t, 2, 0) for t in (u, w, qk, q_g, k_tail, g_last))
    S, o = lax.scan(step, state0, xs)
    return jnp.moveaxis(o, 0, 2).reshape(B, H, L, dv), S


def gdn_prepare(qkv, a_proj, b_proj, conv_w, a_log, dt_bias):
    B, L, _ = qkv.shape
    qkv = jax.nn.silu(centred_depthwise_conv(qkv, conv_w)).astype(jnp.float32)
    q, k, v = jnp.split(qkv, [GDN_QK_DIM, 2 * GDN_QK_DIM], axis=-1)
    q = l2_normalize(q.reshape(B, L, GDN_HEADS, GDN_DK).transpose(0, 2, 1, 3)) * GDN_DK ** -0.5
    k = l2_normalize(k.reshape(B, L, GDN_HEADS, GDN_DK).transpose(0, 2, 1, 3))
    v = v.reshape(B, L, GDN_HEADS, GDN_DV).transpose(0, 2, 1, 3)
    a = a_proj.astype(jnp.float32).reshape(B, L, 2, GDN_HEADS)
    b = b_proj.astype(jnp.float32).reshape(B, L, 2, GDN_HEADS)
    g = -jnp.exp(a_log.astype(jnp.float32)) * jax.nn.softplus(a + dt_bias.astype(jnp.float32))
    beta = jax.nn.sigmoid(b)
    return q, k, v, g.transpose(2, 0, 3, 1), beta.transpose(2, 0, 3, 1)


def bidirectional_gdn(lat, ctx):
    q, k, v, g, beta = lat
    qc, kc, vc, gc, bc = ctx
    zero = jnp.zeros((q.shape[0], GDN_HEADS, GDN_DK, GDN_DV), jnp.float32)
    rev = lambda t: jnp.flip(t, axis=2)
    oc_f, s_f = gated_delta_chunked(qc, kc, vc, gc[0], bc[0], zero)
    o_f, _ = gated_delta_chunked(q, k, v, g[0], beta[0], s_f)
    oc_b, s_b = gated_delta_chunked(rev(qc), rev(kc), rev(vc), rev(gc[1]), rev(bc[1]), zero)
    o_b, _ = gated_delta_chunked(rev(q), rev(k), rev(v), rev(g[1]), rev(beta[1]), s_b)
    return o_f + rev(o_b), oc_f + rev(oc_b)


def gdn_output(o, z, norm_g):
    B, H, L, dv = o.shape
    o = rms_norm(o.transpose(0, 2, 1, 3), norm_g)
    gate = jax.nn.silu(z.astype(jnp.float32)).reshape(B, L, H, dv)
    return (o * gate).reshape(B, L, H * dv).astype(z.dtype)


def split_hybrid(p):
    idx = np.cumsum(HY_SPLITS)[:-1].tolist()
    return jnp.split(p, idx, axis=-1)


def attn_gdn_mixer(h, hc, w_in, w_out, sink, conv_w, a_log, dt_bias, norm_g, ctx_needed):
    B, L, _ = h.shape
    Lc = hc.shape[1]
    q, k, v, qkv, z, a, b = split_hybrid(h @ w_in)
    qc, kc, vc, qkv_c, z_c, a_c, b_c = split_hybrid(hc @ w_in)
    cos, sin = axial_rope(L)
    q = apply_rope(q.reshape(B, L, ATTN_Q_HEADS, HEAD_DIM), cos, sin).reshape(B, L, ATTN_KV_HEADS, ATTN_GROUP, HEAD_DIM)
    k = apply_rope(k.reshape(B, L, ATTN_KV_HEADS, HEAD_DIM), cos, sin)
    v = v.reshape(B, L, ATTN_KV_HEADS, HEAD_DIM)
    kc = kc.reshape(B, Lc, ATTN_KV_HEADS, HEAD_DIM)
    vc = vc.reshape(B, Lc, ATTN_KV_HEADS, HEAD_DIM)
    sink_logit = sink.reshape(ATTN_KV_HEADS, ATTN_GROUP).astype(jnp.float32)
    attn_out = windowed_attention(q, k, v, kc, vc, sink_logit)
    o, oc = bidirectional_gdn(gdn_prepare(qkv, a, b, conv_w, a_log, dt_bias),
                              gdn_prepare(qkv_c, a_c, b_c, conv_w, a_log, dt_bias))
    y = jnp.concatenate([attn_out, gdn_output(o, z, norm_g)], axis=-1) @ w_out
    if not ctx_needed:
        return y, None
    attn_c = context_attention(qc.reshape(B, Lc, ATTN_KV_HEADS, ATTN_GROUP, HEAD_DIM), kc, vc, sink_logit)
    yc = jnp.concatenate([attn_c, gdn_output(oc, z_c, norm_g)], axis=-1) @ w_out
    return y, yc


def short_conv_mixer(h, w_in, conv_w, w_out):
    b_gate, c_gate, u = jnp.split(h @ w_in, 3, axis=-1)
    return (b_gate * centred_depthwise_conv(c_gate * u, conv_w)) @ w_out


def swiglu(h, w_gate, w_up, w_down):
    return (jax.nn.silu(h @ w_gate) * (h @ w_up)) @ w_down


def setup_inputs(seed: int = 0) -> dict:
    key = jax.random.key(seed)
    ks = jax.random.split(key, 24)
    f32 = jnp.float32
    d = D_MODEL
    n_even = (DEPTH + 1) // 2
    n_odd = DEPTH // 2
    normal = lambda k, shape, s: jax.random.normal(k, shape, f32) * s
    gain = lambda k, shape: 1.0 + 0.02 * jax.random.normal(k, shape, f32)
    dt = jnp.exp(jax.random.uniform(ks[15], (n_even, 2, GDN_HEADS), f32, math.log(1e-3), math.log(1e-1)))
    return {
        'x': normal(ks[0], (BATCH, SEQ, d), 1.0),
        'c': normal(ks[1], (BATCH, d), 1.0),
        'ctx': normal(ks[2], (BATCH, CTX_LEN, d), 1.0),
        'c_ctx': normal(ks[3], (d,), 1.0),
        'ada_w': normal(ks[4], (DEPTH, d, 6 * d), 0.5 * d ** -0.5),
        'ada_b': normal(ks[5], (DEPTH, 6 * d), 0.01),
        'pre_mix_g': gain(ks[6], (DEPTH, d)),
        'post_mix_g': gain(ks[7], (DEPTH, d)),
        'pre_ffn_g': gain(ks[8], (DEPTH, d)),
        'post_ffn_g': gain(ks[9], (DEPTH, d)),
        'hy_w_in': normal(ks[10], (n_even, d, HY_IN), d ** -0.5),
        'hy_w_out': normal(ks[11], (n_even, MIX_WIDTH, d), MIX_WIDTH ** -0.5),
        'attn_sink': normal(ks[12], (n_even, ATTN_Q_HEADS), 1.0),
        'gdn_conv_w': normal(ks[13], (n_even, GDN_CONV, 2 * GDN_QK_DIM + GDN_V_DIM), GDN_CONV ** -0.5),
        'gdn_a_log': jnp.log(jax.random.uniform(ks[14], (n_even, 2, GDN_HEADS), f32, 1.0, 16.0)),
        'gdn_dt_bias': dt + jnp.log(-jnp.expm1(-dt)),
        'gdn_norm_g': gain(ks[16], (n_even, GDN_DV)),
        'sc_w_in': normal(ks[17], (n_odd, d, 3 * d), d ** -0.5),
        'sc_conv_w': normal(ks[18], (n_odd, SC_CONV, d), SC_CONV ** -0.5),
        'sc_w_out': normal(ks[19], (n_odd, d, d), d ** -0.5),
        'ffn_w_gate': normal(ks[20], (DEPTH, d, FFN_HIDDEN), d ** -0.5),
        'ffn_w_up': normal(ks[21], (DEPTH, d, FFN_HIDDEN), d ** -0.5),
        'ffn_w_down': normal(ks[22], (DEPTH, FFN_HIDDEN, d), FFN_HIDDEN ** -0.5),
    }


def reference(x, c, ctx, c_ctx, ada_w, ada_b, pre_mix_g, post_mix_g, pre_ffn_g, post_ffn_g,
              hy_w_in, hy_w_out, attn_sink, gdn_conv_w, gdn_a_log, gdn_dt_bias, gdn_norm_g,
              sc_w_in, sc_conv_w, sc_w_out, ffn_w_gate, ffn_w_up, ffn_w_down):
    for l in range(DEPTH):
        ctx_needed = any(j % 2 == 0 for j in range(l + 1, DEPTH))
        sh1, sc1, g1, sh2, sc2, g2 = ada_params(c, ada_w[l], ada_b[l])
        sh1, sc1, g1, sh2, sc2, g2 = (t[:, None, :] for t in (sh1, sc1, g1, sh2, sc2, g2))
        h = modulate(rms_norm(x, pre_mix_g[l]), sh1, sc1)
        if l % 2 == 0 or ctx_needed:
            csh1, csc1, cg1, csh2, csc2, cg2 = ada_params(c_ctx, ada_w[l], ada_b[l])
            hc = modulate(rms_norm(ctx, pre_mix_g[l]), csh1, csc1)
        if l % 2 == 0:
            e = l // 2
            y, yc = attn_gdn_mixer(h, hc, hy_w_in[e], hy_w_out[e], attn_sink[e], gdn_conv_w[e],
                                   gdn_a_log[e], gdn_dt_bias[e], gdn_norm_g[e], ctx_needed)
        else:
            o = l // 2
            y = short_conv_mixer(h, sc_w_in[o], sc_conv_w[o], sc_w_out[o])
            if ctx_needed:
                yc = short_conv_mixer(hc, sc_w_in[o], sc_conv_w[o], sc_w_out[o])
        x = x + g1 * rms_norm(y, post_mix_g[l])
        f = swiglu(modulate(rms_norm(x, pre_ffn_g[l]), sh2, sc2), ffn_w_gate[l], ffn_w_up[l], ffn_w_down[l])
        x = x + g2 * rms_norm(f, post_ffn_g[l])
        if ctx_needed:
            ctx = ctx + cg1 * rms_norm(yc, post_mix_g[l])
            fc = swiglu(modulate(rms_norm(ctx, pre_ffn_g[l]), csh2, csc2), ffn_w_gate[l], ffn_w_up[l], ffn_w_down[l])
            ctx = ctx + cg2 * rms_norm(fc, post_ffn_g[l])
    return x
```

```cpp
#include <hip/hip_runtime.h>
#include <hip/hip_cooperative_groups.h>
#include <cstdio>
#include <cstdint>
namespace cg = cooperative_groups;

__device__ __forceinline__ int tidx() { int t = (int)threadIdx.x; asm volatile("" : "+v"(t)); return t & 511; }
namespace pg8 {
#define PG8_LAS __attribute__((address_space(3)))
typedef unsigned short bf16_t;
typedef short bf16x8 __attribute__((ext_vector_type(8)));
typedef float f32x4 __attribute__((ext_vector_type(4)));
typedef unsigned u32x4 __attribute__((ext_vector_type(4)));
constexpr int BM = 256, BK = 64, HALF = 128, HTB = HALF * BK * 2  , STAGE_BYTES = 8 * HTB, NXCD = 8, WGM = 8;

__host__ __device__ __forceinline__ int lds_byte(int r, int c) { const int st = (r >> 4) * 2 + (c >> 5), rr = r & 15, cc = c & 31, ob = rr * 64 + cc * 2; return st * 1024 + (ob ^ (((ob >> 9) & 1) << 5)); }
__host__ __device__ __forceinline__ void stage_rc(int b, int& R, int& C) { const int st = b / 1024, sb = b % 1024, swz = sb ^ (((sb >> 9) & 1) << 5); R = (st >> 1) * 16 + swz / 64; C = (st & 1) * 32 + (swz % 64) / 2; }
__host__ __device__ __forceinline__ int perm32(int rho) { const int n = rho >> 4, i = rho & 15; return 8 * (i >> 2) + 4 * n + (i & 3); }

struct Unit { int pm, pn; };
struct Gemm { const bf16_t* A; const bf16_t* Bt; int M, N, K; };

struct StaticOrder {
    int nM, nN, nwg, G, c;
    __host__ __device__ void init(int M, int N, int G_, int c_) { nM = M / BM; nN = N / BM; nwg = nM * nN; G = G_; c = c_; }
    __host__ __device__ bool next(int i, Unit& u) const {
        const long L = (long)i * G + c; if (L >= nwg) return false;
        int wgid = (int)L; { const int q = nwg / NXCD, r = nwg % NXCD, xcd = wgid % NXCD, off = wgid / NXCD; wgid = (xcd < r ? xcd * (q + 1) : r * (q + 1) + (xcd - r) * q) + off; }
        const int nig = WGM * nN, gid = wgid / nig, fm = gid * WGM, gsz = (nM - fm) < WGM ? (nM - fm) : WGM;
        u.pm = fm + ((wgid % nig) % gsz); u.pn = (wgid % nig) / gsz; return true;
    }
    __device__ __forceinline__ void a_ready(const Unit&) const {}
    __device__ __forceinline__ void done(const Unit&) const {}
};

__device__ __forceinline__ unsigned cvt_pk_bf16(float lo, float hi) { unsigned r; asm volatile("v_cvt_pk_bf16_f32 %0, %1, %2" : "=v"(r) : "v"(lo), "v"(hi)); return r; }
template <class Epi, class Sched, bool ALIGN_EPI = false, bool SP2 = false>
__device__ __forceinline__ void gemm_phase(PG8_LAS unsigned char* lds, const Gemm g, const Sched& S, const Epi& E) {
    const int tid = tidx(), wid = __builtin_amdgcn_readfirstlane(tid >> 6), lane = tid & 63, wr = wid >> 2, wc = wid & 3, fr = lane & 15, fq = lane >> 4;
    const int K = g.K, nt = K / BK;
    unsigned voffA[2], voffB[2];
#pragma unroll
    for (int i = 0; i < 2; ++i) { int R, C; stage_rc(tid * 16 + i * 8192, R, C); const int Rb = Epi::PERM ? ((R & ~31) + perm32(R & 31)) : R;
        voffA[i] = (unsigned)(R * K + C) * 2u; voffB[i] = (unsigned)(Rb * K + C) * 2u; }
    const size_t kstep = (size_t)(BK * 2);
    const size_t hstep = (size_t)HALF * K * 2;
    const size_t tstep = 2 * hstep;
    const unsigned ldsw = (unsigned)wid * 1024u;
    const int aoff = lds_byte(wr * 64 + fr, fq * 8), boff = lds_byte(wc * 32 + fr, fq * 8);
#define PG8_SA(b, h) (((b) * 2 + (h)) * HTB)
#define PG8_SB(b, h) ((4 + (b) * 2 + (h)) * HTB)
#define PG8_STAGE(bufoff, gbase, voff) do { _Pragma("unroll") for (int _i = 0; _i < 2; ++_i) \
        __builtin_amdgcn_global_load_lds((const unsigned*)((const char*)(gbase) + (voff)[_i]), (PG8_LAS unsigned*)(lds + (bufoff) + ldsw + _i * 8192), 16, 0, 0); } while (0)
#define PG8_LDA(dst, b, h) do { _Pragma("unroll") for (int m = 0; m < 4; ++m) _Pragma("unroll") for (int k = 0; k < 2; ++k) dst[m][k] = *(const PG8_LAS bf16x8*)(lds + PG8_SA(b, h) + aoff + m * 2048 + k * 1024); } while (0)
#define PG8_LDB(dst, b, h) do { _Pragma("unroll") for (int n = 0; n < 2; ++n) _Pragma("unroll") for (int k = 0; k < 2; ++k) dst[n][k] = *(const PG8_LAS bf16x8*)(lds + PG8_SB(b, h) + boff + n * 2048 + k * 1024); } while (0)
#define PG8_MMA(ai, bj, At, Bt) do { __builtin_amdgcn_s_setprio(1); _Pragma("unroll") for (int m = 0; m < 4; ++m) _Pragma("unroll") for (int n = 0; n < 2; ++n) _Pragma("unroll") for (int k = 0; k < 2; ++k) \
        acc[ai][bj][m][n] = __builtin_amdgcn_mfma_f32_16x16x32_bf16(Bt[n][k], At[m][k], acc[ai][bj][m][n], 0, 0, 0); __builtin_amdgcn_s_setprio(0); } while (0)
#define PG8_WAIT_V(n) asm volatile("s_waitcnt vmcnt(" #n ")" ::: "memory")
#define PG8_WAIT_L(n) asm volatile("s_waitcnt lgkmcnt(" #n ")" ::: "memory")
#define PG8_BAR __builtin_amdgcn_s_barrier()
#define PG8_SCHED __builtin_amdgcn_sched_barrier(0)
    Unit cur, nxt; int ui = 0;
    if (!S.next(0, cur)) return;
    f32x4 acc[2][2][4][2];
#pragma unroll
    for (int a = 0; a < 2; ++a)
#pragma unroll
        for (int b = 0; b < 2; ++b)
#pragma unroll
            for (int m = 0; m < 4; ++m)
#pragma unroll
                for (int n = 0; n < 2; ++n) acc[a][b][m][n] = (f32x4){0.f, 0.f, 0.f, 0.f};
    bf16x8 At[4][2], B0[2][2], B1[2][2];
    const char* cA = (const char*)g.A + (size_t)cur.pm * tstep; const char* cB = (const char*)g.Bt + (size_t)cur.pn * tstep;
    S.a_ready(cur);
    if constexpr (SP2) {
        PG8_STAGE(PG8_SB(0, 0), cB, voffB); PG8_STAGE(PG8_SB(0, 1), cB + hstep, voffB); PG8_STAGE(PG8_SA(0, 0), cA, voffA); PG8_STAGE(PG8_SA(0, 1), cA + hstep, voffA);
        if (wr == 1) PG8_BAR;
        PG8_WAIT_V(2); PG8_BAR;
        PG8_STAGE(PG8_SB(1, 0), cB + kstep, voffB); PG8_STAGE(PG8_SA(1, 0), cA + kstep, voffA); PG8_STAGE(PG8_SB(1, 1), cB + hstep + kstep, voffB);
        PG8_WAIT_V(6); PG8_BAR;
    } else {
        PG8_STAGE(PG8_SB(0, 0), cB, voffB); PG8_STAGE(PG8_SA(0, 0), cA, voffA); PG8_STAGE(PG8_SB(0, 1), cB + hstep, voffB); PG8_STAGE(PG8_SA(0, 1), cA + hstep, voffA);
        if (wr == 1) PG8_BAR;
        PG8_WAIT_V(4); PG8_BAR;
        PG8_STAGE(PG8_SB(1, 0), cB + kstep, voffB); PG8_STAGE(PG8_SA(1, 0), cA + kstep, voffA); PG8_STAGE(PG8_SB(1, 1), cB + hstep + kstep, voffB);
        PG8_WAIT_V(6); PG8_BAR;
    }
    for (;;) {
        const bool has_next = S.next(ui + 1, nxt);
        const char* nA = has_next ? (const char*)g.A + (size_t)nxt.pm * tstep : cA; const char* nB = has_next ? (const char*)g.Bt + (size_t)nxt.pn * tstep : cB;
        for (int t = 0; t < nt; t += 2) {
            const bool last = (t == nt - 2);
            const char* a1 = cA + (size_t)(t + 1) * kstep;
            const char* a2 = last ? nA : cA + (size_t)(t + 2) * kstep; const char* b2 = last ? nB : cB + (size_t)(t + 2) * kstep;
            const char* a3 = a2 + kstep; const char* b3 = b2 + kstep;
            if (last && has_next) S.a_ready(nxt);
            if constexpr (SP2) {
            PG8_LDB(B0, 0, 0); PG8_LDB(B1, 0, 1); PG8_SCHED; PG8_LDA(At, 0, 0); PG8_STAGE(PG8_SA(1, 1), a1 + hstep, voffA);
            PG8_WAIT_V(8); PG8_WAIT_L(0); PG8_BAR; PG8_MMA(0, 0, At, B0); PG8_MMA(0, 1, At, B1); PG8_BAR; PG8_SCHED;
            PG8_LDA(At, 0, 1); PG8_STAGE(PG8_SB(0, 0), b2, voffB); PG8_STAGE(PG8_SB(0, 1), b2 + hstep, voffB); PG8_STAGE(PG8_SA(0, 0), a2, voffA);
            PG8_WAIT_V(8); PG8_WAIT_L(0); PG8_BAR; PG8_MMA(1, 0, At, B0); PG8_MMA(1, 1, At, B1); PG8_BAR; PG8_SCHED;
            PG8_LDB(B0, 1, 0); PG8_LDB(B1, 1, 1); PG8_SCHED; PG8_LDA(At, 1, 0); PG8_STAGE(PG8_SA(0, 1), a2 + hstep, voffA);
            PG8_WAIT_V(8); PG8_WAIT_L(0); PG8_BAR; PG8_MMA(0, 0, At, B0); PG8_MMA(0, 1, At, B1); PG8_BAR; PG8_SCHED;
            PG8_LDA(At, 1, 1); PG8_STAGE(PG8_SB(1, 0), b3, voffB); PG8_STAGE(PG8_SB(1, 1), b3 + hstep, voffB); PG8_STAGE(PG8_SA(1, 0), a3, voffA);
            PG8_WAIT_V(8); PG8_WAIT_L(0); PG8_BAR; PG8_MMA(1, 0, At, B0); PG8_MMA(1, 1, At, B1); PG8_BAR; PG8_SCHED;
            } else {
            PG8_LDB(B0, 0, 0); PG8_SCHED; PG8_LDA(At, 0, 0); PG8_STAGE(PG8_SA(1, 1), a1 + hstep, voffA);
            PG8_WAIT_L(8); PG8_BAR; PG8_WAIT_L(0); PG8_MMA(0, 0, At, B0); PG8_BAR; PG8_SCHED;
            PG8_LDB(B1, 0, 1); PG8_STAGE(PG8_SB(0, 0), b2, voffB);
            PG8_BAR; PG8_WAIT_L(0); PG8_MMA(0, 1, At, B1); PG8_BAR;
            PG8_LDA(At, 0, 1); PG8_STAGE(PG8_SA(0, 0), a2, voffA);
            PG8_BAR; PG8_WAIT_L(0); PG8_MMA(1, 0, At, B0); PG8_BAR; PG8_SCHED;
            PG8_STAGE(PG8_SB(0, 1), b2 + hstep, voffB);
            PG8_WAIT_V(6); PG8_BAR; PG8_MMA(1, 1, At, B1); PG8_BAR;
            PG8_LDB(B0, 1, 0); PG8_SCHED; PG8_LDA(At, 1, 0); PG8_STAGE(PG8_SA(0, 1), a2 + hstep, voffA);
            PG8_WAIT_L(8); PG8_BAR; PG8_WAIT_L(0); PG8_MMA(0, 0, At, B0); PG8_BAR; PG8_SCHED;
            PG8_LDB(B1, 1, 1); PG8_STAGE(PG8_SB(1, 0), b3, voffB);
            PG8_BAR; PG8_WAIT_L(0); PG8_MMA(0, 1, At, B1); PG8_BAR;
            PG8_LDA(At, 1, 1); PG8_STAGE(PG8_SA(1, 0), a3, voffA);
            PG8_BAR; PG8_WAIT_L(0); PG8_MMA(1, 0, At, B0); PG8_BAR; PG8_SCHED;
            PG8_STAGE(PG8_SB(1, 1), b3 + hstep, voffB);
            PG8_WAIT_V(6); PG8_BAR; PG8_MMA(1, 1, At, B1); PG8_BAR;
            }
        }
        if constexpr (ALIGN_EPI) { if (wr == 0) PG8_BAR; }
        if constexpr (!Epi::AFTER_DRAIN) { E(acc, cur, wr, wc, fr, fq); S.done(cur); }
        if (!has_next) break;
#pragma unroll
        for (int a = 0; a < 2; ++a)
#pragma unroll
            for (int b = 0; b < 2; ++b)
#pragma unroll
                for (int m = 0; m < 4; ++m)
#pragma unroll
                    for (int n = 0; n < 2; ++n) acc[a][b][m][n] = (f32x4){0.f, 0.f, 0.f, 0.f};
        cur = nxt; cA = nA; cB = nB; ++ui;
        if constexpr (ALIGN_EPI) { if (wr == 1) PG8_BAR; }
    }
    PG8_WAIT_V(0);
    if constexpr (!ALIGN_EPI) { if (wr == 0) PG8_BAR; }
    PG8_BAR;
    if constexpr (Epi::AFTER_DRAIN) { E.fused(acc, cur, wr, wc, fr, fq, lds, wid, lane); S.done(cur); }
#undef PG8_SA
#undef PG8_SB
#undef PG8_STAGE
#undef PG8_LDA
#undef PG8_LDB
#undef PG8_MMA
#undef PG8_WAIT_V
#undef PG8_WAIT_L
#undef PG8_BAR
#undef PG8_SCHED
}
}

using pg8::bf16_t; using pg8::bf16x8; using pg8::f32x4; using pg8::u32x4;
typedef unsigned u32x2 __attribute__((ext_vector_type(2)));
#define DI __device__ __forceinline__
#define LAS __attribute__((address_space(3)))
constexpr int DM = 1024, SEQL = 16384, NB = 2, NLAT = NB * SEQL, CTXL = 256, NCTX = NB * CTXL, MROWS = NLAT + NCTX;
constexpr int FF = 2816, NPROJ = 2816, PG_LD = 1536, ATT_LD = 768, HYIN = 2832;
constexpr size_t OUT_ATT = (size_t)40 << 20;
constexpr int NCHUNK = MROWS / 64;
constexpr int NREC = NCHUNK * 4 * 2;
constexpr int REC_BYTES = 73728, REC_W = 0, REC_QG = 16384, REC_KTT = 32768, REC_QK = 49152, REC_UT = 57344;
constexpr int REC_IN_WS = 3640;
constexpr float EPS = 1e-6f;
constexpr int LDS_BYTES = 163840;
constexpr size_t MiB = 1u << 20;
constexpr size_t OFF_MOD = 1 * MiB, OFF_ROPE = OFF_MOD + 512 * 1024, OFF_EGL = OFF_ROPE + 256 * 1024, OFF_AB = 2 * MiB, OFF_SSQ = 5 * MiB, OFF_WT = 8 * MiB;
constexpr size_t OFF_H = 58 * MiB, OFF_Z = 124 * MiB, OFF_QN = 157 * MiB, OFF_KN = 190 * MiB, OFF_VN = 223 * MiB, OFF_BIG = 256 * MiB, OFF_Y = 124 * MiB, OFF_O = 190 * MiB, OFF_X16 = 190 * MiB;
constexpr size_t WS_NEED = 512 * MiB;
constexpr size_t OFF_PROG = OFF_EGL + 32 * 1024;
constexpr size_t WT_IN = 0, WT_OUT = WT_IN + (size_t)2816 * 1024, WT_GU0 = WT_OUT + (size_t)1024 * 1024, WT_DN0 = WT_GU0 + (size_t)5632 * 1024, WT_SCIN = WT_DN0 + (size_t)1024 * 2816,
                 WT_SCOUT = WT_SCIN + (size_t)3072 * 1024, WT_GU1 = WT_SCOUT + (size_t)1024 * 1024, WT_DN1 = WT_GU1 + (size_t)5632 * 1024, WT_END = WT_DN1 + (size_t)1024 * 2816;

struct Args {
    const float* x; const float* c; const float* ctx; const float* c_ctx; const float* ada_w; const float* ada_b; const float* pre_mix_g; const float* post_mix_g; const float* pre_ffn_g; const float* post_ffn_g;
    const float* hy_w_in; const float* hy_w_out; const float* attn_sink; const float* gdn_conv_w; const float* gdn_a_log; const float* gdn_dt_bias; const float* gdn_norm_g;
    const float* sc_w_in; const float* sc_conv_w; const float* sc_w_out; const float* ffn_w_gate; const float* ffn_w_up; const float* ffn_w_down;
    float* out; unsigned char* ws; int ph_lo, ph_hi;
};

DI unsigned f2bf(float f) { unsigned u = __float_as_uint(f); return (u + 0x7fffu + ((u >> 16) & 1u)) >> 16; }
typedef float f32x2_t __attribute__((ext_vector_type(2)));
typedef __bf16 bf16x2_t __attribute__((ext_vector_type(2)));
DI unsigned pk2(float lo, float hi) { f32x2_t v = {lo, hi}; bf16x2_t b = __builtin_convertvector(v, bf16x2_t); return __builtin_bit_cast(unsigned, b); }
DI float bflo(unsigned u) { return __uint_as_float(u << 16); }
DI float bfhi(unsigned u) { return __uint_as_float(u & 0xffff0000u); }
DI float bf1(bf16_t h) { return __uint_as_float(((unsigned)h) << 16); }
DI float wave_sum(float v) {
#pragma unroll
    for (int o = 32; o; o >>= 1) v += __shfl_xor(v, o);
    return v;
}
DI float siluf(float x) { return x * __builtin_amdgcn_rcpf(1.f + __expf(-x)); }
DI f32x4 mfma16(bf16x8 a, bf16x8 b, f32x4 c) { return __builtin_amdgcn_mfma_f32_16x16x32_bf16(a, b, c, 0, 0, 0); }
DI bf16x8 pack2(f32x4 a, f32x4 b) { u32x4 p; p.x = pk2(a[0], a[1]); p.y = pk2(a[2], a[3]); p.z = pk2(b[0], b[1]); p.w = pk2(b[2], b[3]); return __builtin_bit_cast(bf16x8, p); }
DI bf16x8 ldf16(const char* p) { return *(const bf16x8*)p; }
DI bf16x8 ldf8x2(const char* p) { u32x2 lo = *(const u32x2*)p; u32x2 hi = *(const u32x2*)(p + 32); u32x4 v; v.x = lo.x; v.y = lo.y; v.z = hi.x; v.w = hi.y; return __builtin_bit_cast(bf16x8, v); }
DI void unpack8(u32x4 v, float (&f)[8]) { f[0] = bflo(v.x); f[1] = bfhi(v.x); f[2] = bflo(v.y); f[3] = bfhi(v.y); f[4] = bflo(v.z); f[5] = bfhi(v.z); f[6] = bflo(v.w); f[7] = bfhi(v.w); }
DI u32x4 pack8(const float (&f)[8]) { u32x4 v; v.x = pk2(f[0], f[1]); v.y = pk2(f[2], f[3]); v.z = pk2(f[4], f[5]); v.w = pk2(f[6], f[7]); return v; }

DI unsigned char* rec_ptr(const Args& a, int r) { return r < REC_IN_WS ? a.ws + OFF_BIG + (size_t)r * REC_BYTES : (unsigned char*)a.out + (size_t)(r - REC_IN_WS) * REC_BYTES; }

struct EpiProj {
    static constexpr bool PERM = true, AFTER_DRAIN = false;
    bf16_t* AT; bf16_t* P; bf16_t* Z;
    DI void operator()(const f32x4 (&acc)[2][2][4][2], const pg8::Unit& u, int wr, int wc, int fr, int fq) const {
        const int row0 = u.pm * 256 + wr * 64 + fr; bf16_t* base; int ld, colt;
        if (u.pn < 3) { base = AT; ld = ATT_LD; colt = u.pn * 256; } else if (u.pn < 9) { base = P; ld = PG_LD; colt = (u.pn - 3) * 256; } else { base = Z; ld = 512; colt = (u.pn - 9) * 256; }
        const int col0 = colt + wc * 32 + 8 * fq;
#pragma unroll
        for (int ai = 0; ai < 2; ++ai)
#pragma unroll
            for (int m = 0; m < 4; ++m) { bf16_t* rowp = base + (size_t)(row0 + ai * 128 + m * 16) * ld + col0;
#pragma unroll
                for (int bj = 0; bj < 2; ++bj) { const f32x4 v0 = acc[ai][bj][m][0], v1 = acc[ai][bj][m][1]; u32x4 w;
                    w.x = pg8::cvt_pk_bf16(v0[0], v0[1]); w.y = pg8::cvt_pk_bf16(v0[2], v0[3]); w.z = pg8::cvt_pk_bf16(v1[0], v1[1]); w.w = pg8::cvt_pk_bf16(v1[2], v1[3]);
                    *(u32x4*)(rowp + bj * 128) = w; } }
    }
};
struct EpiAct {
    static constexpr bool PERM = true, AFTER_DRAIN = false;
    bf16_t* O;
    DI void operator()(const f32x4 (&acc)[2][2][4][2], const pg8::Unit& u, int wr, int wc, int fr, int fq) const {
        const int row0 = u.pm * 256 + wr * 64 + fr, col0 = u.pn * 128 + wc * 32 + 8 * fq;
#pragma unroll
        for (int ai = 0; ai < 2; ++ai)
#pragma unroll
            for (int m = 0; m < 4; ++m) { bf16_t* rowp = O + (size_t)(row0 + ai * 128 + m * 16) * FF + col0; float v[8];
#pragma unroll
                for (int n = 0; n < 2; ++n)
#pragma unroll
                    for (int e = 0; e < 4; ++e) v[4 * n + e] = siluf(acc[ai][0][m][n][e]) * acc[ai][1][m][n][e];
                u32x4 w; w.x = pg8::cvt_pk_bf16(v[0], v[1]); w.y = pg8::cvt_pk_bf16(v[2], v[3]); w.z = pg8::cvt_pk_bf16(v[4], v[5]); w.w = pg8::cvt_pk_bf16(v[6], v[7]);
                *(u32x4*)rowp = w; }
    }
};
struct EpiSc {
    static constexpr bool PERM = true, AFTER_DRAIN = false;
    bf16_t* CU; bf16_t* BG;
    DI void operator()(const f32x4 (&acc)[2][2][4][2], const pg8::Unit& u, int wr, int wc, int fr, int fq) const {
        const int row0 = u.pm * 256 + wr * 64 + fr;
        if (u.pn < 8) {
            const int col0 = u.pn * 128 + wc * 32 + 8 * fq;
#pragma unroll
            for (int ai = 0; ai < 2; ++ai)
#pragma unroll
                for (int m = 0; m < 4; ++m) { bf16_t* rowp = CU + (size_t)(row0 + ai * 128 + m * 16) * DM + col0; float v[8];
#pragma unroll
                    for (int n = 0; n < 2; ++n)
#pragma unroll
                        for (int e = 0; e < 4; ++e) v[4 * n + e] = acc[ai][0][m][n][e] * acc[ai][1][m][n][e];
                    u32x4 w; w.x = pg8::cvt_pk_bf16(v[0], v[1]); w.y = pg8::cvt_pk_bf16(v[2], v[3]); w.z = pg8::cvt_pk_bf16(v[4], v[5]); w.w = pg8::cvt_pk_bf16(v[6], v[7]);
                    *(u32x4*)rowp = w; }
        } else {
            const int col0 = (u.pn - 8) * 256 + wc * 32 + 8 * fq;
#pragma unroll
            for (int ai = 0; ai < 2; ++ai)
#pragma unroll
                for (int m = 0; m < 4; ++m) { bf16_t* rowp = BG + (size_t)(row0 + ai * 128 + m * 16) * DM + col0;
#pragma unroll
                    for (int bj = 0; bj < 2; ++bj) { const f32x4 v0 = acc[ai][bj][m][0], v1 = acc[ai][bj][m][1]; u32x4 w;
                        w.x = pg8::cvt_pk_bf16(v0[0], v0[1]); w.y = pg8::cvt_pk_bf16(v0[2], v0[3]); w.z = pg8::cvt_pk_bf16(v1[0], v1[1]); w.w = pg8::cvt_pk_bf16(v1[2], v1[3]);
                        *(u32x4*)(rowp + bj * 128) = w; } }
        }
    }
};
struct EpiY {
    static constexpr bool PERM = true, AFTER_DRAIN = false;
    bf16_t* Y; float* SSQ;
    DI void operator()(const f32x4 (&acc)[2][2][4][2], const pg8::Unit& u, int wr, int wc, int fr, int fq) const {
        const int row0 = u.pm * 256 + wr * 64 + fr, col0 = u.pn * 256 + wc * 32 + 8 * fq;
#pragma unroll
        for (int ai = 0; ai < 2; ++ai)
#pragma unroll
            for (int m = 0; m < 4; ++m) { const int row = row0 + ai * 128 + m * 16; bf16_t* rowp = Y + (size_t)row * DM + col0; float s = 0.f;
#pragma unroll
                for (int bj = 0; bj < 2; ++bj) { const f32x4 v0 = acc[ai][bj][m][0], v1 = acc[ai][bj][m][1]; u32x4 w;
                    w.x = pg8::cvt_pk_bf16(v0[0], v0[1]); w.y = pg8::cvt_pk_bf16(v0[2], v0[3]); w.z = pg8::cvt_pk_bf16(v1[0], v1[1]); w.w = pg8::cvt_pk_bf16(v1[2], v1[3]);
                    *(u32x4*)(rowp + bj * 128) = w;
                    s += v0[0] * v0[0] + v0[1] * v0[1] + v0[2] * v0[2] + v0[3] * v0[3] + v1[0] * v1[0] + v1[1] * v1[1] + v1[2] * v1[2] + v1[3] * v1[3]; }
                s += __shfl_xor(s, 16); s += __shfl_xor(s, 32);
                if (fq == 0) SSQ[(size_t)row * 16 + u.pn * 4 + wc] = s; }
    }
};

template <class Epi> DI void run_gemm(char* smem, const bf16_t* A, const bf16_t* Bt, int M, int N, int K, const Epi& E) {
    pg8::Gemm g; g.A = A; g.Bt = Bt; g.M = M; g.N = N; g.K = K;
    pg8::StaticOrder S; S.init(M, N, (int)gridDim.x, (int)blockIdx.x);
    pg8::gemm_phase<Epi, pg8::StaticOrder, false, true>((PG8_LAS unsigned char*)smem, g, S, E);
    __syncthreads();
}

DI void p0_ada_unit(const Args& a, char* smem, int u) {
    const int l = u / 96, col0 = (u % 96) * 64, tid = tidx();
    float* sc = (float*)smem;
    float* red = (float*)(smem + 12288);
    for (int i = tid; i < 3072; i += 512) { const int cd = i >> 10, k = i & 1023; const float v = cd < 2 ? a.c[cd * DM + k] : a.c_ctx[k]; sc[i] = siluf(v); }
    __syncthreads();
    const int col = tid & 63, kq = tid >> 6;
    const float* W = a.ada_w + (size_t)l * DM * 6144 + col0 + col;
    float s0 = 0.f, s1 = 0.f, s2 = 0.f;
    for (int k0 = kq * 128; k0 < kq * 128 + 128; k0 += 16) { float w[16];
#pragma unroll
        for (int j = 0; j < 16; ++j) w[j] = W[(size_t)(k0 + j) * 6144];
#pragma unroll
        for (int j = 0; j < 16; ++j) { s0 += sc[k0 + j] * w[j]; s1 += sc[1024 + k0 + j] * w[j]; s2 += sc[2048 + k0 + j] * w[j]; } }
    red[(kq * 3 + 0) * 64 + col] = s0; red[(kq * 3 + 1) * 64 + col] = s1; red[(kq * 3 + 2) * 64 + col] = s2;
    __syncthreads();
    if (tid < 192) { const int cd = tid >> 6, cc = tid & 63; float s = 0.f;
        for (int q = 0; q < 8; ++q) s += red[(q * 3 + cd) * 64 + cc];
        float* MOD = (float*)(a.ws + OFF_MOD);
        MOD[((size_t)l * 3 + cd) * 6144 + col0 + cc] = s + a.ada_b[l * 6144 + col0 + cc]; }
    __syncthreads();
}
DI void p0_rope_unit(const Args& a) {
    if (tidx() < 16) __hip_atomic_store((unsigned*)(a.ws + OFF_PROG) + tidx() * 16, 0u, __ATOMIC_RELAXED, __HIP_MEMORY_SCOPE_AGENT);
    float2* R = (float2*)(a.ws + OFF_ROPE);
    for (int i = tidx(); i < 4096; i += 512) { const int p = i >> 4, f = i & 15;
        const float inv = powf(10000.f, -(float)f / 16.f); const float ang = (float)p * inv;
        R[i] = make_float2(cosf(ang), sinf(ang)); }
}
struct WtTile { const float* src; bf16_t* dst; int ldn, K, scol0, n0, k0; };
DI WtTile p0_wt_desc(const Args& a, int t) {
    bf16_t* WT = (bf16_t*)(a.ws + OFF_WT);
    const int T_IN = 44 * 16, T_OUT = 16 * 16, T_GU = 88 * 16, T_DN = 16 * 44, T_SCIN = 48 * 16, T_SCOUT = 16 * 16;
    int m = 0; int rem = t;
    if (rem >= T_IN) { rem -= T_IN; m = 1;
      if (rem >= T_OUT) { rem -= T_OUT; m = 2;
        if (rem >= T_GU) { rem -= T_GU; m = 3;
          if (rem >= T_DN) { rem -= T_DN; m = 4;
            if (rem >= T_SCIN) { rem -= T_SCIN; m = 5;
              if (rem >= T_SCOUT) { rem -= T_SCOUT; m = 6;
                if (rem >= T_GU) { rem -= T_GU; m = 7; } } } } } } }
    WtTile d; int nb, kb;
    if (m == 0) { d.K = 1024; nb = rem / 16; kb = rem % 16; d.src = a.hy_w_in; d.ldn = HYIN; d.scol0 = nb * 64; d.dst = WT + WT_IN; }
    else if (m == 1) { d.K = 1024; nb = rem / 16; kb = rem % 16; d.src = a.hy_w_out; d.ldn = 1024; d.scol0 = nb * 64; d.dst = WT + WT_OUT; }
    else if (m == 2 || m == 6) { const int l = m == 2 ? 0 : 1; d.K = 1024; nb = rem / 16; kb = rem % 16; const int n0 = nb * 64, pn = n0 >> 8, sg = (n0 >> 7) & 1, i0 = n0 & 127;
        d.src = (sg ? a.ffn_w_up : a.ffn_w_gate) + (size_t)l * DM * FF; d.ldn = FF; d.scol0 = pn * 128 + i0; d.dst = WT + (l ? WT_GU1 : WT_GU0); }
    else if (m == 3 || m == 7) { const int l = m == 3 ? 0 : 1; d.K = 2816; nb = rem / 44; kb = rem % 44; d.src = a.ffn_w_down + (size_t)l * FF * DM; d.ldn = 1024; d.scol0 = nb * 64; d.dst = WT + (l ? WT_DN1 : WT_DN0); }
    else if (m == 4) { d.K = 1024; nb = rem / 16; kb = rem % 16; const int n0 = nb * 64; d.src = a.sc_w_in; d.ldn = 3072; d.dst = WT + WT_SCIN;
        if (n0 < 2048) { const int pn = n0 >> 8, sg = (n0 >> 7) & 1, i0 = n0 & 127; d.scol0 = (sg ? 2048 : 1024) + pn * 128 + i0; } else d.scol0 = n0 - 2048; }
    else { d.K = 1024; nb = rem / 16; kb = rem % 16; d.src = a.sc_w_out; d.ldn = 1024; d.scol0 = nb * 64; d.dst = WT + WT_SCOUT; }
    d.n0 = nb * 64; d.k0 = kb * 64; return d;
}
constexpr int P0_WT_TILES = 44 * 16 + 16 * 16 + 88 * 16 + 16 * 44 + 48 * 16 + 16 * 16 + 88 * 16 + 16 * 44;
constexpr int P0_WT_GROUPS = P0_WT_TILES / 4, P0_WT_EARLY = 44 * 16 / 4;
DI void p0_wt_group(const Args& a, char* smem, int g) {
    const int tid = tidx(); float* T = (float*)smem;
    f32x4 v0[4], v1[4];
#pragma unroll
    for (int j = 0; j < 4; ++j) { const WtTile d = p0_wt_desc(a, g * 4 + j); const int k = tid >> 3, ns = (tid & 7) * 8; const float* p = d.src + (size_t)(d.k0 + k) * d.ldn + d.scol0 + ns;
        v0[j] = *(const f32x4*)p; v1[j] = *(const f32x4*)(p + 4); }
#pragma unroll
    for (int j = 0; j < 4; ++j) { const int k = tid >> 3, ns = (tid & 7) * 8; float* t = T + j * 4160 + k * 65 + ns;
        t[0] = v0[j][0]; t[1] = v0[j][1]; t[2] = v0[j][2]; t[3] = v0[j][3]; t[4] = v1[j][0]; t[5] = v1[j][1]; t[6] = v1[j][2]; t[7] = v1[j][3]; }
    __syncthreads();
#pragma unroll
    for (int j = 0; j < 4; ++j) { const WtTile d = p0_wt_desc(a, g * 4 + j); const int n = tid >> 3, ks = (tid & 7) * 8; float f[8];
#pragma unroll
        for (int e = 0; e < 8; ++e) f[e] = T[j * 4160 + (ks + e) * 65 + n];
        *(u32x4*)(d.dst + (size_t)(d.n0 + n) * d.K + d.k0 + ks) = pack8(f); }
    __syncthreads();
}
DI void phase0(const Args& a, char* smem) {
    for (int u = blockIdx.x; u < 193 + P0_WT_EARLY; u += gridDim.x) {
        if (u < 192) p0_ada_unit(a, smem, u); else if (u == 192) p0_rope_unit(a); else p0_wt_group(a, smem, u - 193);
    }
}

DI void phase1(const Args& a, char* smem) {
    float* WAB = (float*)smem;
    const int tid = tidx(), lane = tid & 63, wid = tid >> 6;
    for (int i = tid; i < 16384; i += 512) { const int k = i >> 4, j = i & 15; WAB[j * 1024 + k] = a.hy_w_in[(size_t)k * HYIN + 2816 + j]; }
    __syncthreads();
    const float* MOD = (const float*)(a.ws + OFF_MOD);
    bf16_t* H = (bf16_t*)(a.ws + OFF_H); float* AB = (float*)(a.ws + OFF_AB);
    f32x4 m1[4], m0[4]; int cur_cd = -1;
    const int rs = (int)gridDim.x * 8;
    f32x4 nv[4];
    { const int row0 = blockIdx.x * 8 + wid; if (row0 < MROWS) { const float* src0 = row0 < NLAT ? a.x + (size_t)row0 * DM : a.ctx + (size_t)(row0 - NLAT) * DM;
#pragma unroll
        for (int i = 0; i < 4; ++i) nv[i] = *(const f32x4*)(src0 + i * 256 + lane * 4); } }
    for (int row = blockIdx.x * 8 + wid; row < MROWS; row += rs) {
        const int cd = row < NLAT ? row / SEQL : 2;
        if (cd != cur_cd) { const float* sh = MOD + (size_t)cd * 6144, *scl = sh + 1024;
#pragma unroll
            for (int i = 0; i < 4; ++i) { const int k = i * 256 + lane * 4; const f32x4 g = *(const f32x4*)(a.pre_mix_g + k), s1 = *(const f32x4*)(sh + k), c1 = *(const f32x4*)(scl + k); m1[i] = g * (c1 + 1.f); m0[i] = s1; }
            cur_cd = cd; }
        f32x4 v[4]; float ss = 0.f;
#pragma unroll
        for (int i = 0; i < 4; ++i) { v[i] = nv[i]; ss += v[i][0] * v[i][0] + v[i][1] * v[i][1] + v[i][2] * v[i][2] + v[i][3] * v[i][3]; }
        { const int nrow = row + rs; if (nrow < MROWS) { const float* srcn = nrow < NLAT ? a.x + (size_t)nrow * DM : a.ctx + (size_t)(nrow - NLAT) * DM;
#pragma unroll
            for (int i = 0; i < 4; ++i) nv[i] = *(const f32x4*)(srcn + i * 256 + lane * 4); } }
        ss = wave_sum(ss); const float r = rsqrtf(ss * (1.f / 1024.f) + EPS);
#pragma unroll
        for (int i = 0; i < 4; ++i) { const int k = i * 256 + lane * 4;
#pragma unroll
            for (int e = 0; e < 4; ++e) v[i][e] = v[i][e] * r * m1[i][e] + m0[i][e];
            u32x2 w; w.x = pk2(v[i][0], v[i][1]); w.y = pk2(v[i][2], v[i][3]); *(u32x2*)(H + (size_t)row * DM + k) = w; }
        float p[16];
#pragma unroll
        for (int j = 0; j < 16; ++j) { float sj = 0.f;
#pragma unroll
            for (int i = 0; i < 4; ++i) { const f32x4 w = *(const f32x4*)(WAB + j * 1024 + i * 256 + lane * 4); sj += v[i][0] * w[0] + v[i][1] * w[1] + v[i][2] * w[2] + v[i][3] * w[3]; }
            p[j] = sj; __builtin_amdgcn_sched_barrier(0); }
        float q8[8], q4[4], q2[2], q1;
        { const bool hi = (lane & 32) != 0;
#pragma unroll
          for (int t = 0; t < 8; ++t) { const float snd = hi ? p[t] : p[t + 8], kp = hi ? p[t + 8] : p[t]; q8[t] = kp + __shfl_xor(snd, 32); } }
        { const bool hi = (lane & 16) != 0;
#pragma unroll
          for (int t = 0; t < 4; ++t) { const float snd = hi ? q8[t] : q8[t + 4], kp = hi ? q8[t + 4] : q8[t]; q4[t] = kp + __shfl_xor(snd, 16); } }
        { const bool hi = (lane & 8) != 0;
#pragma unroll
          for (int t = 0; t < 2; ++t) { const float snd = hi ? q4[t] : q4[t + 2], kp = hi ? q4[t + 2] : q4[t]; q2[t] = kp + __shfl_xor(snd, 8); } }
        { const bool hi = (lane & 4) != 0; const float snd = hi ? q2[0] : q2[1], kp = hi ? q2[1] : q2[0]; q1 = kp + __shfl_xor(snd, 4); }
        q1 += __shfl_xor(q1, 2); q1 += __shfl_xor(q1, 1);
        if ((lane & 3) == 0) AB[(size_t)row * 16 + (lane >> 2)] = q1;
    }
    __syncthreads();
}

DI void conv_rows(const Args& a) {
    const int lane = tidx() & 63, wid = tidx() >> 6;
    const bf16_t* P = (const bf16_t*)(a.ws + OFF_BIG);
    bf16_t* QN = (bf16_t*)(a.ws + OFF_QN); bf16_t* KN = (bf16_t*)(a.ws + OFF_KN); bf16_t* VN = (bf16_t*)(a.ws + OFF_VN);
    float w0[3][8], w1[3][8], w2[3][8];
#pragma unroll
    for (int part = 0; part < 3; ++part)
#pragma unroll
        for (int e = 0; e < 8; ++e) { const int ch = part * 512 + lane * 8 + e; w0[part][e] = a.gdn_conv_w[ch]; w1[part][e] = a.gdn_conv_w[1536 + ch]; w2[part][e] = a.gdn_conv_w[3072 + ch]; }
    const u32x4 zero4 = {0u, 0u, 0u, 0u};
    for (int blk = blockIdx.x * 8 + wid; blk < MROWS / 16; blk += gridDim.x * 8) {
        const int r0 = blk * 16;
        int t0, len; if (r0 < NLAT) { t0 = r0 & (SEQL - 1); len = SEQL; } else { t0 = (r0 - NLAT) & (CTXL - 1); len = CTXL; }
        u32x4 xp[3], xc[3], xn[3], xnn[3];
#pragma unroll
        for (int part = 0; part < 3; ++part) { const bf16_t* p = P + (size_t)r0 * PG_LD + part * 512 + lane * 8;
            xc[part] = *(const u32x4*)p; xp[part] = t0 > 0 ? *(const u32x4*)(p - PG_LD) : zero4; xn[part] = t0 + 1 < len ? *(const u32x4*)(p + PG_LD) : zero4; }
        for (int i = 0; i < 16; ++i) {
            const int row = r0 + i, t = t0 + i;
#pragma unroll
            for (int part = 0; part < 3; ++part) xnn[part] = (i < 15 && t + 2 < len) ? *(const u32x4*)(P + (size_t)(row + 2) * PG_LD + part * 512 + lane * 8) : zero4;
#pragma unroll
            for (int part = 0; part < 3; ++part) {
                float fc[8], fp[8], fn[8]; unpack8(xc[part], fc); unpack8(xp[part], fp); unpack8(xn[part], fn);
                float y[8]; float ss = 0.f;
#pragma unroll
                for (int e = 0; e < 8; ++e) { const float cv = w0[part][e] * fp[e] + w1[part][e] * fc[e] + w2[part][e] * fn[e]; y[e] = siluf(cv); ss += y[e] * y[e]; }
                if (part < 2) {
                    ss += __shfl_xor(ss, 1); ss += __shfl_xor(ss, 2); ss += __shfl_xor(ss, 4); ss += __shfl_xor(ss, 8);
                    const float r = rsqrtf(ss + EPS) * (part == 0 ? 0.08838834764831845f : 1.f);
#pragma unroll
                    for (int e = 0; e < 8; ++e) y[e] *= r;
                }
                bf16_t* dst = (part == 0 ? QN : part == 1 ? KN : VN) + (size_t)row * 512 + lane * 8;
                *(u32x4*)dst = pack8(y);
            }
#pragma unroll
            for (int part = 0; part < 3; ++part) { xp[part] = xc[part]; xc[part] = xn[part]; xn[part] = xnn[part]; }
        }
    }
}

constexpr int AT_QS = 0, AT_KS = 36864, AT_VT = AT_KS + 320 * 144, AT_VT_STRIDE = 656, AT_ROPE = AT_VT + 64 * 656;
static_assert(AT_ROPE + 32768 <= LDS_BYTES, "attention LDS map");
constexpr int N_ATT_UNITS = 1024;
DI int vt_pos(int i) { return (i & ~31) + ((i >> 2) & 3) * 8 + ((i >> 4) & 1) * 4 + (i & 3); }
DI void attn_load_kv(const Args& a, char* smem, const bf16_t* P, long grow0, int tpos0, int tlen, int nrows, int kvh, bool rope) {
    const int tid = tidx();
    const float2* R = (const float2*)(smem + AT_ROPE);
    u32x4 ka[3], kb[3], vv[5];
#pragma unroll
    for (int it = 0; it < 3; ++it) { const int idx = tid + it * 512, i = idx >> 2, q = idx & 3, t = tpos0 + i; const bool ok = idx < nrows * 4 && t >= 0 && t < tlen;
        ka[it] = (u32x4){0u, 0u, 0u, 0u}; kb[it] = (u32x4){0u, 0u, 0u, 0u};
        if (ok) { const bf16_t* p = P + (grow0 + i) * ATT_LD + 512 + kvh * 64 + q * 8; ka[it] = *(const u32x4*)p; kb[it] = *(const u32x4*)(p + 32); } }
#pragma unroll
    for (int it = 0; it < 5; ++it) { const int idx = tid + it * 512, q = idx / nrows, i = idx - q * nrows, t = tpos0 + i; const bool ok = idx < nrows * 8 && t >= 0 && t < tlen;
        vv[it] = (u32x4){0u, 0u, 0u, 0u};
        if (ok) vv[it] = *(const u32x4*)(P + (grow0 + i) * ATT_LD + 640 + kvh * 64 + q * 8); }
#pragma unroll
    for (int it = 0; it < 3; ++it) { const int idx = tid + it * 512, i = idx >> 2, q = idx & 3, t = tpos0 + i;
        if (idx < nrows * 4) {
            float x1[8], x2[8]; unpack8(ka[it], x1); unpack8(kb[it], x2);
            if (rope && t >= 0 && t < tlen) { const int pp = (q < 2) ? (t >> 6) : (t & 63); const float2* rp = R + pp * 16 + (q & 1) * 8;
#pragma unroll
                for (int e = 0; e < 8; ++e) { const float2 cs = rp[e]; const float o1 = x1[e] * cs.x - x2[e] * cs.y, o2 = x2[e] * cs.x + x1[e] * cs.y; x1[e] = o1; x2[e] = o2; } }
            *(u32x4*)(smem + AT_KS + i * 144 + q * 16) = pack8(x1);
            *(u32x4*)(smem + AT_KS + i * 144 + 64 + q * 16) = pack8(x2); } }
#pragma unroll
    for (int it = 0; it < 5; ++it) { const int idx = tid + it * 512, q = idx / nrows, i = idx - q * nrows;
        if (idx < nrows * 8) { const u32x4 v = vv[it];
            bf16_t* vt = (bf16_t*)(smem + AT_VT) + vt_pos(i); const int d0 = q * 8;
            vt[(d0 + 0) * 328] = (bf16_t)(v.x & 0xffff); vt[(d0 + 1) * 328] = (bf16_t)(v.x >> 16);
            vt[(d0 + 2) * 328] = (bf16_t)(v.y & 0xffff); vt[(d0 + 3) * 328] = (bf16_t)(v.y >> 16);
            vt[(d0 + 4) * 328] = (bf16_t)(v.z & 0xffff); vt[(d0 + 5) * 328] = (bf16_t)(v.z >> 16);
            vt[(d0 + 6) * 328] = (bf16_t)(v.w & 0xffff); vt[(d0 + 7) * 328] = (bf16_t)(v.w >> 16); } }
}
DI void attn_unit(const Args& a, char* smem, int u) {
    const int b = u >> 9, kvh = (u >> 8) & 1, qb = u & 255, q0 = qb * 64;
    const int tid = tidx(), lane = tid & 63, wid = tid >> 6, fr = lane & 15, fq = lane >> 4;
    const bf16_t* P = (const bf16_t*)((const unsigned char*)a.out + OUT_ATT);
    const float2* R = (const float2*)(smem + AT_ROPE);
    bf16_t* MIX = (bf16_t*)(a.ws + OFF_H);
    constexpr float QSCALE = 0.125f * 1.4426950408889634f;
#pragma unroll
    for (int it = 0; it < 2; ++it) { const int idx = tid + it * 512, hr = idx >> 2, q = idx & 3, g = hr >> 6, r = hr & 63; const int t = q0 + r;
      const bf16_t* p = P + ((size_t)b * SEQL + t) * ATT_LD + (kvh * 4 + g) * 64 + q * 8; float x1[8], x2[8];
      unpack8(*(const u32x4*)p, x1); unpack8(*(const u32x4*)(p + 32), x2);
      const int pp = (q < 2) ? (t >> 6) : (t & 63); const float2* rp = R + pp * 16 + (q & 1) * 8;
#pragma unroll
      for (int e = 0; e < 8; ++e) { const float2 cs = rp[e]; const float o1 = (x1[e] * cs.x - x2[e] * cs.y) * QSCALE, o2 = (x2[e] * cs.x + x1[e] * cs.y) * QSCALE; x1[e] = o1; x2[e] = o2; }
      *(u32x4*)(smem + AT_QS + hr * 144 + q * 16) = pack8(x1); *(u32x4*)(smem + AT_QS + hr * 144 + 64 + q * 16) = pack8(x2); }
    const int g = wid >> 1, qs = wid & 1, hq = kvh * 4 + g;
    const int qi0 = q0 + qs * 32 + fr;
    float m_run[2], l_run[2];
    m_run[0] = m_run[1] = a.attn_sink[hq] * 1.4426950408889634f; l_run[0] = l_run[1] = (fq == 0) ? 1.f : 0.f;
    f32x4 O[2][4];
#pragma unroll
    for (int j = 0; j < 2; ++j)
#pragma unroll
        for (int dt = 0; dt < 4; ++dt) O[j][dt] = (f32x4){0.f, 0.f, 0.f, 0.f};
    bf16x8 Qf[2][2];
#pragma unroll
    for (int pass = 0; pass < 2; ++pass) {
        if (pass == 0) attn_load_kv(a, smem, P, (long)b * SEQL + q0 - 128, q0 - 128, SEQL, 320, kvh, true);
        else attn_load_kv(a, smem, P, (long)NLAT + b * CTXL, 0, CTXL, 256, kvh, false);
        __syncthreads();
        if (pass == 0) {
#pragma unroll
            for (int j = 0; j < 2; ++j) { const char* qp = smem + AT_QS + (g * 64 + qs * 32 + j * 16 + fr) * 144 + fq * 16; Qf[j][0] = ldf16(qp); Qf[j][1] = ldf16(qp + 64); } }
        const int ngrp = pass == 0 ? 5 : 4;
#pragma unroll 1
        for (int kk = 0; kk < ngrp; ++kk) {
            f32x4 sc[2][4];
            { const char* kp = smem + AT_KS + (kk * 64 + fr) * 144 + fq * 16;
#pragma unroll
              for (int kt = 0; kt < 4; ++kt) { const bf16x8 k0 = ldf16(kp + kt * 16 * 144), k1 = ldf16(kp + kt * 16 * 144 + 64);
#pragma unroll
                  for (int j = 0; j < 2; ++j) { f32x4 z = {0.f, 0.f, 0.f, 0.f}; z = mfma16(k0, Qf[j][0], z); sc[j][kt] = mfma16(k1, Qf[j][1], z); } } }
            const int kbase = q0 - 128 + kk * 64;
            const bool need_mask = pass == 0 && (kk == 0 || kk == 4 || kbase < 0 || kbase + 64 > SEQL);
            if (need_mask) {
#pragma unroll
                for (int j = 0; j < 2; ++j) { const int qi = qi0 + j * 16;
#pragma unroll
                    for (int kt = 0; kt < 4; ++kt)
#pragma unroll
                        for (int r = 0; r < 4; ++r) { const int k = kbase + kt * 16 + fq * 4 + r; const bool v = k >= 0 && k < SEQL && (qi - k) <= 128 && (k - qi) <= 128; sc[j][kt][r] = v ? sc[j][kt][r] : -1e30f; } }
            }
            bf16x8 Pb[2][2];
#pragma unroll
            for (int j = 0; j < 2; ++j) {
                float mx = m_run[j];
#pragma unroll
                for (int kt = 0; kt < 4; ++kt) mx = fmaxf(fmaxf(mx, fmaxf(sc[j][kt][0], sc[j][kt][1])), fmaxf(sc[j][kt][2], sc[j][kt][3]));
                mx = fmaxf(mx, __shfl_xor(mx, 16)); mx = fmaxf(mx, __shfl_xor(mx, 32));
                const float alpha = __builtin_amdgcn_exp2f(m_run[j] - mx); m_run[j] = mx;
                float ps = 0.f;
#pragma unroll
                for (int kt = 0; kt < 4; ++kt)
#pragma unroll
                    for (int r = 0; r < 4; ++r) { const float pv = __builtin_amdgcn_exp2f(sc[j][kt][r] - mx); sc[j][kt][r] = pv; ps += pv; }
                l_run[j] = l_run[j] * alpha + ps;
                Pb[j][0] = pack2(sc[j][0], sc[j][1]); Pb[j][1] = pack2(sc[j][2], sc[j][3]);
#pragma unroll
                for (int dt = 0; dt < 4; ++dt) O[j][dt] = O[j][dt] * alpha;
            }
            { const char* vp = smem + AT_VT + fr * AT_VT_STRIDE + (kk * 64 + fq * 8) * 2;
#pragma unroll
              for (int dt = 0; dt < 4; ++dt)
#pragma unroll
                  for (int kp = 0; kp < 2; ++kp) { const bf16x8 vf = ldf16(vp + dt * 16 * AT_VT_STRIDE + kp * 64);
                      O[0][dt] = mfma16(vf, Pb[0][kp], O[0][dt]); O[1][dt] = mfma16(vf, Pb[1][kp], O[1][dt]); } }
        }
        __syncthreads();
    }
#pragma unroll
    for (int j = 0; j < 2; ++j) {
        float l = l_run[j]; l += __shfl_xor(l, 16); l += __shfl_xor(l, 32);
        const float inv = 1.f / l;
        bf16_t* op = MIX + ((size_t)b * SEQL + qi0 + j * 16) * DM + hq * 64 + fq * 4;
#pragma unroll
        for (int dt = 0; dt < 4; ++dt) { u32x2 w; w.x = pk2(O[j][dt][0] * inv, O[j][dt][1] * inv); w.y = pk2(O[j][dt][2] * inv, O[j][dt][3] * inv); *(u32x2*)(op + dt * 16) = w; }
    }
}
DI void phase3a(const Args& a, char* smem) { conv_rows(a); }

constexpr int PR_Q = 0, PR_K = 17408, PR_KT = 34816, PR_KB = 53248, PR_VT = 71680, PR_AS = 90112, PR_TS = 107520, PR_TB = 124928, PR_GC = 134144, PR_BETA = 134400;
DI float softplusf(float x) { return fmaxf(x, 0.f) + log1pf(expf(-fabsf(x))); }
struct PrepIn { u32x4 lq[2], lk[2], lv[2]; float av, bv; };
DI void prep_load(const Args& a, int r, PrepIn& in) {
    const int dir = r & 1, h = (r >> 1) & 3, cidx = r >> 3, base = cidx * 64;
    const int tid = tidx(), lane = tid & 63;
    const bf16_t* QN = (const bf16_t*)(a.ws + OFF_QN); const bf16_t* KN = (const bf16_t*)(a.ws + OFF_KN); const bf16_t* VN = (const bf16_t*)(a.ws + OFF_VN);
    const float* AB = (const float*)(a.ws + OFF_AB);
#pragma unroll
    for (int it = 0; it < 2; ++it) { const int idx = tid + it * 512, rr = idx & 63, q = idx >> 6; const int tok = dir ? base + 63 - rr : base + rr;
        const size_t go = (size_t)tok * 512 + h * 128 + q * 8; in.lq[it] = *(const u32x4*)(QN + go); in.lk[it] = *(const u32x4*)(KN + go); in.lv[it] = *(const u32x4*)(VN + go); }
    { const int tok = dir ? base + 63 - lane : base + lane; in.av = AB[(size_t)tok * 16 + dir * 4 + h]; in.bv = AB[(size_t)tok * 16 + 8 + dir * 4 + h]; }
}
#define LDS_BARRIER() do { asm volatile("s_waitcnt lgkmcnt(0)" ::: "memory"); __builtin_amdgcn_s_barrier(); asm volatile("" ::: "memory"); } while (0)
DI void prep_unit(const Args& a, char* smem, int r, const PrepIn& in) {
    const int dir = r & 1, h = (r >> 1) & 3, cidx = r >> 3;
    const int tid = tidx(), lane = tid & 63, wid = tid >> 6, fr = lane & 15, fq = lane >> 4;
    float* gc = (float*)(smem + PR_GC); float* beta = (float*)(smem + PR_BETA);
    int slot_;
    { int bb, st; if (cidx < 512) { bb = cidx >> 8; const int n = cidx & 255; st = 4 + (dir ? 255 - n : n); } else { bb = (cidx - 512) >> 2; const int n = (cidx - 512) & 3; st = dir ? 3 - n : n; }
      slot_ = ((bb * 4 + h) * 2 + dir) * 260 + st; }
    const int slot = slot_;
    unsigned char* rec = rec_ptr(a, slot);
    u32x4 lq[2], lk[2], lv[2];
#pragma unroll
    for (int it = 0; it < 2; ++it) { lq[it] = in.lq[it]; lk[it] = in.lk[it]; lv[it] = in.lv[it]; }
    if (wid == 0) {
        const float av = in.av, bv = in.bv;
        float gv = -expf(a.gdn_a_log[dir * 4 + h]) * softplusf(av + a.gdn_dt_bias[dir * 4 + h]);
#pragma unroll
        for (int o = 1; o < 64; o <<= 1) { const float t = __shfl_up(gv, o); if (lane >= o) gv += t; }
        gc[lane] = gv; beta[lane] = 1.f / (1.f + expf(-bv));
        if (lane == 63) ((float*)(a.ws + OFF_EGL))[slot] = expf(gv);
    }
    LDS_BARRIER();
#pragma unroll
    for (int it = 0; it < 2; ++it) {
        const int idx = tid + it * 512, rr = idx & 63, q = idx >> 6;
        const u32x4 qv = lq[it], kv = lk[it], vv = lv[it];
        *(u32x4*)(smem + PR_Q + rr * 272 + q * 16) = qv; *(u32x4*)(smem + PR_K + rr * 272 + q * 16) = kv;
        float kf[8], vf[8]; unpack8(kv, kf); unpack8(vv, vf);
        const float bt = beta[rr], be = bt * expf(gc[rr]);
        bf16_t* kt = (bf16_t*)(smem + PR_KT) + (q * 8) * 72 + rr; bf16_t* kb = (bf16_t*)(smem + PR_KB) + (q * 8) * 72 + rr; bf16_t* vt = (bf16_t*)(smem + PR_VT) + (q * 8) * 72 + rr;
#pragma unroll
        for (int e = 0; e < 8; ++e) { kt[e * 72] = (bf16_t)f2bf(kf[e]); kb[e * 72] = (bf16_t)f2bf(kf[e] * be); vt[e * 72] = (bf16_t)f2bf(vf[e] * bt); }
    }
    LDS_BARRIER();
    float* As = (float*)(smem + PR_AS); float* Ts = (float*)(smem + PR_TS);
#pragma unroll
    for (int tt = 0; tt < 2; ++tt) {
        const int t = wid * 2 + tt, mt = t >> 2, nt = t & 3;
        f32x4 kk = {0.f, 0.f, 0.f, 0.f}, qk = {0.f, 0.f, 0.f, 0.f};
#pragma unroll
        for (int ks = 0; ks < 4; ++ks) {
            const bf16x8 am = ldf16(smem + PR_K + (mt * 16 + fr) * 272 + ks * 64 + fq * 16);
            const bf16x8 bk = ldf16(smem + PR_K + (nt * 16 + fr) * 272 + ks * 64 + fq * 16);
            const bf16x8 bq = ldf16(smem + PR_Q + (nt * 16 + fr) * 272 + ks * 64 + fq * 16);
            kk = mfma16(am, bk, kk); qk = mfma16(am, bq, qk);
        }
        const int i = nt * 16 + fr; const float gi = gc[i], bi = beta[i];
        f32x4 av; u32x2 qw; float qv[4];
#pragma unroll
        for (int j4 = 0; j4 < 4; ++j4) { const int j = mt * 16 + fq * 4 + j4; const float dg = gi - gc[j];
            av[j4] = (i > j) ? bi * kk[j4] * expf(dg) : 0.f; qv[j4] = (i >= j) ? qk[j4] * expf(dg) : 0.f; }
        *(f32x4*)(As + i * 68 + mt * 16 + fq * 4) = av;
        qw.x = pk2(qv[0], qv[1]); qw.y = pk2(qv[2], qv[3]);
        *(u32x2*)(rec + REC_QK + (i * 64 + (mt >> 1) * 32 + fq * 8 + (mt & 1) * 4) * 2) = qw;
    }
    LDS_BARRIER();
    if (wid == 0) {
        const int bI = lane >> 4, c = lane & 15; float x[16];
#pragma unroll
        for (int i = 0; i < 16; ++i) { float sacc = (i == c) ? 1.f : 0.f; const float* ar = As + (bI * 16 + i) * 68 + bI * 16;
#pragma unroll
            for (int j = 0; j < i; ++j) sacc -= ar[j] * x[j];
            x[i] = sacc; }
#pragma unroll
        for (int i = 0; i < 16; ++i) Ts[(bI * 16 + i) * 68 + bI * 16 + c] = x[i];
    }
    LDS_BARRIER();
    { float* scr = (float*)(smem + PR_TB) + wid * 16 * 17;
#pragma unroll
      for (int bI = 1; bI < 4; ++bI) {
          if (wid < bI) { const int bJ = wid; f32x4 racc = {0.f, 0.f, 0.f, 0.f};
              for (int bK = bJ; bK < bI; ++bK) {
#pragma unroll
                  for (int kk = 0; kk < 4; ++kk) { const float av = As[(bI * 16 + fr) * 68 + bK * 16 + kk * 4 + fq], bv = Ts[(bK * 16 + kk * 4 + fq) * 68 + bJ * 16 + fr];
                      racc = __builtin_amdgcn_mfma_f32_16x16x4f32(av, bv, racc, 0, 0, 0); } }
#pragma unroll
              for (int j = 0; j < 4; ++j) scr[(fq * 4 + j) * 17 + fr] = racc[j];
              asm volatile("s_waitcnt lgkmcnt(0)" ::: "memory"); __builtin_amdgcn_wave_barrier();
              f32x4 tacc = {0.f, 0.f, 0.f, 0.f};
#pragma unroll
              for (int kk = 0; kk < 4; ++kk) { const float av = Ts[(bI * 16 + fr) * 68 + bI * 16 + kk * 4 + fq], bv = scr[(kk * 4 + fq) * 17 + fr];
                  tacc = __builtin_amdgcn_mfma_f32_16x16x4f32(av, bv, tacc, 0, 0, 0); }
#pragma unroll
              for (int j = 0; j < 4; ++j) Ts[(bI * 16 + fq * 4 + j) * 68 + bJ * 16 + fr] = -tacc[j];
          }
          LDS_BARRIER();
      } }
    for (int idx = tid; idx < 2048; idx += 512) { const int i = idx >> 5, j2 = (idx & 31) * 2; const bool up = (j2 >> 4) > (i >> 4);
        *(unsigned*)(smem + PR_TB + i * 144 + j2 * 2) = up ? 0u : pk2(Ts[i * 68 + j2], Ts[i * 68 + j2 + 1]); }
    LDS_BARRIER();
#pragma unroll
    for (int tt = 0; tt < 4; ++tt) {
        const int t = wid * 4 + tt;
        { const int ct = t & 3, et = t >> 2; f32x4 acc = {0.f, 0.f, 0.f, 0.f};
#pragma unroll
          for (int ks = 0; ks < 2; ++ks) acc = mfma16(ldf16(smem + PR_TB + (ct * 16 + fr) * 144 + ks * 64 + fq * 16), ldf16(smem + PR_VT + (et * 16 + fr) * 144 + ks * 64 + fq * 16), acc);
          u32x2 w; w.x = pk2(acc[0], acc[1]); w.y = pk2(acc[2], acc[3]);
          *(u32x2*)(rec + REC_UT + ((et * 16 + fr) * 64 + ct * 16 + fq * 4) * 2) = w; }
        { const int ct = t & 3, dt = t >> 2; f32x4 acc = {0.f, 0.f, 0.f, 0.f};
#pragma unroll
          for (int ks = 0; ks < 2; ++ks) acc = mfma16(ldf16(smem + PR_KB + (dt * 16 + fr) * 144 + ks * 64 + fq * 16), ldf16(smem + PR_TB + (ct * 16 + fr) * 144 + ks * 64 + fq * 16), acc);
          u32x2 w; w.x = pk2(acc[0], acc[1]); w.y = pk2(acc[2], acc[3]);
          *(u32x2*)(rec + REC_W + ((ct * 16 + fr) * 128 + (dt >> 1) * 32 + fq * 8 + (dt & 1) * 4) * 2) = w; }
    }
    const float glast = gc[63];
    for (int idx = tid; idx < 1024; idx += 512) {
        { const int rr = idx >> 4, q = idx & 15; float f[8]; unpack8(*(const u32x4*)(smem + PR_Q + rr * 272 + q * 16), f); const float e = expf(gc[rr]);
#pragma unroll
          for (int j = 0; j < 8; ++j) f[j] *= e;
          const int p0 = (q >> 2) * 32 + ((q >> 1) & 1) * 4; u32x2 w0, w1; w0.x = pk2(f[0], f[1]); w0.y = pk2(f[2], f[3]); w1.x = pk2(f[4], f[5]); w1.y = pk2(f[6], f[7]);
          *(u32x2*)(rec + REC_QG + (rr * 128 + p0 + ((2 * q) & 3) * 8) * 2) = w0; *(u32x2*)(rec + REC_QG + (rr * 128 + p0 + ((2 * q + 1) & 3) * 8) * 2) = w1; }
        { const int d = idx >> 3, q = idx & 7; float f[8]; unpack8(*(const u32x4*)(smem + PR_KT + d * 144 + q * 16), f);
#pragma unroll
          for (int j = 0; j < 8; ++j) f[j] *= expf(glast - gc[q * 8 + j]);
          const int p0 = (q >> 2) * 32 + ((q >> 1) & 1) * 4; u32x2 w0, w1; w0.x = pk2(f[0], f[1]); w0.y = pk2(f[2], f[3]); w1.x = pk2(f[4], f[5]); w1.y = pk2(f[6], f[7]);
          *(u32x2*)(rec + REC_KTT + (d * 64 + p0 + ((2 * q) & 3) * 8) * 2) = w0; *(u32x2*)(rec + REC_KTT + (d * 64 + p0 + ((2 * q + 1) & 3) * 8) * 2) = w1; }
    }
    LDS_BARRIER();
}
DI void phase3b(const Args& a, char* smem) {
    const int G = (int)gridDim.x; int r = (int)blockIdx.x;
    PrepIn cur, nxt;
    if (r < NREC) prep_load(a, r, cur);
    for (; r < NREC; r += G) {
        if (r + G < NREC) prep_load(a, r + G, nxt);
        prep_unit(a, smem, r, cur);
        cur = nxt;
    }
}

constexpr int SC_W = 0, SC_QG = 18432, SC_KTT = 36864, SC_QK = 57344, SC_UT = 67584, SC_EGL = 70144, SC_BUF = 70160, SC_NP = 3712, SC_OST = 2 * 70160;
DI int scan_rec(int b, int h, int dir, int step) { return ((b * 4 + h) * 2 + dir) * 260 + step; }
#define SC_BARRIER() do { asm volatile("s_waitcnt lgkmcnt(0)" ::: "memory"); __builtin_amdgcn_s_barrier(); asm volatile("" ::: "memory"); } while (0)
DI void scan_unit(const Args& a, char* smem, int u) {
    const int sl = u & 7, chain = u >> 3, dir = chain & 1, h = (chain >> 1) & 3, b = chain >> 3, e0 = sl * 16;
    const int tid = tidx(), lane = tid & 63, wid = __builtin_amdgcn_readfirstlane(tid >> 6), fr = lane & 15, fq = lane >> 4;
    const float* EGL = (const float*)(a.ws + OFF_EGL);
    bf16_t* Ob = (bf16_t*)(a.ws + OFF_O) + (size_t)dir * NLAT * 512;
    constexpr int NSTEP = 260;
    if (wid == 0) {
        f32x4 S[8];
#pragma unroll
        for (int i = 0; i < 8; ++i) S[i] = (f32x4){0.f, 0.f, 0.f, 0.f};
        for (int step = -1; step <= NSTEP; ++step) {
            if (step >= 0 && step < NSTEP) {
                const char* buf = smem + (step & 1) * SC_BUF;
                const float egl = *(const float*)(buf + SC_EGL);
                if (sl == 0 && lane == 0) __hip_atomic_store((unsigned*)(a.ws + OFF_PROG) + chain * 16, (unsigned)step, __ATOMIC_RELAXED, __HIP_MEMORY_SCOPE_AGENT);
                const char* pw = buf + SC_W + fr * 288 + fq * 16; const char* pq = buf + SC_QG + fr * 288 + fq * 16;
                const char* pk = buf + SC_QK + fr * 160 + fq * 16; const char* pt = buf + SC_KTT + fr * 160 + fq * 16;
                bf16x8 fa[8], fb[8];
#define LD_WQ(F, ct) do { _Pragma("unroll") for (int kk = 0; kk < 4; ++kk) { F[kk] = ldf16(pw + (ct) * 16 * 288 + kk * 64); F[4 + kk] = ldf16(pq + (ct) * 16 * 288 + kk * 64); } } while (0)
#define LD_QK(F) do { _Pragma("unroll") for (int ct = 0; ct < 4; ++ct) { F[2 * ct] = ldf16(pk + ct * 16 * 160); F[2 * ct + 1] = ldf16(pk + ct * 16 * 160 + 64); } } while (0)
#define LD_KT(F, d0) do { _Pragma("unroll") for (int dd = 0; dd < 4; ++dd) { F[2 * dd] = ldf16(pt + ((d0) + dd) * 16 * 160); F[2 * dd + 1] = ldf16(pt + ((d0) + dd) * 16 * 160 + 64); } } while (0)
#define MM_WQ(F, ct) do { f32x4 acc = {0.f, 0.f, 0.f, 0.f}, accq = {0.f, 0.f, 0.f, 0.f}; \
        _Pragma("unroll") for (int kk = 0; kk < 4; ++kk) { acc = mfma16(F[kk], Sb[kk], acc); accq = mfma16(F[4 + kk], Sb[kk], accq); } \
        vn[ct][0] = bflo(uu[ct].x) - acc[0]; vn[ct][1] = bfhi(uu[ct].x) - acc[1]; vn[ct][2] = bflo(uu[ct].y) - acc[2]; vn[ct][3] = bfhi(uu[ct].y) - acc[3]; oo[ct] = accq; } while (0)
                LD_WQ(fa, 0);
                u32x2 uu[4];
#pragma unroll
                for (int ct = 0; ct < 4; ++ct) uu[ct] = *(const u32x2*)(buf + SC_UT + fr * 160 + (ct * 16 + fq * 4) * 2);
                bf16x8 Sb[4];
#pragma unroll
                for (int kk = 0; kk < 4; ++kk) Sb[kk] = pack2(S[2 * kk], S[2 * kk + 1]);
                f32x4 vn[4], oo[4];
                LD_WQ(fb, 1); __builtin_amdgcn_sched_barrier(0);
                MM_WQ(fa, 0); __builtin_amdgcn_sched_barrier(0);
                LD_WQ(fa, 2); __builtin_amdgcn_sched_barrier(0);
                MM_WQ(fb, 1); __builtin_amdgcn_sched_barrier(0);
                LD_WQ(fb, 3); __builtin_amdgcn_sched_barrier(0);
                MM_WQ(fa, 2); __builtin_amdgcn_sched_barrier(0);
                LD_QK(fa); __builtin_amdgcn_sched_barrier(0);
                MM_WQ(fb, 3); __builtin_amdgcn_sched_barrier(0);
                LD_KT(fb, 0); __builtin_amdgcn_sched_barrier(0);
                bf16x8 Vb[2]; Vb[0] = pack2(vn[0], vn[1]); Vb[1] = pack2(vn[2], vn[3]);
#pragma unroll
                for (int ct = 0; ct < 4; ++ct) { oo[ct] = mfma16(fa[2 * ct], Vb[0], oo[ct]); oo[ct] = mfma16(fa[2 * ct + 1], Vb[1], oo[ct]); }
                __builtin_amdgcn_sched_barrier(0);
                LD_KT(fa, 4); __builtin_amdgcn_sched_barrier(0);
#pragma unroll
                for (int dd = 0; dd < 4; ++dd) { S[dd] = S[dd] * egl; S[dd] = mfma16(fb[2 * dd], Vb[0], S[dd]); S[dd] = mfma16(fb[2 * dd + 1], Vb[1], S[dd]); }
                __builtin_amdgcn_sched_barrier(0);
#pragma unroll
                for (int dd = 0; dd < 4; ++dd) { S[4 + dd] = S[4 + dd] * egl; S[4 + dd] = mfma16(fa[2 * dd], Vb[0], S[4 + dd]); S[4 + dd] = mfma16(fa[2 * dd + 1], Vb[1], S[4 + dd]); }
#undef LD_WQ
#undef LD_QK
#undef LD_KT
#undef MM_WQ
                if (step >= 4) { bf16_t* ost = (bf16_t*)(smem + SC_OST + (step & 1) * 2048);
#pragma unroll
                    for (int ct = 0; ct < 4; ++ct) { const unsigned w0 = pk2(oo[ct][0], oo[ct][1]), w1 = pk2(oo[ct][2], oo[ct][3]); const int c0 = ct * 16 + fq * 4;
                        ost[(c0 + 0) * 16 + fr] = (bf16_t)(w0 & 0xffff); ost[(c0 + 1) * 16 + fr] = (bf16_t)(w0 >> 16); ost[(c0 + 2) * 16 + fr] = (bf16_t)(w1 & 0xffff); ost[(c0 + 3) * 16 + fr] = (bf16_t)(w1 >> 16); }
                }
            }
            SC_BARRIER();
        }
    } else {
        u32x4 tA[9], tB[9], tC[9]; float eA = 0.f, eB = 0.f, eC = 0.f;
#define SC_LOAD(T, E, st) do { const int rn_ = scan_rec(b, h, dir, (st)); const unsigned char* rec_ = rec_ptr(a, rn_); \
        _Pragma("unroll") for (int it = 0; it < 9; ++it) { const int p = tid - 64 + it * 448; \
            if (p < SC_NP) { const unsigned char* src = p < 3584 ? rec_ + p * 16 : rec_ + REC_UT + e0 * 128 + (p - 3584) * 16; T[it] = *(const u32x4*)src; } } \
        if (tid == 64) E = EGL[rn_]; } while (0)
#define SC_WRITE(T, E, st) do { char* buf_ = smem + ((st) & 1) * SC_BUF; if (tid == 64) *(float*)(buf_ + SC_EGL) = E; \
        _Pragma("unroll") for (int it = 0; it < 9; ++it) { const int p = tid - 64 + it * 448; \
            if (p < SC_NP) { int off; \
                if (p < 2048) off = (p >> 10) * 18432 + ((p & 1023) >> 4) * 288 + (p & 15) * 16; \
                else if (p < 3584) { const int q = p - 2048; off = SC_KTT + (q >> 3) * 160 + (q & 7) * 16; } \
                else { const int q = p - 3584; off = SC_UT + (q >> 3) * 160 + (q & 7) * 16; } \
                *(u32x4*)(buf_ + off) = T[it]; } } } while (0)
#define SC_ITER(T, E, st) do { if ((st) <= NSTEP) { \
        if ((st) + 1 < NSTEP) SC_WRITE(T, E, (st) + 1); \
        if ((st) - 1 >= 4 && (st) - 1 < NSTEP && tid < 192) { const int ps = (st) - 1, n = ps - 4, chunk = dir ? 255 - n : n; const int q = tid - 64, c = q >> 1, hf = q & 1; \
            const size_t tok = (size_t)b * SEQL + chunk * 64 + (dir ? 63 - c : c); \
            *(u32x4*)(Ob + tok * 512 + h * 128 + e0 + hf * 8) = *(const u32x4*)(smem + SC_OST + (ps & 1) * 2048 + c * 32 + hf * 16); } \
        if ((st) + 4 < NSTEP) SC_LOAD(T, E, (st) + 4); \
        SC_BARRIER(); } } while (0)
        SC_LOAD(tA, eA, 0); SC_LOAD(tB, eB, 1); SC_LOAD(tC, eC, 2);
        for (int st = -1; st <= NSTEP; st += 3) { SC_ITER(tA, eA, st); SC_ITER(tB, eB, st + 1); SC_ITER(tC, eC, st + 2); }
#undef SC_ITER
#undef SC_WRITE
#undef SC_LOAD
    }
}
constexpr int SC_LEAD = 12;
DI void scan_prefetch(const Args& a, int chain, int phase_, int nph) {
    const int tid = tidx(); unsigned acc = 0u;
    unsigned* prog = (unsigned*)(a.ws + OFF_PROG) + chain * 16; int budget = 8192;
    for (int step = phase_; step < 260; step += nph) {
        while (budget > 0 && (int)__hip_atomic_load(prog, __ATOMIC_RELAXED, __HIP_MEMORY_SCOPE_AGENT) + SC_LEAD < step) { __builtin_amdgcn_s_sleep(8); --budget; }
        const unsigned char* rec = rec_ptr(a, chain * 260 + step);
        u32x4 v[9];
#pragma unroll
        for (int it = 0; it < 9; ++it) v[it] = *(const u32x4*)(rec + (size_t)(tid + it * 512) * 16);
#pragma unroll
        for (int it = 0; it < 9; ++it) acc ^= v[it].x ^ v[it].y ^ v[it].z ^ v[it].w;
    }
    if (acc == 0x9e3779b9u) ((unsigned*)(a.ws))[tid] = acc;
}
DI void phase4(const Args& a, char* smem) {
    const int G = (int)gridDim.x, NS = G >= 256 ? 128 : (G >= 2 ? G / 2 : 0), NPF = G >= 256 ? 32 : 0;
    if (NS == 0) { for (int u = 0; u < 128; ++u) scan_unit(a, smem, u);
        { const u32x4* src = (const u32x4*)(a.ws + OFF_ROPE); u32x4* dst = (u32x4*)(smem + AT_ROPE); for (int i = tidx(); i < 2048; i += 512) dst[i] = src[i]; } __syncthreads();
        for (int u = 0; u < N_ATT_UNITS; ++u) attn_unit(a, smem, u);
        __syncthreads(); for (int g = P0_WT_EARLY; g < P0_WT_GROUPS; ++g) p0_wt_group(a, smem, g); return; }
    if ((int)blockIdx.x < NS) {
        if (NS == 128) { const int blk = (int)blockIdx.x, xcd = blk & 7, j = blk >> 3; scan_unit(a, smem, ((xcd * 2 + (j >> 3)) << 3) | (j & 7)); }
        else for (int u = blockIdx.x; u < 128; u += NS) scan_unit(a, smem, u); }
    else if ((int)blockIdx.x < NS + NPF) { const int p = (int)blockIdx.x - NS, xcd = p & 7, j = p >> 3;
        scan_prefetch(a, xcd * 2 + (j & 1), j >> 1, 2); }
    else { const int NA = G - NS - NPF, ab = (int)blockIdx.x - NS - NPF;
        { const u32x4* src = (const u32x4*)(a.ws + OFF_ROPE); u32x4* dst = (u32x4*)(smem + AT_ROPE); for (int i = tidx(); i < 2048; i += 512) dst[i] = src[i]; }
        __syncthreads();
        for (int u = ab; u < N_ATT_UNITS; u += NA) attn_unit(a, smem, u);
        __syncthreads(); for (int g = P0_WT_EARLY + ab; g < P0_WT_GROUPS; g += NA) p0_wt_group(a, smem, g); }
}

DI void phase5(const Args& a) {
    const int lane = tidx() & 63, wid = tidx() >> 6;
    const bf16_t* Of = (const bf16_t*)(a.ws + OFF_O); const bf16_t* Obk = Of + (size_t)NLAT * 512; const bf16_t* Z = (const bf16_t*)(a.ws + OFF_Z);
    bf16_t* MIX = (bf16_t*)(a.ws + OFF_H);
    float ng[8];
#pragma unroll
    for (int e = 0; e < 8; ++e) ng[e] = a.gdn_norm_g[(lane & 15) * 8 + e];
    const int rs = (int)gridDim.x * 8;
    u32x4 nf, nb, nz;
    { const int row0 = blockIdx.x * 8 + wid; if (row0 < NLAT) { nf = *(const u32x4*)(Of + (size_t)row0 * 512 + lane * 8); nb = *(const u32x4*)(Obk + (size_t)row0 * 512 + lane * 8); nz = *(const u32x4*)(Z + (size_t)row0 * 512 + lane * 8); } }
    for (int row = blockIdx.x * 8 + wid; row < NLAT; row += rs) {
        float of[8], ob[8], z[8];
        unpack8(nf, of); unpack8(nb, ob); unpack8(nz, z);
        { const int nrow = row + rs; if (nrow < NLAT) { nf = *(const u32x4*)(Of + (size_t)nrow * 512 + lane * 8); nb = *(const u32x4*)(Obk + (size_t)nrow * 512 + lane * 8); nz = *(const u32x4*)(Z + (size_t)nrow * 512 + lane * 8); } }
        float ss = 0.f;
#pragma unroll
        for (int e = 0; e < 8; ++e) { of[e] += ob[e]; ss += of[e] * of[e]; }
        ss += __shfl_xor(ss, 1); ss += __shfl_xor(ss, 2); ss += __shfl_xor(ss, 4); ss += __shfl_xor(ss, 8);
        const float r = rsqrtf(ss * (1.f / 128.f) + EPS);
#pragma unroll
        for (int e = 0; e < 8; ++e) of[e] = of[e] * r * ng[e] * siluf(z[e]);
        *(u32x4*)(MIX + (size_t)row * DM + 512 + lane * 8) = pack8(of);
    }
}

template <bool IN_F32, bool OUT_F32> DI void rowpass(const Args& a, const void* xin_v, void* xout_v, const float* gate_base, int gate_bstride, const float* post_g,
                const float* next_g, const float* nsh_base, const float* nsc_base, int n_bstride, bool has_next) {
    const int lane = tidx() & 63, wid = tidx() >> 6;
    const bf16_t* Y = (const bf16_t*)(a.ws + OFF_Y); const float* SSQ = (const float*)(a.ws + OFF_SSQ); bf16_t* H = (bf16_t*)(a.ws + OFF_H);
    const int rs = (int)gridDim.x * 8;
    const float* xin = (const float*)xin_v; const bf16_t* xin16 = (const bf16_t*)xin_v; float* xout = (float*)xout_v; bf16_t* xout16 = (bf16_t*)xout_v;
    f32x4 xA[4], xB[4], xC[4]; u32x2 bA[4], bB[4], bC[4], yA[4], yB[4], yC[4]; float sA = 0.f, sB = 0.f, sC = 0.f;
#define RP_LOAD(XF, XB, Yv, S, r) do { _Pragma("unroll") for (int i = 0; i < 4; ++i) { const int k = i * 256 + lane * 4; \
        if constexpr (IN_F32) XF[i] = *(const f32x4*)(xin + (size_t)(r) * DM + k); else XB[i] = *(const u32x2*)(xin16 + (size_t)(r) * DM + k); \
        Yv[i] = *(const u32x2*)(Y + (size_t)(r) * DM + k); } \
        S = lane < 16 ? SSQ[(size_t)(r) * 16 + lane] : 0.f; } while (0)
    f32x4 gp[4], n1[4], n0[4]; int cur_b = -1;
#define RP_PARAMS(b) do { const float* gate = gate_base + (size_t)(b) * gate_bstride; \
        _Pragma("unroll") for (int i = 0; i < 4; ++i) { const int k = i * 256 + lane * 4; const f32x4 gv = *(const f32x4*)(gate + k), pg = *(const f32x4*)(post_g + k); gp[i] = gv * pg; \
            if (has_next) { const f32x4 g = *(const f32x4*)(next_g + k), s1 = *(const f32x4*)(nsh_base + (size_t)(b) * n_bstride + k), c1 = *(const f32x4*)(nsc_base + (size_t)(b) * n_bstride + k); \
                n1[i] = g * (c1 + 1.f); n0[i] = s1; } } } while (0)
#define RP_COMP(XF, XB, Yv, S, row) do { \
        const int b = (row) / SEQL; if (b != cur_b) { RP_PARAMS(b); cur_b = b; } \
        const float ry = rsqrtf(wave_sum(S) * (1.f / 1024.f) + EPS); \
        f32x4 v[4]; float ss = 0.f; \
        _Pragma("unroll") for (int i = 0; i < 4; ++i) { const int k = i * 256 + lane * 4; \
            const f32x4 yv = {bflo(Yv[i].x), bfhi(Yv[i].x), bflo(Yv[i].y), bfhi(Yv[i].y)}; \
            f32x4 xv; if constexpr (IN_F32) xv = XF[i]; else xv = (f32x4){bflo(XB[i].x), bfhi(XB[i].x), bflo(XB[i].y), bfhi(XB[i].y)}; \
            _Pragma("unroll") for (int e = 0; e < 4; ++e) { v[i][e] = xv[e] + gp[i][e] * (yv[e] * ry); ss += v[i][e] * v[i][e]; } \
            if constexpr (OUT_F32) *(f32x4*)(xout + (size_t)(row) * DM + k) = v[i]; else { u32x2 xw; xw.x = pk2(v[i][0], v[i][1]); xw.y = pk2(v[i][2], v[i][3]); *(u32x2*)(xout16 + (size_t)(row) * DM + k) = xw; } } \
        if (has_next) { \
            ss = wave_sum(ss); const float r = rsqrtf(ss * (1.f / 1024.f) + EPS); \
            _Pragma("unroll") for (int i = 0; i < 4; ++i) { const int k = i * 256 + lane * 4; float o[4]; \
                _Pragma("unroll") for (int e = 0; e < 4; ++e) o[e] = v[i][e] * r * n1[i][e] + n0[i][e]; \
                u32x2 w; w.x = pk2(o[0], o[1]); w.y = pk2(o[2], o[3]); *(u32x2*)(H + (size_t)(row) * DM + k) = w; } } } while (0)
    const int r0 = blockIdx.x * 8 + wid;
    if (r0 < NLAT) RP_LOAD(xA, bA, yA, sA, r0);
    if (r0 + rs < NLAT) RP_LOAD(xB, bB, yB, sB, r0 + rs);
    if (r0 + 2 * rs < NLAT) RP_LOAD(xC, bC, yC, sC, r0 + 2 * rs);
    for (int row = r0; row < NLAT; row += 3 * rs) {
        RP_COMP(xA, bA, yA, sA, row); if (row + 3 * rs < NLAT) RP_LOAD(xA, bA, yA, sA, row + 3 * rs);
        if (row + rs < NLAT) { RP_COMP(xB, bB, yB, sB, row + rs); if (row + 4 * rs < NLAT) RP_LOAD(xB, bB, yB, sB, row + 4 * rs); }
        if (row + 2 * rs < NLAT) { RP_COMP(xC, bC, yC, sC, row + 2 * rs); if (row + 5 * rs < NLAT) RP_LOAD(xC, bC, yC, sC, row + 5 * rs); }
    }
#undef RP_LOAD
#undef RP_COMP
#undef RP_PARAMS
}

DI void phase12(const Args& a) {
    const int lane = tidx() & 63, wid = tidx() >> 6;
    const bf16_t* CU = (const bf16_t*)(a.ws + OFF_BIG); const bf16_t* BG = CU + (size_t)NLAT * DM; bf16_t* MIX = (bf16_t*)(a.ws + OFF_H);
    float w0[2][8], w1[2][8], w2[2][8];
#pragma unroll
    for (int part = 0; part < 2; ++part)
#pragma unroll
        for (int e = 0; e < 8; ++e) { const int ch = part * 512 + lane * 8 + e; w0[part][e] = a.sc_conv_w[ch]; w1[part][e] = a.sc_conv_w[1024 + ch]; w2[part][e] = a.sc_conv_w[2048 + ch]; }
    const u32x4 zero4 = {0u, 0u, 0u, 0u};
    for (int blk = blockIdx.x * 8 + wid; blk < NLAT / 16; blk += gridDim.x * 8) {
        const int r0 = blk * 16, t0 = r0 & (SEQL - 1);
        u32x4 xp[2], xc[2], xn[2], xnn[2], bg[2], bgn[2], bgnn[2];
#pragma unroll
        for (int part = 0; part < 2; ++part) { const bf16_t* p = CU + (size_t)r0 * DM + part * 512 + lane * 8; const bf16_t* pb = BG + (size_t)r0 * DM + part * 512 + lane * 8;
            xc[part] = *(const u32x4*)p; xp[part] = t0 > 0 ? *(const u32x4*)(p - DM) : zero4; xn[part] = t0 + 1 < SEQL ? *(const u32x4*)(p + DM) : zero4;
            bg[part] = *(const u32x4*)pb; bgn[part] = *(const u32x4*)(pb + DM); }
        for (int i = 0; i < 16; ++i) {
            const int row = r0 + i, t = t0 + i;
#pragma unroll
            for (int part = 0; part < 2; ++part) { xnn[part] = (i < 15 && t + 2 < SEQL) ? *(const u32x4*)(CU + (size_t)(row + 2) * DM + part * 512 + lane * 8) : zero4;
                bgnn[part] = i < 14 ? *(const u32x4*)(BG + (size_t)(row + 2) * DM + part * 512 + lane * 8) : zero4; }
#pragma unroll
            for (int part = 0; part < 2; ++part) {
                float fc[8], fp[8], fn[8], fb[8], o[8]; unpack8(xc[part], fc); unpack8(xp[part], fp); unpack8(xn[part], fn); unpack8(bg[part], fb);
#pragma unroll
                for (int e = 0; e < 8; ++e) o[e] = fb[e] * (w0[part][e] * fp[e] + w1[part][e] * fc[e] + w2[part][e] * fn[e]);
                *(u32x4*)(MIX + (size_t)row * DM + part * 512 + lane * 8) = pack8(o);
            }
#pragma unroll
            for (int part = 0; part < 2; ++part) { xp[part] = xc[part]; xc[part] = xn[part]; xn[part] = xnn[part]; bg[part] = bgn[part]; bgn[part] = bgnn[part]; }
        }
    }
}

#ifndef ONLY_PH
#define ONLY_PH -1
#endif
#define PHASE_ON(n) ((ONLY_PH) < 0 || (ONLY_PH) == (n))
constexpr int N_PHASES = 18;
__global__ void __launch_bounds__(512, 2) fwd_megakernel(Args a) {
    extern __shared__ __attribute__((aligned(16))) char smem[];
    cg::grid_group grid = cg::this_grid();
    const float* MOD = (const float*)(a.ws + OFF_MOD);
    const bf16_t* WT = (const bf16_t*)(a.ws + OFF_WT);
    bf16_t* H = (bf16_t*)(a.ws + OFF_H);
    bf16_t* BIG = (bf16_t*)(a.ws + OFF_BIG);
    bf16_t* Y = (bf16_t*)(a.ws + OFF_Y); float* SSQ = (float*)(a.ws + OFF_SSQ);
    const int lo = a.ph_lo, hi = a.ph_hi;
#define IN(k) (PHASE_ON(k) && lo <= (k) && (k) < hi)
#define SEAM(k) do { if (lo <= (k) && (k) + 1 < hi) grid.sync(); } while (0)
#ifndef DBL
#define DBL 0u
#endif
#ifndef XSYNC
#define XSYNC 0
#endif
#define PH(k, ...) do { if (IN(k)) { __VA_ARGS__; if (((DBL) >> (k)) & 1u) { grid.sync(); __VA_ARGS__; } } SEAM(k); } while (0)
    PH(0, phase0(a, smem););
    PH(1, phase1(a, smem););
    PH(2, { EpiProj E; E.AT = (bf16_t*)((unsigned char*)a.out + OUT_ATT); E.P = BIG; E.Z = (bf16_t*)(a.ws + OFF_Z); run_gemm(smem, H, WT + WT_IN, MROWS, NPROJ, 1024, E); });
    PH(3, phase3a(a, smem););
    PH(4, phase3b(a, smem););
    PH(5, phase4(a, smem););
    PH(6, phase5(a););
    PH(7, { EpiY E; E.Y = Y; E.SSQ = SSQ; run_gemm(smem, H, WT + WT_OUT, NLAT, 1024, 1024, E); });
    PH(8, rowpass<true, false>(a, a.x, a.ws + OFF_X16, MOD + 2 * 1024, 6144, a.post_mix_g, a.pre_ffn_g, MOD + 3 * 1024, MOD + 4 * 1024, 6144, true););
    PH(9, { EpiAct E; E.O = BIG; run_gemm(smem, H, WT + WT_GU0, NLAT, 5632, 1024, E); });
    PH(10, { EpiY E; E.Y = Y; E.SSQ = SSQ; run_gemm(smem, BIG, WT + WT_DN0, NLAT, 1024, FF, E); });
    PH(11, rowpass<false, false>(a, a.ws + OFF_X16, a.ws + OFF_X16, MOD + 5 * 1024, 6144, a.post_ffn_g, a.pre_mix_g + 1024, MOD + 3 * 6144 + 0 * 1024, MOD + 3 * 6144 + 1 * 1024, 6144, true););
    PH(12, { EpiSc E; E.CU = BIG; E.BG = BIG + (size_t)NLAT * DM; run_gemm(smem, H, WT + WT_SCIN, NLAT, 3072, 1024, E); });
    PH(13, phase12(a););
    PH(14, { EpiY E; E.Y = Y; E.SSQ = SSQ; run_gemm(smem, H, WT + WT_SCOUT, NLAT, 1024, 1024, E); });
    PH(15, rowpass<false, false>(a, a.ws + OFF_X16, a.ws + OFF_X16, MOD + 3 * 6144 + 2 * 1024, 6144, a.post_mix_g + 1024, a.pre_ffn_g + 1024, MOD + 3 * 6144 + 3 * 1024, MOD + 3 * 6144 + 4 * 1024, 6144, true););
    PH(16, { EpiAct E; E.O = BIG; run_gemm(smem, H, WT + WT_GU1, NLAT, 5632, 1024, E); });
    PH(17, { EpiY E; E.Y = Y; E.SSQ = SSQ; run_gemm(smem, BIG, WT + WT_DN1, NLAT, 1024, FF, E); });
    PH(18, rowpass<false, true>(a, a.ws + OFF_X16, a.out, MOD + 3 * 6144 + 5 * 1024, 6144, a.post_ffn_g + 1024, nullptr, nullptr, nullptr, 0, false););
}

extern "C" void kernel_launch(void* const* d_in, const int* in_sizes, int n_in, void* d_out, int out_size, void* d_ws, size_t ws_size, hipStream_t stream) {
    static int grid = 0;
    if (grid == 0) {
        if (n_in != 23 || ws_size < WS_NEED) { fprintf(stderr, "kernel_launch: unexpected n_in %d / ws %zu\n", n_in, ws_size); grid = -1; return; }
        int dev = 0, cus = 0, per_cu = 0;
        hipGetDevice(&dev); hipDeviceGetAttribute(&cus, hipDeviceAttributeMultiprocessorCount, dev);
        hipFuncSetAttribute((const void*)fwd_megakernel, hipFuncAttributeMaxDynamicSharedMemorySize, LDS_BYTES);
        hipOccupancyMaxActiveBlocksPerMultiprocessor(&per_cu, (const void*)fwd_megakernel, 512, LDS_BYTES);
        if (per_cu < 1) { fprintf(stderr, "kernel_launch: occupancy query says %d blocks/CU\n", per_cu); per_cu = 1; }
        grid = cus * 1;
        (void)hipGetLastError();
    }
    if (grid < 0) return;
    Args a{};
    const float** f = (const float**)&a;
    for (int i = 0; i < 23; ++i) f[i] = (const float*)d_in[i];
    a.out = (float*)d_out; a.ws = (unsigned char*)d_ws; a.ph_lo = 0; a.ph_hi = N_PHASES + 1;
    void* args[] = {&a};
    hipError_t e = hipLaunchCooperativeKernel((const void*)fwd_megakernel, dim3(grid), dim3(512), args, LDS_BYTES, stream);
    if (e != hipSuccess) fprintf(stderr, "cooperative launch failed: %s (grid %d)\n", hipGetErrorString(e), grid);
}
```

```cpp
#include <hip/hip_runtime.h>
#include <hip/hip_cooperative_groups.h>
#include <cstdio>
#include <cstdint>
namespace cg = cooperative_groups;

__device__ __forceinline__ int tidx() { int t = (int)threadIdx.x; asm volatile("" : "+v"(t)); return t & 511; }
namespace pg8 {
#define PG8_LAS __attribute__((address_space(3)))
typedef unsigned short bf16_t;
typedef short bf16x8 __attribute__((ext_vector_type(8)));
typedef float f32x4 __attribute__((ext_vector_type(4)));
typedef unsigned u32x4 __attribute__((ext_vector_type(4)));
constexpr int BM = 256, BK = 64, HALF = 128, HTB = HALF * BK * 2  , STAGE_BYTES = 8 * HTB, NXCD = 8, WGM = 8;

__host__ __device__ __forceinline__ int lds_byte(int r, int c) { const int st = (r >> 4) * 2 + (c >> 5), rr = r & 15, cc = c & 31, ob = rr * 64 + cc * 2; return st * 1024 + (ob ^ (((ob >> 9) & 1) << 5)); }
__host__ __device__ __forceinline__ void stage_rc(int b, int& R, int& C) { const int st = b / 1024, sb = b % 1024, swz = sb ^ (((sb >> 9) & 1) << 5); R = (st >> 1) * 16 + swz / 64; C = (st & 1) * 32 + (swz % 64) / 2; }
__host__ __device__ __forceinline__ int perm32(int rho) { const int n = rho >> 4, i = rho & 15; return 8 * (i >> 2) + 4 * n + (i & 3); }

struct Unit { int pm, pn; };
struct Gemm { const bf16_t* A; const bf16_t* Bt; int M, N, K; };

struct StaticOrder {
    int nM, nN, nwg, G, c;
    __host__ __device__ void init(int M, int N, int G_, int c_) { nM = M / BM; nN = N / BM; nwg = nM * nN; G = G_; c = c_; }
    __host__ __device__ bool next(int i, Unit& u) const {
        const long L = (long)i * G + c; if (L >= nwg) return false;
        int wgid = (int)L; { const int q = nwg / NXCD, r = nwg % NXCD, xcd = wgid % NXCD, off = wgid / NXCD; wgid = (xcd < r ? xcd * (q + 1) : r * (q + 1) + (xcd - r) * q) + off; }
        const int nig = WGM * nN, gid = wgid / nig, fm = gid * WGM, gsz = (nM - fm) < WGM ? (nM - fm) : WGM;
        u.pm = fm + ((wgid % nig) % gsz); u.pn = (wgid % nig) / gsz; return true;
    }
    __device__ __forceinline__ void a_ready(const Unit&) const {}
    __device__ __forceinline__ void done(const Unit&) const {}
};

__device__ __forceinline__ unsigned cvt_pk_bf16(float lo, float hi) { unsigned r; asm volatile("v_cvt_pk_bf16_f32 %0, %1, %2" : "=v"(r) : "v"(lo), "v"(hi)); return r; }
template <class Epi, class Sched, bool ALIGN_EPI = false, bool SP2 = false>
__device__ __forceinline__ void gemm_phase(PG8_LAS unsigned char* lds, const Gemm g, const Sched& S, const Epi& E) {
    const int tid = tidx(), wid = __builtin_amdgcn_readfirstlane(tid >> 6), lane = tid & 63, wr = wid >> 2, wc = wid & 3, fr = lane & 15, fq = lane >> 4;
    const int K = g.K, nt = K / BK;
    unsigned voffA[2], voffB[2];
#pragma unroll
    for (int i = 0; i < 2; ++i) { int R, C; stage_rc(tid * 16 + i * 8192, R, C); const int Rb = Epi::PERM ? ((R & ~31) + perm32(R & 31)) : R;
        voffA[i] = (unsigned)(R * K + C) * 2u; voffB[i] = (unsigned)(Rb * K + C) * 2u; }
    const size_t kstep = (size_t)(BK * 2);
    const size_t hstep = (size_t)HALF * K * 2;
    const size_t tstep = 2 * hstep;
    const unsigned ldsw = (unsigned)wid * 1024u;
    const int aoff = lds_byte(wr * 64 + fr, fq * 8), boff = lds_byte(wc * 32 + fr, fq * 8);
#define PG8_SA(b, h) (((b) * 2 + (h)) * HTB)
#define PG8_SB(b, h) ((4 + (b) * 2 + (h)) * HTB)
#define PG8_STAGE(bufoff, gbase, voff) do { _Pragma("unroll") for (int _i = 0; _i < 2; ++_i) \
        __builtin_amdgcn_global_load_lds((const unsigned*)((const char*)(gbase) + (voff)[_i]), (PG8_LAS unsigned*)(lds + (bufoff) + ldsw + _i * 8192), 16, 0, 0); } while (0)
#define PG8_LDA(dst, b, h) do { _Pragma("unroll") for (int m = 0; m < 4; ++m) _Pragma("unroll") for (int k = 0; k < 2; ++k) dst[m][k] = *(const PG8_LAS bf16x8*)(lds + PG8_SA(b, h) + aoff + m * 2048 + k * 1024); } while (0)
#define PG8_LDB(dst, b, h) do { _Pragma("unroll") for (int n = 0; n < 2; ++n) _Pragma("unroll") for (int k = 0; k < 2; ++k) dst[n][k] = *(const PG8_LAS bf16x8*)(lds + PG8_SB(b, h) + boff + n * 2048 + k * 1024); } while (0)
#define PG8_MMA(ai, bj, At, Bt) do { __builtin_amdgcn_s_setprio(1); _Pragma("unroll") for (int m = 0; m < 4; ++m) _Pragma("unroll") for (int n = 0; n < 2; ++n) _Pragma("unroll") for (int k = 0; k < 2; ++k) \
        acc[ai][bj][m][n] = __builtin_amdgcn_mfma_f32_16x16x32_bf16(Bt[n][k], At[m][k], acc[ai][bj][m][n], 0, 0, 0); __builtin_amdgcn_s_setprio(0); } while (0)
#define PG8_WAIT_V(n) asm volatile("s_waitcnt vmcnt(" #n ")" ::: "memory")
#define PG8_WAIT_L(n) asm volatile("s_waitcnt lgkmcnt(" #n ")" ::: "memory")
#define PG8_BAR __builtin_amdgcn_s_barrier()
#define PG8_SCHED __builtin_amdgcn_sched_barrier(0)
    Unit cur, nxt; int ui = 0;
    if (!S.next(0, cur)) return;
    f32x4 acc[2][2][4][2];
#pragma unroll
    for (int a = 0; a < 2; ++a)
#pragma unroll
        for (int b = 0; b < 2; ++b)
#pragma unroll
            for (int m = 0; m < 4; ++m)
#pragma unroll
                for (int n = 0; n < 2; ++n) acc[a][b][m][n] = (f32x4){0.f, 0.f, 0.f, 0.f};
    bf16x8 At[4][2], B0[2][2], B1[2][2];
    const char* cA = (const char*)g.A + (size_t)cur.pm * tstep; const char* cB = (const char*)g.Bt + (size_t)cur.pn * tstep;
    S.a_ready(cur);
    if constexpr (SP2) {
        PG8_STAGE(PG8_SB(0, 0), cB, voffB); PG8_STAGE(PG8_SB(0, 1), cB + hstep, voffB); PG8_STAGE(PG8_SA(0, 0), cA, voffA); PG8_STAGE(PG8_SA(0, 1), cA + hstep, voffA);
        if (wr == 1) PG8_BAR;
        PG8_WAIT_V(2); PG8_BAR;
        PG8_STAGE(PG8_SB(1, 0), cB + kstep, voffB); PG8_STAGE(PG8_SA(1, 0), cA + kstep, voffA); PG8_STAGE(PG8_SB(1, 1), cB + hstep + kstep, voffB);
        PG8_WAIT_V(6); PG8_BAR;
    } else {
        PG8_STAGE(PG8_SB(0, 0), cB, voffB); PG8_STAGE(PG8_SA(0, 0), cA, voffA); PG8_STAGE(PG8_SB(0, 1), cB + hstep, voffB); PG8_STAGE(PG8_SA(0, 1), cA + hstep, voffA);
        if (wr == 1) PG8_BAR;
        PG8_WAIT_V(4); PG8_BAR;
        PG8_STAGE(PG8_SB(1, 0), cB + kstep, voffB); PG8_STAGE(PG8_SA(1, 0), cA + kstep, voffA); PG8_STAGE(PG8_SB(1, 1), cB + hstep + kstep, voffB);
        PG8_WAIT_V(6); PG8_BAR;
    }
    for (;;) {
        const bool has_next = S.next(ui + 1, nxt);
        const char* nA = has_next ? (const char*)g.A + (size_t)nxt.pm * tstep : cA; const char* nB = has_next ? (const char*)g.Bt + (size_t)nxt.pn * tstep : cB;
        for (int t = 0; t < nt; t += 2) {
            const bool last = (t == nt - 2);
            const char* a1 = cA + (size_t)(t + 1) * kstep;
            const char* a2 = last ? nA : cA + (size_t)(t + 2) * kstep; const char* b2 = last ? nB : cB + (size_t)(t + 2) * kstep;
            const char* a3 = a2 + kstep; const char* b3 = b2 + kstep;
            if (last && has_next) S.a_ready(nxt);
            if constexpr (SP2) {
            PG8_LDB(B0, 0, 0); PG8_LDB(B1, 0, 1); PG8_SCHED; PG8_LDA(At, 0, 0); PG8_STAGE(PG8_SA(1, 1), a1 + hstep, voffA);
            PG8_WAIT_V(8); PG8_WAIT_L(0); PG8_BAR; PG8_MMA(0, 0, At, B0); PG8_MMA(0, 1, At, B1); PG8_BAR; PG8_SCHED;
            PG8_LDA(At, 0, 1); PG8_STAGE(PG8_SB(0, 0), b2, voffB); PG8_STAGE(PG8_SB(0, 1), b2 + hstep, voffB); PG8_STAGE(PG8_SA(0, 0), a2, voffA);
            PG8_WAIT_V(8); PG8_WAIT_L(0); PG8_BAR; PG8_MMA(1, 0, At, B0); PG8_MMA(1, 1, At, B1); PG8_BAR; PG8_SCHED;
            PG8_LDB(B0, 1, 0); PG8_LDB(B1, 1, 1); PG8_SCHED; PG8_LDA(At, 1, 0); PG8_STAGE(PG8_SA(0, 1), a2 + hstep, voffA);
            PG8_WAIT_V(8); PG8_WAIT_L(0); PG8_BAR; PG8_MMA(0, 0, At, B0); PG8_MMA(0, 1, At, B1); PG8_BAR; PG8_SCHED;
            PG8_LDA(At, 1, 1); PG8_STAGE(PG8_SB(1, 0), b3, voffB); PG8_STAGE(PG8_SB(1, 1), b3 + hstep, voffB); PG8_STAGE(PG8_SA(1, 0), a3, voffA);
            PG8_WAIT_V(8); PG8_WAIT_L(0); PG8_BAR; PG8_MMA(1, 0, At, B0); PG8_MMA(1, 1, At, B1); PG8_BAR; PG8_SCHED;
            } else {
            PG8_LDB(B0, 0, 0); PG8_SCHED; PG8_LDA(At, 0, 0); PG8_STAGE(PG8_SA(1, 1), a1 + hstep, voffA);
            PG8_WAIT_L(8); PG8_BAR; PG8_WAIT_L(0); PG8_MMA(0, 0, At, B0); PG8_BAR; PG8_SCHED;
            PG8_LDB(B1, 0, 1); PG8_STAGE(PG8_SB(0, 0), b2, voffB);
            PG8_BAR; PG8_WAIT_L(0); PG8_MMA(0, 1, At, B1); PG8_BAR;
            PG8_LDA(At, 0, 1); PG8_STAGE(PG8_SA(0, 0), a2, voffA);
            PG8_BAR; PG8_WAIT_L(0); PG8_MMA(1, 0, At, B0); PG8_BAR; PG8_SCHED;
            PG8_STAGE(PG8_SB(0, 1), b2 + hstep, voffB);
            PG8_WAIT_V(6); PG8_BAR; PG8_MMA(1, 1, At, B1); PG8_BAR;
            PG8_LDB(B0, 1, 0); PG8_SCHED; PG8_LDA(At, 1, 0); PG8_STAGE(PG8_SA(0, 1), a2 + hstep, voffA);
            PG8_WAIT_L(8); PG8_BAR; PG8_WAIT_L(0); PG8_MMA(0, 0, At, B0); PG8_BAR; PG8_SCHED;
            PG8_LDB(B1, 1, 1); PG8_STAGE(PG8_SB(1, 0), b3, voffB);
            PG8_BAR; PG8_WAIT_L(0); PG8_MMA(0, 1, At, B1); PG8_BAR;
            PG8_LDA(At, 1, 1); PG8_STAGE(PG8_SA(1, 0), a3, voffA);
            PG8_BAR; PG8_WAIT_L(0); PG8_MMA(1, 0, At, B0); PG8_BAR; PG8_SCHED;
            PG8_STAGE(PG8_SB(1, 1), b3 + hstep, voffB);
            PG8_WAIT_V(6); PG8_BAR; PG8_MMA(1, 1, At, B1); PG8_BAR;
            }
        }
        if constexpr (ALIGN_EPI) { if (wr == 0) PG8_BAR; }
        if constexpr (!Epi::AFTER_DRAIN) { E(acc, cur, wr, wc, fr, fq); S.done(cur); }
        if (!has_next) break;
#pragma unroll
        for (int a = 0; a < 2; ++a)
#pragma unroll
            for (int b = 0; b < 2; ++b)
#pragma unroll
                for (int m = 0; m < 4; ++m)
#pragma unroll
                    for (int n = 0; n < 2; ++n) acc[a][b][m][n] = (f32x4){0.f, 0.f, 0.f, 0.f};
        cur = nxt; cA = nA; cB = nB; ++ui;
        if constexpr (ALIGN_EPI) { if (wr == 1) PG8_BAR; }
    }
    PG8_WAIT_V(0);
    if constexpr (!ALIGN_EPI) { if (wr == 0) PG8_BAR; }
    PG8_BAR;
    if constexpr (Epi::AFTER_DRAIN) { E.fused(acc, cur, wr, wc, fr, fq, lds, wid, lane); S.done(cur); }
#undef PG8_SA
#undef PG8_SB
#undef PG8_STAGE
#undef PG8_LDA
#undef PG8_LDB
#undef PG8_MMA
#undef PG8_WAIT_V
#undef PG8_WAIT_L
#undef PG8_BAR
#undef PG8_SCHED
}
}

using pg8::bf16_t; using pg8::bf16x8; using pg8::f32x4; using pg8::u32x4;
typedef unsigned u32x2 __attribute__((ext_vector_type(2)));
#define DI __device__ __forceinline__
#define LAS __attribute__((address_space(3)))
constexpr int DM = 1024, SEQL = 16384, NB = 2, NLAT = NB * SEQL, CTXL = 256, NCTX = NB * CTXL, MROWS = NLAT + NCTX;
constexpr int FF = 2816, NPROJ = 2816, PG_LD = 1536, ATT_LD = 768, HYIN = 2832;
constexpr size_t OUT_ATT = (size_t)40 << 20;
constexpr int NCHUNK = MROWS / 64;
constexpr int NREC = NCHUNK * 4 * 2;
constexpr int REC_BYTES = 73728, REC_W = 0, REC_QG = 16384, REC_KTT = 32768, REC_QK = 49152, REC_UT = 57344;
constexpr int REC_IN_WS = 3640;
constexpr float EPS = 1e-6f;
constexpr int LDS_BYTES = 163840;
constexpr size_t MiB = 1u << 20;
constexpr size_t OFF_MOD = 1 * MiB, OFF_ROPE = OFF_MOD + 512 * 1024, OFF_EGL = OFF_ROPE + 256 * 1024, OFF_AB = 2 * MiB, OFF_SSQ = 5 * MiB, OFF_WT = 8 * MiB;
constexpr size_t OFF_H = 58 * MiB, OFF_Z = 124 * MiB, OFF_QN = 157 * MiB, OFF_KN = 190 * MiB, OFF_VN = 223 * MiB, OFF_BIG = 256 * MiB, OFF_Y = 124 * MiB, OFF_O = 190 * MiB, OFF_X16 = 190 * MiB;
constexpr size_t WS_NEED = 512 * MiB;
constexpr size_t OFF_PROG = OFF_EGL + 32 * 1024;
constexpr size_t WT_IN = 0, WT_OUT = WT_IN + (size_t)2816 * 1024, WT_GU0 = WT_OUT + (size_t)1024 * 1024, WT_DN0 = WT_GU0 + (size_t)5632 * 1024, WT_SCIN = WT_DN0 + (size_t)1024 * 2816,
                 WT_SCOUT = WT_SCIN + (size_t)3072 * 1024, WT_GU1 = WT_SCOUT + (size_t)1024 * 1024, WT_DN1 = WT_GU1 + (size_t)5632 * 1024, WT_END = WT_DN1 + (size_t)1024 * 2816;

struct Args {
    const float* x; const float* c; const float* ctx; const float* c_ctx; const float* ada_w; const float* ada_b; const float* pre_mix_g; const float* post_mix_g; const float* pre_ffn_g; const float* post_ffn_g;
    const float* hy_w_in; const float* hy_w_out; const float* attn_sink; const float* gdn_conv_w; const float* gdn_a_log; const float* gdn_dt_bias; const float* gdn_norm_g;
    const float* sc_w_in; const float* sc_conv_w; const float* sc_w_out; const float* ffn_w_gate; const float* ffn_w_up; const float* ffn_w_down;
    float* out; unsigned char* ws; int ph_lo, ph_hi;
};

DI unsigned f2bf(float f) { unsigned u = __float_as_uint(f); return (u + 0x7fffu + ((u >> 16) & 1u)) >> 16; }
typedef float f32x2_t __attribute__((ext_vector_type(2)));
typedef __bf16 bf16x2_t __attribute__((ext_vector_type(2)));
DI unsigned pk2(float lo, float hi) { f32x2_t v = {lo, hi}; bf16x2_t b = __builtin_convertvector(v, bf16x2_t); return __builtin_bit_cast(unsigned, b); }
DI float bflo(unsigned u) { return __uint_as_float(u << 16); }
DI float bfhi(unsigned u) { return __uint_as_float(u & 0xffff0000u); }
DI float bf1(bf16_t h) { return __uint_as_float(((unsigned)h) << 16); }
DI float wave_sum(float v) {
#pragma unroll
    for (int o = 32; o; o >>= 1) v += __shfl_xor(v, o);
    return v;
}
DI float siluf(float x) { return x * __builtin_amdgcn_rcpf(1.f + __expf(-x)); }
DI f32x4 mfma16(bf16x8 a, bf16x8 b, f32x4 c) { return __builtin_amdgcn_mfma_f32_16x16x32_bf16(a, b, c, 0, 0, 0); }
DI bf16x8 pack2(f32x4 a, f32x4 b) { u32x4 p; p.x = pk2(a[0], a[1]); p.y = pk2(a[2], a[3]); p.z = pk2(b[0], b[1]); p.w = pk2(b[2], b[3]); return __builtin_bit_cast(bf16x8, p); }
DI bf16x8 ldf16(const char* p) { return *(const bf16x8*)p; }
DI bf16x8 ldf8x2(const char* p) { u32x2 lo = *(const u32x2*)p; u32x2 hi = *(const u32x2*)(p + 32); u32x4 v; v.x = lo.x; v.y = lo.y; v.z = hi.x; v.w = hi.y; return __builtin_bit_cast(bf16x8, v); }
DI void unpack8(u32x4 v, float (&f)[8]) { f[0] = bflo(v.x); f[1] = bfhi(v.x); f[2] = bflo(v.y); f[3] = bfhi(v.y); f[4] = bflo(v.z); f[5] = bfhi(v.z); f[6] = bflo(v.w); f[7] = bfhi(v.w); }
DI u32x4 pack8(const float (&f)[8]) { u32x4 v; v.x = pk2(f[0], f[1]); v.y = pk2(f[2], f[3]); v.z = pk2(f[4], f[5]); v.w = pk2(f[6], f[7]); return v; }

DI unsigned char* rec_ptr(const Args& a, int r) { return r < REC_IN_WS ? a.ws + OFF_BIG + (size_t)r * REC_BYTES : (unsigned char*)a.out + (size_t)(r - REC_IN_WS) * REC_BYTES; }

struct EpiProj {
    static constexpr bool PERM = true, AFTER_DRAIN = false;
    bf16_t* AT; bf16_t* P; bf16_t* Z;
    DI void operator()(const f32x4 (&acc)[2][2][4][2], const pg8::Unit& u, int wr, int wc, int fr, int fq) const {
        const int row0 = u.pm * 256 + wr * 64 + fr; bf16_t* base; int ld, colt;
        if (u.pn < 3) { base = AT; ld = ATT_LD; colt = u.pn * 256; } else if (u.pn < 9) { base = P; ld = PG_LD; colt = (u.pn - 3) * 256; } else { base = Z; ld = 512; colt = (u.pn - 9) * 256; }
        const int col0 = colt + wc * 32 + 8 * fq;
#pragma unroll
        for (int ai = 0; ai < 2; ++ai)
#pragma unroll
            for (int m = 0; m < 4; ++m) { bf16_t* rowp = base + (size_t)(row0 + ai * 128 + m * 16) * ld + col0;
#pragma unroll
                for (int bj = 0; bj < 2; ++bj) { const f32x4 v0 = acc[ai][bj][m][0], v1 = acc[ai][bj][m][1]; u32x4 w;
                    w.x = pg8::cvt_pk_bf16(v0[0], v0[1]); w.y = pg8::cvt_pk_bf16(v0[2], v0[3]); w.z = pg8::cvt_pk_bf16(v1[0], v1[1]); w.w = pg8::cvt_pk_bf16(v1[2], v1[3]);
                    *(u32x4*)(rowp + bj * 128) = w; } }
    }
};
struct EpiAct {
    static constexpr bool PERM = true, AFTER_DRAIN = false;
    bf16_t* O;
    DI void operator()(const f32x4 (&acc)[2][2][4][2], const pg8::Unit& u, int wr, int wc, int fr, int fq) const {
        const int row0 = u.pm * 256 + wr * 64 + fr, col0 = u.pn * 128 + wc * 32 + 8 * fq;
#pragma unroll
        for (int ai = 0; ai < 2; ++ai)
#pragma unroll
            for (int m = 0; m < 4; ++m) { bf16_t* rowp = O + (size_t)(row0 + ai * 128 + m * 16) * FF + col0; float v[8];
#pragma unroll
                for (int n = 0; n < 2; ++n)
#pragma unroll
                    for (int e = 0; e < 4; ++e) v[4 * n + e] = siluf(acc[ai][0][m][n][e]) * acc[ai][1][m][n][e];
                u32x4 w; w.x = pg8::cvt_pk_bf16(v[0], v[1]); w.y = pg8::cvt_pk_bf16(v[2], v[3]); w.z = pg8::cvt_pk_bf16(v[4], v[5]); w.w = pg8::cvt_pk_bf16(v[6], v[7]);
                *(u32x4*)rowp = w; }
    }
};
struct EpiSc {
    static constexpr bool PERM = true, AFTER_DRAIN = false;
    bf16_t* CU; bf16_t* BG;
    DI void operator()(const f32x4 (&acc)[2][2][4][2], const pg8::Unit& u, int wr, int wc, int fr, int fq) const {
        const int row0 = u.pm * 256 + wr * 64 + fr;
        if (u.pn < 8) {
            const int col0 = u.pn * 128 + wc * 32 + 8 * fq;
#pragma unroll
            for (int ai = 0; ai < 2; ++ai)
#pragma unroll
                for (int m = 0; m < 4; ++m) { bf16_t* rowp = CU + (size_t)(row0 + ai * 128 + m * 16) * DM + col0; float v[8];
#pragma unroll
                    for (int n = 0; n < 2; ++n)
#pragma unroll
                        for (int e = 0; e < 4; ++e) v[4 * n + e] = acc[ai][0][m][n][e] * acc[ai][1][m][n][e];
                    u32x4 w; w.x = pg8::cvt_pk_bf16(v[0], v[1]); w.y = pg8::cvt_pk_bf16(v[2], v[3]); w.z = pg8::cvt_pk_bf16(v[4], v[5]); w.w = pg8::cvt_pk_bf16(v[6], v[7]);
                    *(u32x4*)rowp = w; }
        } else {
            const int col0 = (u.pn - 8) * 256 + wc * 32 + 8 * fq;
#pragma unroll
            for (int ai = 0; ai < 2; ++ai)
#pragma unroll
                for (int m = 0; m < 4; ++m) { bf16_t* rowp = BG + (size_t)(row0 + ai * 128 + m * 16) * DM + col0;
#pragma unroll
                    for (int bj = 0; bj < 2; ++bj) { const f32x4 v0 = acc[ai][bj][m][0], v1 = acc[ai][bj][m][1]; u32x4 w;
                        w.x = pg8::cvt_pk_bf16(v0[0], v0[1]); w.y = pg8::cvt_pk_bf16(v0[2], v0[3]); w.z = pg8::cvt_pk_bf16(v1[0], v1[1]); w.w = pg8::cvt_pk_bf16(v1[2], v1[3]);
                        *(u32x4*)(rowp + bj * 128) = w; } }
        }
    }
};
struct EpiY {
    static constexpr bool PERM = true, AFTER_DRAIN = false;
    bf16_t* Y; float* SSQ;
    DI void operator()(const f32x4 (&acc)[2][2][4][2], const pg8::Unit& u, int wr, int wc, int fr, int fq) const {
        const int row0 = u.pm * 256 + wr * 64 + fr, col0 = u.pn * 256 + wc * 32 + 8 * fq;
#pragma unroll
        for (int ai = 0; ai < 2; ++ai)
#pragma unroll
            for (int m = 0; m < 4; ++m) { const int row = row0 + ai * 128 + m * 16; bf16_t* rowp = Y + (size_t)row * DM + col0; float s = 0.f;
#pragma unroll
                for (int bj = 0; bj < 2; ++bj) { const f32x4 v0 = acc[ai][bj][m][0], v1 = acc[ai][bj][m][1]; u32x4 w;
                    w.x = pg8::cvt_pk_bf16(v0[0], v0[1]); w.y = pg8::cvt_pk_bf16(v0[2], v0[3]); w.z = pg8::cvt_pk_bf16(v1[0], v1[1]); w.w = pg8::cvt_pk_bf16(v1[2], v1[3]);
                    *(u32x4*)(rowp + bj * 128) = w;
                    s += v0[0] * v0[0] + v0[1] * v0[1] + v0[2] * v0[2] + v0[3] * v0[3] + v1[0] * v1[0] + v1[1] * v1[1] + v1[2] * v1[2] + v1[3] * v1[3]; }
                s += __shfl_xor(s, 16); s += __shfl_xor(s, 32);
                if (fq == 0) SSQ[(size_t)row * 16 + u.pn * 4 + wc] = s; }
    }
};

template <class Epi> DI void run_gemm(char* smem, const bf16_t* A, const bf16_t* Bt, int M, int N, int K, const Epi& E) {
    pg8::Gemm g; g.A = A; g.Bt = Bt; g.M = M; g.N = N; g.K = K;
    pg8::StaticOrder S; S.init(M, N, (int)gridDim.x, (int)blockIdx.x);
    pg8::gemm_phase<Epi, pg8::StaticOrder, false, true>((PG8_LAS unsigned char*)smem, g, S, E);
    __syncthreads();
}

DI void p0_ada_unit(const Args& a, char* smem, int u) {
    const int l = u / 96, col0 = (u % 96) * 64, tid = tidx();
    float* sc = (float*)smem;
    float* red = (float*)(smem + 12288);
    for (int i = tid; i < 3072; i += 512) { const int cd = i >> 10, k = i & 1023; const float v = cd < 2 ? a.c[cd * DM + k] : a.c_ctx[k]; sc[i] = siluf(v); }
    __syncthreads();
    const int col = tid & 63, kq = tid >> 6;
    const float* W = a.ada_w + (size_t)l * DM * 6144 + col0 + col;
    float s0 = 0.f, s1 = 0.f, s2 = 0.f;
    for (int k0 = kq * 128; k0 < kq * 128 + 128; k0 += 16) { float w[16];
#pragma unroll
        for (int j = 0; j < 16; ++j) w[j] = W[(size_t)(k0 + j) * 6144];
#pragma unroll
        for (int j = 0; j < 16; ++j) { s0 += sc[k0 + j] * w[j]; s1 += sc[1024 + k0 + j] * w[j]; s2 += sc[2048 + k0 + j] * w[j]; } }
    red[(kq * 3 + 0) * 64 + col] = s0; red[(kq * 3 + 1) * 64 + col] = s1; red[(kq * 3 + 2) * 64 + col] = s2;
    __syncthreads();
    if (tid < 192) { const int cd = tid >> 6, cc = tid & 63; float s = 0.f;
        for (int q = 0; q < 8; ++q) s += red[(q * 3 + cd) * 64 + cc];
        float* MOD = (float*)(a.ws + OFF_MOD);
        MOD[((size_t)l * 3 + cd) * 6144 + col0 + cc] = s + a.ada_b[l * 6144 + col0 + cc]; }
    __syncthreads();
}
DI void p0_rope_unit(const Args& a) {
    if (tidx() < 16) __hip_atomic_store((unsigned*)(a.ws + OFF_PROG) + tidx() * 16, 0u, __ATOMIC_RELAXED, __HIP_MEMORY_SCOPE_AGENT);
    float2* R = (float2*)(a.ws + OFF_ROPE);
    for (int i = tidx(); i < 4096; i += 512) { const int p = i >> 4, f = i & 15;
        const float inv = powf(10000.f, -(float)f / 16.f); const float ang = (float)p * inv;
        R[i] = make_float2(cosf(ang), sinf(ang)); }
}
struct WtTile { const float* src; bf16_t* dst; int ldn, K, scol0, n0, k0; };
DI WtTile p0_wt_desc(const Args& a, int t) {
    bf16_t* WT = (bf16_t*)(a.ws + OFF_WT);
    const int T_IN = 44 * 16, T_OUT = 16 * 16, T_GU = 88 * 16, T_DN = 16 * 44, T_SCIN = 48 * 16, T_SCOUT = 16 * 16;
    int m = 0; int rem = t;
    if (rem >= T_IN) { rem -= T_IN; m = 1;
      if (rem >= T_OUT) { rem -= T_OUT; m = 2;
        if (rem >= T_GU) { rem -= T_GU; m = 3;
          if (rem >= T_DN) { rem -= T_DN; m = 4;
            if (rem >= T_SCIN) { rem -= T_SCIN; m = 5;
              if (rem >= T_SCOUT) { rem -= T_SCOUT; m = 6;
                if (rem >= T_GU) { rem -= T_GU; m = 7; } } } } } } }
    WtTile d; int nb, kb;
    if (m == 0) { d.K = 1024; nb = rem / 16; kb = rem % 16; d.src = a.hy_w_in; d.ldn = HYIN; d.scol0 = nb * 64; d.dst = WT + WT_IN; }
    else if (m == 1) { d.K = 1024; nb = rem / 16; kb = rem % 16; d.src = a.hy_w_out; d.ldn = 1024; d.scol0 = nb * 64; d.dst = WT + WT_OUT; }
    else if (m == 2 || m == 6) { const int l = m == 2 ? 0 : 1; d.K = 1024; nb = rem / 16; kb = rem % 16; const int n0 = nb * 64, pn = n0 >> 8, sg = (n0 >> 7) & 1, i0 = n0 & 127;
        d.src = (sg ? a.ffn_w_up : a.ffn_w_gate) + (size_t)l * DM * FF; d.ldn = FF; d.scol0 = pn * 128 + i0; d.dst = WT + (l ? WT_GU1 : WT_GU0); }
    else if (m == 3 || m == 7) { const int l = m == 3 ? 0 : 1; d.K = 2816; nb = rem / 44; kb = rem % 44; d.src = a.ffn_w_down + (size_t)l * FF * DM; d.ldn = 1024; d.scol0 = nb * 64; d.dst = WT + (l ? WT_DN1 : WT_DN0); }
    else if (m == 4) { d.K = 1024; nb = rem / 16; kb = rem % 16; const int n0 = nb * 64; d.src = a.sc_w_in; d.ldn = 3072; d.dst = WT + WT_SCIN;
        if (n0 < 2048) { const int pn = n0 >> 8, sg = (n0 >> 7) & 1, i0 = n0 & 127; d.scol0 = (sg ? 2048 : 1024) + pn * 128 + i0; } else d.scol0 = n0 - 2048; }
    else { d.K = 1024; nb = rem / 16; kb = rem % 16; d.src = a.sc_w_out; d.ldn = 1024; d.scol0 = nb * 64; d.dst = WT + WT_SCOUT; }
    d.n0 = nb * 64; d.k0 = kb * 64; return d;
}
constexpr int P0_WT_TILES = 44 * 16 + 16 * 16 + 88 * 16 + 16 * 44 + 48 * 16 + 16 * 16 + 88 * 16 + 16 * 44;
constexpr int P0_WT_GROUPS = P0_WT_TILES / 4, P0_WT_EARLY = 44 * 16 / 4;
DI void p0_wt_group(const Args& a, char* smem, int g) {
    const int tid = tidx(); float* T = (float*)smem;
    f32x4 v0[4], v1[4];
#pragma unroll
    for (int j = 0; j < 4; ++j) { const WtTile d = p0_wt_desc(a, g * 4 + j); const int k = tid >> 3, ns = (tid & 7) * 8; const float* p = d.src + (size_t)(d.k0 + k) * d.ldn + d.scol0 + ns;
        v0[j] = *(const f32x4*)p; v1[j] = *(const f32x4*)(p + 4); }
#pragma unroll
    for (int j = 0; j < 4; ++j) { const int k = tid >> 3, ns = (tid & 7) * 8; float* t = T + j * 4160 + k * 65 + ns;
        t[0] = v0[j][0]; t[1] = v0[j][1]; t[2] = v0[j][2]; t[3] = v0[j][3]; t[4] = v1[j][0]; t[5] = v1[j][1]; t[6] = v1[j][2]; t[7] = v1[j][3]; }
    __syncthreads();
#pragma unroll
    for (int j = 0; j < 4; ++j) { const WtTile d = p0_wt_desc(a, g * 4 + j); const int n = tid >> 3, ks = (tid & 7) * 8; float f[8];
#pragma unroll
        for (int e = 0; e < 8; ++e) f[e] = T[j * 4160 + (ks + e) * 65 + n];
        *(u32x4*)(d.dst + (size_t)(d.n0 + n) * d.K + d.k0 + ks) = pack8(f); }
    __syncthreads();
}
DI void phase0(const Args& a, char* smem) {
    for (int u = blockIdx.x; u < 193 + P0_WT_EARLY; u += gridDim.x) {
        if (u < 192) p0_ada_unit(a, smem, u); else if (u == 192) p0_rope_unit(a); else p0_wt_group(a, smem, u - 193);
    }
}

DI void phase1(const Args& a, char* smem) {
    float* WAB = (float*)smem;
    const int tid = tidx(), lane = tid & 63, wid = tid >> 6;
    for (int i = tid; i < 16384; i += 512) { const int k = i >> 4, j = i & 15; WAB[j * 1024 + k] = a.hy_w_in[(size_t)k * HYIN + 2816 + j]; }
    __syncthreads();
    const float* MOD = (const float*)(a.ws + OFF_MOD);
    bf16_t* H = (bf16_t*)(a.ws + OFF_H); float* AB = (float*)(a.ws + OFF_AB);
    f32x4 m1[4], m0[4]; int cur_cd = -1;
    const int rs = (int)gridDim.x * 8;
    f32x4 nv[4];
    { const int row0 = blockIdx.x * 8 + wid; if (row0 < MROWS) { const float* src0 = row0 < NLAT ? a.x + (size_t)row0 * DM : a.ctx + (size_t)(row0 - NLAT) * DM;
#pragma unroll
        for (int i = 0; i < 4; ++i) nv[i] = *(const f32x4*)(src0 + i * 256 + lane * 4); } }
    for (int row = blockIdx.x * 8 + wid; row < MROWS; row += rs) {
        const int cd = row < NLAT ? row / SEQL : 2;
        if (cd != cur_cd) { const float* sh = MOD + (size_t)cd * 6144, *scl = sh + 1024;
#pragma unroll
            for (int i = 0; i < 4; ++i) { const int k = i * 256 + lane * 4; const f32x4 g = *(const f32x4*)(a.pre_mix_g + k), s1 = *(const f32x4*)(sh + k), c1 = *(const f32x4*)(scl + k); m1[i] = g * (c1 + 1.f); m0[i] = s1; }
            cur_cd = cd; }
        f32x4 v[4]; float ss = 0.f;
#pragma unroll
        for (int i = 0; i < 4; ++i) { v[i] = nv[i]; ss += v[i][0] * v[i][0] + v[i][1] * v[i][1] + v[i][2] * v[i][2] + v[i][3] * v[i][3]; }
        { const int nrow = row + rs; if (nrow < MROWS) { const float* srcn = nrow < NLAT ? a.x + (size_t)nrow * DM : a.ctx + (size_t)(nrow - NLAT) * DM;
#pragma unroll
            for (int i = 0; i < 4; ++i) nv[i] = *(const f32x4*)(srcn + i * 256 + lane * 4); } }
        ss = wave_sum(ss); const float r = rsqrtf(ss * (1.f / 1024.f) + EPS);
#pragma unroll
        for (int i = 0; i < 4; ++i) { const int k = i * 256 + lane * 4;
#pragma unroll
            for (int e = 0; e < 4; ++e) v[i][e] = v[i][e] * r * m1[i][e] + m0[i][e];
            u32x2 w; w.x = pk2(v[i][0], v[i][1]); w.y = pk2(v[i][2], v[i][3]); *(u32x2*)(H + (size_t)row * DM + k) = w; }
        float p[16];
#pragma unroll
        for (int j = 0; j < 16; ++j) { float sj = 0.f;
#pragma unroll
            for (int i = 0; i < 4; ++i) { const f32x4 w = *(const f32x4*)(WAB + j * 1024 + i * 256 + lane * 4); sj += v[i][0] * w[0] + v[i][1] * w[1] + v[i][2] * w[2] + v[i][3] * w[3]; }
            p[j] = sj; __builtin_amdgcn_sched_barrier(0); }
        float q8[8], q4[4], q2[2], q1;
        { const bool hi = (lane & 32) != 0;
#pragma unroll
          for (int t = 0; t < 8; ++t) { const float snd = hi ? p[t] : p[t + 8], kp = hi ? p[t + 8] : p[t]; q8[t] = kp + __shfl_xor(snd, 32); } }
        { const bool hi = (lane & 16) != 0;
#pragma unroll
          for (int t = 0; t < 4; ++t) { const float snd = hi ? q8[t] : q8[t + 4], kp = hi ? q8[t + 4] : q8[t]; q4[t] = kp + __shfl_xor(snd, 16); } }
        { const bool hi = (lane & 8) != 0;
#pragma unroll
          for (int t = 0; t < 2; ++t) { const float snd = hi ? q4[t] : q4[t + 2], kp = hi ? q4[t + 2] : q4[t]; q2[t] = kp + __shfl_xor(snd, 8); } }
        { const bool hi = (lane & 4) != 0; const float snd = hi ? q2[0] : q2[1], kp = hi ? q2[1] : q2[0]; q1 = kp + __shfl_xor(snd, 4); }
        q1 += __shfl_xor(q1, 2); q1 += __shfl_xor(q1, 1);
        if ((lane & 3) == 0) AB[(size_t)row * 16 + (lane >> 2)] = q1;
    }
    __syncthreads();
}

DI void conv_rows(const Args& a) {
    const int lane = tidx() & 63, wid = tidx() >> 6;
    const bf16_t* P = (const bf16_t*)(a.ws + OFF_BIG);
    bf16_t* QN = (bf16_t*)(a.ws + OFF_QN); bf16_t* KN = (bf16_t*)(a.ws + OFF_KN); bf16_t* VN = (bf16_t*)(a.ws + OFF_VN);
    float w0[3][8], w1[3][8], w2[3][8];
#pragma unroll
    for (int part = 0; part < 3; ++part)
#pragma unroll
        for (int e = 0; e < 8; ++e) { const int ch = part * 512 + lane * 8 + e; w0[part][e] = a.gdn_conv_w[ch]; w1[part][e] = a.gdn_conv_w[1536 + ch]; w2[part][e] = a.gdn_conv_w[3072 + ch]; }
    const u32x4 zero4 = {0u, 0u, 0u, 0u};
    for (int blk = blockIdx.x * 8 + wid; blk < MROWS / 16; blk += gridDim.x * 8) {
        const int r0 = blk * 16;
        int t0, len; if (r0 < NLAT) { t0 = r0 & (SEQL - 1); len = SEQL; } else { t0 = (r0 - NLAT) & (CTXL - 1); len = CTXL; }
        u32x4 xp[3], xc[3], xn[3], xnn[3];
#pragma unroll
        for (int part = 0; part < 3; ++part) { const bf16_t* p = P + (size_t)r0 * PG_LD + part * 512 + lane * 8;
            xc[part] = *(const u32x4*)p; xp[part] = t0 > 0 ? *(const u32x4*)(p - PG_LD) : zero4; xn[part] = t0 + 1 < len ? *(const u32x4*)(p + PG_LD) : zero4; }
        for (int i = 0; i < 16; ++i) {
            const int row = r0 + i, t = t0 + i;
#pragma unroll
            for (int part = 0; part < 3; ++part) xnn[part] = (i < 15 && t + 2 < len) ? *(const u32x4*)(P + (size_t)(row + 2) * PG_LD + part * 512 + lane * 8) : zero4;
#pragma unroll
            for (int part = 0; part < 3; ++part) {
                float fc[8], fp[8], fn[8]; unpack8(xc[part], fc); unpack8(xp[part], fp); unpack8(xn[part], fn);
                float y[8]; float ss = 0.f;
#pragma unroll
                for (int e = 0; e < 8; ++e) { const float cv = w0[part][e] * fp[e] + w1[part][e] * fc[e] + w2[part][e] * fn[e]; y[e] = siluf(cv); ss += y[e] * y[e]; }
                if (part < 2) {
                    ss += __shfl_xor(ss, 1); ss += __shfl_xor(ss, 2); ss += __shfl_xor(ss, 4); ss += __shfl_xor(ss, 8);
                    const float r = rsqrtf(ss + EPS) * (part == 0 ? 0.08838834764831845f : 1.f);
#pragma unroll
                    for (int e = 0; e < 8; ++e) y[e] *= r;
                }
                bf16_t* dst = (part == 0 ? QN : part == 1 ? KN : VN) + (size_t)row * 512 + lane * 8;
                *(u32x4*)dst = pack8(y);
            }
#pragma unroll
            for (int part = 0; part < 3; ++part) { xp[part] = xc[part]; xc[part] = xn[part]; xn[part] = xnn[part]; }
        }
    }
}

constexpr int AT_QS = 0, AT_KS = 36864, AT_VT = AT_KS + 320 * 144, AT_VT_STRIDE = 656, AT_ROPE = AT_VT + 64 * 656;
static_assert(AT_ROPE + 32768 <= LDS_BYTES, "attention LDS map");
constexpr int N_ATT_UNITS = 1024;
DI int vt_pos(int i) { return (i & ~31) + ((i >> 2) & 3) * 8 + ((i >> 4) & 1) * 4 + (i & 3); }
DI void attn_load_kv(const Args& a, char* smem, const bf16_t* P, long grow0, int tpos0, int tlen, int nrows, int kvh, bool rope) {
    const int tid = tidx();
    const float2* R = (const float2*)(smem + AT_ROPE);
    u32x4 ka[3], kb[3], vv[5];
#pragma unroll
    for (int it = 0; it < 3; ++it) { const int idx = tid + it * 512, i = idx >> 2, q = idx & 3, t = tpos0 + i; const bool ok = idx < nrows * 4 && t >= 0 && t < tlen;
        ka[it] = (u32x4){0u, 0u, 0u, 0u}; kb[it] = (u32x4){0u, 0u, 0u, 0u};
        if (ok) { const bf16_t* p = P + (grow0 + i) * ATT_LD + 512 + kvh * 64 + q * 8; ka[it] = *(const u32x4*)p; kb[it] = *(const u32x4*)(p + 32); } }
#pragma unroll
    for (int it = 0; it < 5; ++it) { const int idx = tid + it * 512, q = idx / nrows, i = idx - q * nrows, t = tpos0 + i; const bool ok = idx < nrows * 8 && t >= 0 && t < tlen;
        vv[it] = (u32x4){0u, 0u, 0u, 0u};
        if (ok) vv[it] = *(const u32x4*)(P + (grow0 + i) * ATT_LD + 640 + kvh * 64 + q * 8); }
#pragma unroll
    for (int it = 0; it < 3; ++it) { const int idx = tid + it * 512, i = idx >> 2, q = idx & 3, t = tpos0 + i;
        if (idx < nrows * 4) {
            float x1[8], x2[8]; unpack8(ka[it], x1); unpack8(kb[it], x2);
            if (rope && t >= 0 && t < tlen) { const int pp = (q < 2) ? (t >> 6) : (t & 63); const float2* rp = R + pp * 16 + (q & 1) * 8;
#pragma unroll
                for (int e = 0; e < 8; ++e) { const float2 cs = rp[e]; const float o1 = x1[e] * cs.x - x2[e] * cs.y, o2 = x2[e] * cs.x + x1[e] * cs.y; x1[e] = o1; x2[e] = o2; } }
            *(u32x4*)(smem + AT_KS + i * 144 + q * 16) = pack8(x1);
            *(u32x4*)(smem + AT_KS + i * 144 + 64 + q * 16) = pack8(x2); } }
#pragma unroll
    for (int it = 0; it < 5; ++it) { const int idx = tid + it * 512, q = idx / nrows, i = idx - q * nrows;
        if (idx < nrows * 8) { const u32x4 v = vv[it];
            bf16_t* vt = (bf16_t*)(smem + AT_VT) + vt_pos(i); const int d0 = q * 8;
            vt[(d0 + 0) * 328] = (bf16_t)(v.x & 0xffff); vt[(d0 + 1) * 328] = (bf16_t)(v.x >> 16);
            vt[(d0 + 2) * 328] = (bf16_t)(v.y & 0xffff); vt[(d0 + 3) * 328] = (bf16_t)(v.y >> 16);
            vt[(d0 + 4) * 328] = (bf16_t)(v.z & 0xffff); vt[(d0 + 5) * 328] = (bf16_t)(v.z >> 16);
            vt[(d0 + 6) * 328] = (bf16_t)(v.w & 0xffff); vt[(d0 + 7) * 328] = (bf16_t)(v.w >> 16); } }
}
DI void attn_unit(const Args& a, char* smem, int u) {
    const int b = u >> 9, kvh = (u >> 8) & 1, qb = u & 255, q0 = qb * 64;
    const int tid = tidx(), lane = tid & 63, wid = tid >> 6, fr = lane & 15, fq = lane >> 4;
    const bf16_t* P = (const bf16_t*)((const unsigned char*)a.out + OUT_ATT);
    const float2* R = (const float2*)(smem + AT_ROPE);
    bf16_t* MIX = (bf16_t*)(a.ws + OFF_H);
    constexpr float QSCALE = 0.125f * 1.4426950408889634f;
#pragma unroll
    for (int it = 0; it < 2; ++it) { const int idx = tid + it * 512, hr = idx >> 2, q = idx & 3, g = hr >> 6, r = hr & 63; const int t = q0 + r;
      const bf16_t* p = P + ((size_t)b * SEQL + t) * ATT_LD + (kvh * 4 + g) * 64 + q * 8; float x1[8], x2[8];
      unpack8(*(const u32x4*)p, x1); unpack8(*(const u32x4*)(p + 32), x2);
      const int pp = (q < 2) ? (t >> 6) : (t & 63); const float2* rp = R + pp * 16 + (q & 1) * 8;
#pragma unroll
      for (int e = 0; e < 8; ++e) { const float2 cs = rp[e]; const float o1 = (x1[e] * cs.x - x2[e] * cs.y) * QSCALE, o2 = (x2[e] * cs.x + x1[e] * cs.y) * QSCALE; x1[e] = o1; x2[e] = o2; }
      *(u32x4*)(smem + AT_QS + hr * 144 + q * 16) = pack8(x1); *(u32x4*)(smem + AT_QS + hr * 144 + 64 + q * 16) = pack8(x2); }
    const int g = wid >> 1, qs = wid & 1, hq = kvh * 4 + g;
    const int qi0 = q0 + qs * 32 + fr;
    float m_run[2], l_run[2];
    m_run[0] = m_run[1] = a.attn_sink[hq] * 1.4426950408889634f; l_run[0] = l_run[1] = (fq == 0) ? 1.f : 0.f;
    f32x4 O[2][4];
#pragma unroll
    for (int j = 0; j < 2; ++j)
#pragma unroll
        for (int dt = 0; dt < 4; ++dt) O[j][dt] = (f32x4){0.f, 0.f, 0.f, 0.f};
    bf16x8 Qf[2][2];
#pragma unroll
    for (int pass = 0; pass < 2; ++pass) {
        if (pass == 0) attn_load_kv(a, smem, P, (long)b * SEQL + q0 - 128, q0 - 128, SEQL, 320, kvh, true);
        else attn_load_kv(a, smem, P, (long)NLAT + b * CTXL, 0, CTXL, 256, kvh, false);
        __syncthreads();
        if (pass == 0) {
#pragma unroll
            for (int j = 0; j < 2; ++j) { const char* qp = smem + AT_QS + (g * 64 + qs * 32 + j * 16 + fr) * 144 + fq * 16; Qf[j][0] = ldf16(qp); Qf[j][1] = ldf16(qp + 64); } }
        const int ngrp = pass == 0 ? 5 : 4;
#pragma unroll 1
        for (int kk = 0; kk < ngrp; ++kk) {
            f32x4 sc[2][4];
            { const char* kp = smem + AT_KS + (kk * 64 + fr) * 144 + fq * 16;
#pragma unroll
              for (int kt = 0; kt < 4; ++kt) { const bf16x8 k0 = ldf16(kp + kt * 16 * 144), k1 = ldf16(kp + kt * 16 * 144 + 64);
#pragma unroll
                  for (int j = 0; j < 2; ++j) { f32x4 z = {0.f, 0.f, 0.f, 0.f}; z = mfma16(k0, Qf[j][0], z); sc[j][kt] = mfma16(k1, Qf[j][1], z); } } }
            const int kbase = q0 - 128 + kk * 64;
            const bool need_mask = pass == 0 && (kk == 0 || kk == 4 || kbase < 0 || kbase + 64 > SEQL);
            if (need_mask) {
#pragma unroll
                for (int j = 0; j < 2; ++j) { const int qi = qi0 + j * 16;
#pragma unroll
                    for (int kt = 0; kt < 4; ++kt)
#pragma unroll
                        for (int r = 0; r < 4; ++r) { const int k = kbase + kt * 16 + fq * 4 + r; const bool v = k >= 0 && k < SEQL && (qi - k) <= 128 && (k - qi) <= 128; sc[j][kt][r] = v ? sc[j][kt][r] : -1e30f; } }
            }
            bf16x8 Pb[2][2];
#pragma unroll
            for (int j = 0; j < 2; ++j) {
                float mx = m_run[j];
#pragma unroll
                for (int kt = 0; kt < 4; ++kt) mx = fmaxf(fmaxf(mx, fmaxf(sc[j][kt][0], sc[j][kt][1])), fmaxf(sc[j][kt][2], sc[j][kt][3]));
                mx = fmaxf(mx, __shfl_xor(mx, 16)); mx = fmaxf(mx, __shfl_xor(mx, 32));
                const float alpha = __builtin_amdgcn_exp2f(m_run[j] - mx); m_run[j] = mx;
                float ps = 0.f;
#pragma unroll
                for (int kt = 0; kt < 4; ++kt)
#pragma unroll
                    for (int r = 0; r < 4; ++r) { const float pv = __builtin_amdgcn_exp2f(sc[j][kt][r] - mx); sc[j][kt][r] = pv; ps += pv; }
                l_run[j] = l_run[j] * alpha + ps;
                Pb[j][0] = pack2(sc[j][0], sc[j][1]); Pb[j][1] = pack2(sc[j][2], sc[j][3]);
#pragma unroll
                for (int dt = 0; dt < 4; ++dt) O[j][dt] = O[j][dt] * alpha;
            }
            { const char* vp = smem + AT_VT + fr * AT_VT_STRIDE + (kk * 64 + fq * 8) * 2;
#pragma unroll
              for (int dt = 0; dt < 4; ++dt)
#pragma unroll
                  for (int kp = 0; kp < 2; ++kp) { const bf16x8 vf = ldf16(vp + dt * 16 * AT_VT_STRIDE + kp * 64);
                      O[0][dt] = mfma16(vf, Pb[0][kp], O[0][dt]); O[1][dt] = mfma16(vf, Pb[1][kp], O[1][dt]); } }
        }
        __syncthreads();
    }
#pragma unroll
    for (int j = 0; j < 2; ++j) {
        float l = l_run[j]; l += __shfl_xor(l, 16); l += __shfl_xor(l, 32);
        const float inv = 1.f / l;
        bf16_t* op = MIX + ((size_t)b * SEQL + qi0 + j * 16) * DM + hq * 64 + fq * 4;
#pragma unroll
        for (int dt = 0; dt < 4; ++dt) { u32x2 w; w.x = pk2(O[j][dt][0] * inv, O[j][dt][1] * inv); w.y = pk2(O[j][dt][2] * inv, O[j][dt][3] * inv); *(u32x2*)(op + dt * 16) = w; }
    }
}
DI void phase3a(const Args& a, char* smem) { conv_rows(a); }

constexpr int PR_Q = 0, PR_K = 17408, PR_KT = 34816, PR_KB = 53248, PR_VT = 71680, PR_AS = 90112, PR_TS = 107520, PR_TB = 124928, PR_GC = 134144, PR_BETA = 134400;
DI float softplusf(float x) { return fmaxf(x, 0.f) + log1pf(expf(-fabsf(x))); }
struct PrepIn { u32x4 lq[2], lk[2], lv[2]; float av, bv; };
DI void prep_load(const Args& a, int r, PrepIn& in) {
    const int dir = r & 1, h = (r >> 1) & 3, cidx = r >> 3, base = cidx * 64;
    const int tid = tidx(), lane = tid & 63;
    const bf16_t* QN = (const bf16_t*)(a.ws + OFF_QN); const bf16_t* KN = (const bf16_t*)(a.ws + OFF_KN); const bf16_t* VN = (const bf16_t*)(a.ws + OFF_VN);
    const float* AB = (const float*)(a.ws + OFF_AB);
#pragma unroll
    for (int it = 0; it < 2; ++it) { const int idx = tid + it * 512, rr = idx & 63, q = idx >> 6; const int tok = dir ? base + 63 - rr : base + rr;
        const size_t go = (size_t)tok * 512 + h * 128 + q * 8; in.lq[it] = *(const u32x4*)(QN + go); in.lk[it] = *(const u32x4*)(KN + go); in.lv[it] = *(const u32x4*)(VN + go); }
    { const int tok = dir ? base + 63 - lane : base + lane; in.av = AB[(size_t)tok * 16 + dir * 4 + h]; in.bv = AB[(size_t)tok * 16 + 8 + dir * 4 + h]; }
}
#define LDS_BARRIER() do { asm volatile("s_waitcnt lgkmcnt(0)" ::: "memory"); __builtin_amdgcn_s_barrier(); asm volatile("" ::: "memory"); } while (0)
DI void prep_unit(const Args& a, char* smem, int r, const PrepIn& in) {
    const int dir = r & 1, h = (r >> 1) & 3, cidx = r >> 3;
    const int tid = tidx(), lane = tid & 63, wid = tid >> 6, fr = lane & 15, fq = lane >> 4;
    float* gc = (float*)(smem + PR_GC); float* beta = (float*)(smem + PR_BETA);
    int slot_;
    { int bb, st; if (cidx < 512) { bb = cidx >> 8; const int n = cidx & 255; st = 4 + (dir ? 255 - n : n); } else { bb = (cidx - 512) >> 2; const int n = (cidx - 512) & 3; st = dir ? 3 - n : n; }
      slot_ = ((bb * 4 + h) * 2 + dir) * 260 + st; }
    const int slot = slot_;
    unsigned char* rec = rec_ptr(a, slot);
    u32x4 lq[2], lk[2], lv[2];
#pragma unroll
    for (int it = 0; it < 2; ++it) { lq[it] = in.lq[it]; lk[it] = in.lk[it]; lv[it] = in.lv[it]; }
    if (wid == 0) {
        const float av = in.av, bv = in.bv;
        float gv = -expf(a.gdn_a_log[dir * 4 + h]) * softplusf(av + a.gdn_dt_bias[dir * 4 + h]);
#pragma unroll
        for (int o = 1; o < 64; o <<= 1) { const float t = __shfl_up(gv, o); if (lane >= o) gv += t; }
        gc[lane] = gv; beta[lane] = 1.f / (1.f + expf(-bv));
        if (lane == 63) ((float*)(a.ws + OFF_EGL))[slot] = expf(gv);
    }
    LDS_BARRIER();
#pragma unroll
    for (int it = 0; it < 2; ++it) {
        const int idx = tid + it * 512, rr = idx & 63, q = idx >> 6;
        const u32x4 qv = lq[it], kv = lk[it], vv = lv[it];
        *(u32x4*)(smem + PR_Q + rr * 272 + q * 16) = qv; *(u32x4*)(smem + PR_K + rr * 272 + q * 16) = kv;
        float kf[8], vf[8]; unpack8(kv, kf); unpack8(vv, vf);
        const float bt = beta[rr], be = bt * __expf(gc[rr]);
        bf16_t* kt = (bf16_t*)(smem + PR_KT) + (q * 8) * 72 + rr; bf16_t* kb = (bf16_t*)(smem + PR_KB) + (q * 8) * 72 + rr; bf16_t* vt = (bf16_t*)(smem + PR_VT) + (q * 8) * 72 + rr;
#pragma unroll
        for (int e = 0; e < 8; ++e) { kt[e * 72] = (bf16_t)f2bf(kf[e]); kb[e * 72] = (bf16_t)f2bf(kf[e] * be); vt[e * 72] = (bf16_t)f2bf(vf[e] * bt); }
    }
    LDS_BARRIER();
    float* As = (float*)(smem + PR_AS); float* Ts = (float*)(smem + PR_TS);
#pragma unroll
    for (int tt = 0; tt < 2; ++tt) {
        const int t = wid * 2 + tt, mt = t >> 2, nt = t & 3;
        f32x4 kk = {0.f, 0.f, 0.f, 0.f}, qk = {0.f, 0.f, 0.f, 0.f};
#pragma unroll
        for (int ks = 0; ks < 4; ++ks) {
            const bf16x8 am = ldf16(smem + PR_K + (mt * 16 + fr) * 272 + ks * 64 + fq * 16);
            const bf16x8 bk = ldf16(smem + PR_K + (nt * 16 + fr) * 272 + ks * 64 + fq * 16);
            const bf16x8 bq = ldf16(smem + PR_Q + (nt * 16 + fr) * 272 + ks * 64 + fq * 16);
            kk = mfma16(am, bk, kk); qk = mfma16(am, bq, qk);
        }
        const int i = nt * 16 + fr; const float gi = gc[i], bi = beta[i];
        f32x4 av; u32x2 qw; float qv[4];
#pragma unroll
        for (int j4 = 0; j4 < 4; ++j4) { const int j = mt * 16 + fq * 4 + j4; const float dg = gi - gc[j];
            const float edg = __expf(dg); av[j4] = (i > j) ? bi * kk[j4] * edg : 0.f; qv[j4] = (i >= j) ? qk[j4] * edg : 0.f; }
        *(f32x4*)(As + i * 68 + mt * 16 + fq * 4) = av;
        qw.x = pk2(qv[0], qv[1]); qw.y = pk2(qv[2], qv[3]);
        *(u32x2*)(rec + REC_QK + (i * 64 + (mt >> 1) * 32 + fq * 8 + (mt & 1) * 4) * 2) = qw;
    }
    LDS_BARRIER();
    if (wid == 0) {
        const int bI = lane >> 4, c = lane & 15; float x[16];
#pragma unroll
        for (int i = 0; i < 16; ++i) { float sacc = (i == c) ? 1.f : 0.f; const float* ar = As + (bI * 16 + i) * 68 + bI * 16;
#pragma unroll
            for (int j = 0; j < i; ++j) sacc -= ar[j] * x[j];
            x[i] = sacc; }
#pragma unroll
        for (int i = 0; i < 16; ++i) Ts[(bI * 16 + i) * 68 + bI * 16 + c] = x[i];
    }
    LDS_BARRIER();
    { float* scr = (float*)(smem + PR_TB) + wid * 16 * 17;
#pragma unroll
      for (int bI = 1; bI < 4; ++bI) {
          if (wid < bI) { const int bJ = wid; f32x4 racc = {0.f, 0.f, 0.f, 0.f};
              for (int bK = bJ; bK < bI; ++bK) {
#pragma unroll
                  for (int kk = 0; kk < 4; ++kk) { const float av = As[(bI * 16 + fr) * 68 + bK * 16 + kk * 4 + fq], bv = Ts[(bK * 16 + kk * 4 + fq) * 68 + bJ * 16 + fr];
                      racc = __builtin_amdgcn_mfma_f32_16x16x4f32(av, bv, racc, 0, 0, 0); } }
#pragma unroll
              for (int j = 0; j < 4; ++j) scr[(fq * 4 + j) * 17 + fr] = racc[j];
              asm volatile("s_waitcnt lgkmcnt(0)" ::: "memory"); __builtin_amdgcn_wave_barrier();
              f32x4 tacc = {0.f, 0.f, 0.f, 0.f};
#pragma unroll
              for (int kk = 0; kk < 4; ++kk) { const float av = Ts[(bI * 16 + fr) * 68 + bI * 16 + kk * 4 + fq], bv = scr[(kk * 4 + fq) * 17 + fr];
                  tacc = __builtin_amdgcn_mfma_f32_16x16x4f32(av, bv, tacc, 0, 0, 0); }
#pragma unroll
              for (int j = 0; j < 4; ++j) Ts[(bI * 16 + fq * 4 + j) * 68 + bJ * 16 + fr] = -tacc[j];
          }
          LDS_BARRIER();
      } }
    for (int idx = tid; idx < 2048; idx += 512) { const int i = idx >> 5, j2 = (idx & 31) * 2; const bool up = (j2 >> 4) > (i >> 4);
        *(unsigned*)(smem + PR_TB + i * 144 + j2 * 2) = up ? 0u : pk2(Ts[i * 68 + j2], Ts[i * 68 + j2 + 1]); }
    LDS_BARRIER();
#pragma unroll
    for (int tt = 0; tt < 4; ++tt) {
        const int t = wid * 4 + tt;
        { const int ct = t & 3, et = t >> 2; f32x4 acc = {0.f, 0.f, 0.f, 0.f};
#pragma unroll
          for (int ks = 0; ks < 2; ++ks) acc = mfma16(ldf16(smem + PR_TB + (ct * 16 + fr) * 144 + ks * 64 + fq * 16), ldf16(smem + PR_VT + (et * 16 + fr) * 144 + ks * 64 + fq * 16), acc);
          u32x2 w; w.x = pk2(acc[0], acc[1]); w.y = pk2(acc[2], acc[3]);
          *(u32x2*)(rec + REC_UT + ((et * 16 + fr) * 64 + ct * 16 + fq * 4) * 2) = w; }
        { const int ct = t & 3, dt = t >> 2; f32x4 acc = {0.f, 0.f, 0.f, 0.f};
#pragma unroll
          for (int ks = 0; ks < 2; ++ks) acc = mfma16(ldf16(smem + PR_KB + (dt * 16 + fr) * 144 + ks * 64 + fq * 16), ldf16(smem + PR_TB + (ct * 16 + fr) * 144 + ks * 64 + fq * 16), acc);
          u32x2 w; w.x = pk2(acc[0], acc[1]); w.y = pk2(acc[2], acc[3]);
          *(u32x2*)(rec + REC_W + ((ct * 16 + fr) * 128 + (dt >> 1) * 32 + fq * 8 + (dt & 1) * 4) * 2) = w; }
    }
    const float glast = gc[63];
    for (int idx = tid; idx < 1024; idx += 512) {
        { const int rr = idx >> 4, q = idx & 15; float f[8]; unpack8(*(const u32x4*)(smem + PR_Q + rr * 272 + q * 16), f); const float e = __expf(gc[rr]);
#pragma unroll
          for (int j = 0; j < 8; ++j) f[j] *= e;
          const int p0 = (q >> 2) * 32 + ((q >> 1) & 1) * 4; u32x2 w0, w1; w0.x = pk2(f[0], f[1]); w0.y = pk2(f[2], f[3]); w1.x = pk2(f[4], f[5]); w1.y = pk2(f[6], f[7]);
          *(u32x2*)(rec + REC_QG + (rr * 128 + p0 + ((2 * q) & 3) * 8) * 2) = w0; *(u32x2*)(rec + REC_QG + (rr * 128 + p0 + ((2 * q + 1) & 3) * 8) * 2) = w1; }
        { const int d = idx >> 3, q = idx & 7; float f[8]; unpack8(*(const u32x4*)(smem + PR_KT + d * 144 + q * 16), f);
#pragma unroll
          for (int j = 0; j < 8; ++j) f[j] *= __expf(glast - gc[q * 8 + j]);
          const int p0 = (q >> 2) * 32 + ((q >> 1) & 1) * 4; u32x2 w0, w1; w0.x = pk2(f[0], f[1]); w0.y = pk2(f[2], f[3]); w1.x = pk2(f[4], f[5]); w1.y = pk2(f[6], f[7]);
          *(u32x2*)(rec + REC_KTT + (d * 64 + p0 + ((2 * q) & 3) * 8) * 2) = w0; *(u32x2*)(rec + REC_KTT + (d * 64 + p0 + ((2 * q + 1) & 3) * 8) * 2) = w1; }
    }
    LDS_BARRIER();
}
DI void phase3b(const Args& a, char* smem) {
    const int G = (int)gridDim.x; int r = (int)blockIdx.x;
    PrepIn cur, nxt;
    if (r < NREC) prep_load(a, r, cur);
    for (; r < NREC; r += G) {
        if (r + G < NREC) prep_load(a, r + G, nxt);
        prep_unit(a, smem, r, cur);
        cur = nxt;
    }
}

constexpr int SC_W = 0, SC_QG = 18432, SC_KTT = 36864, SC_QK = 57344, SC_UT = 67584, SC_EGL = 70144, SC_BUF = 70160, SC_NP = 3712, SC_OST = 2 * 70160;
DI int scan_rec(int b, int h, int dir, int step) { return ((b * 4 + h) * 2 + dir) * 260 + step; }
#define SC_BARRIER() do { asm volatile("s_waitcnt lgkmcnt(0)" ::: "memory"); __builtin_amdgcn_s_barrier(); asm volatile("" ::: "memory"); } while (0)
DI void scan_unit(const Args& a, char* smem, int u) {
    const int sl = u & 7, chain = u >> 3, dir = chain & 1, h = (chain >> 1) & 3, b = chain >> 3, e0 = sl * 16;
    const int tid = tidx(), lane = tid & 63, wid = __builtin_amdgcn_readfirstlane(tid >> 6), fr = lane & 15, fq = lane >> 4;
    const float* EGL = (const float*)(a.ws + OFF_EGL);
    bf16_t* Ob = (bf16_t*)(a.ws + OFF_O) + (size_t)dir * NLAT * 512;
    constexpr int NSTEP = 260;
    if (wid == 0) {
        f32x4 S[8];
#pragma unroll
        for (int i = 0; i < 8; ++i) S[i] = (f32x4){0.f, 0.f, 0.f, 0.f};
        for (int step = -1; step <= NSTEP; ++step) {
            if (step >= 0 && step < NSTEP) {
                const char* buf = smem + (step & 1) * SC_BUF;
                const float egl = *(const float*)(buf + SC_EGL);
                if (sl == 0 && lane == 0) __hip_atomic_store((unsigned*)(a.ws + OFF_PROG) + chain * 16, (unsigned)step, __ATOMIC_RELAXED, __HIP_MEMORY_SCOPE_AGENT);
                const char* pw = buf + SC_W + fr * 288 + fq * 16; const char* pq = buf + SC_QG + fr * 288 + fq * 16;
                const char* pk = buf + SC_QK + fr * 160 + fq * 16; const char* pt = buf + SC_KTT + fr * 160 + fq * 16;
                bf16x8 fa[8], fb[8];
#define LD_WQ(F, ct) do { _Pragma("unroll") for (int kk = 0; kk < 4; ++kk) { F[kk] = ldf16(pw + (ct) * 16 * 288 + kk * 64); F[4 + kk] = ldf16(pq + (ct) * 16 * 288 + kk * 64); } } while (0)
#define LD_QK(F) do { _Pragma("unroll") for (int ct = 0; ct < 4; ++ct) { F[2 * ct] = ldf16(pk + ct * 16 * 160); F[2 * ct + 1] = ldf16(pk + ct * 16 * 160 + 64); } } while (0)
#define LD_KT(F, d0) do { _Pragma("unroll") for (int dd = 0; dd < 4; ++dd) { F[2 * dd] = ldf16(pt + ((d0) + dd) * 16 * 160); F[2 * dd + 1] = ldf16(pt + ((d0) + dd) * 16 * 160 + 64); } } while (0)
#define MM_WQ(F, ct) do { f32x4 acc = {0.f, 0.f, 0.f, 0.f}, accq = {0.f, 0.f, 0.f, 0.f}; \
        _Pragma("unroll") for (int kk = 0; kk < 4; ++kk) { acc = mfma16(F[kk], Sb[kk], acc); accq = mfma16(F[4 + kk], Sb[kk], accq); } \
        vn[ct][0] = bflo(uu[ct].x) - acc[0]; vn[ct][1] = bfhi(uu[ct].x) - acc[1]; vn[ct][2] = bflo(uu[ct].y) - acc[2]; vn[ct][3] = bfhi(uu[ct].y) - acc[3]; oo[ct] = accq; } while (0)
                LD_WQ(fa, 0);
                u32x2 uu[4];
#pragma unroll
                for (int ct = 0; ct < 4; ++ct) uu[ct] = *(const u32x2*)(buf + SC_UT + fr * 160 + (ct * 16 + fq * 4) * 2);
                bf16x8 Sb[4];
#pragma unroll
                for (int kk = 0; kk < 4; ++kk) Sb[kk] = pack2(S[2 * kk], S[2 * kk + 1]);
                f32x4 vn[4], oo[4];
                LD_WQ(fb, 1); __builtin_amdgcn_sched_barrier(0);
                MM_WQ(fa, 0); __builtin_amdgcn_sched_barrier(0);
                LD_WQ(fa, 2); __builtin_amdgcn_sched_barrier(0);
                MM_WQ(fb, 1); __builtin_amdgcn_sched_barrier(0);
                LD_WQ(fb, 3); __builtin_amdgcn_sched_barrier(0);
                MM_WQ(fa, 2); __builtin_amdgcn_sched_barrier(0);
                LD_QK(fa); __builtin_amdgcn_sched_barrier(0);
                MM_WQ(fb, 3); __builtin_amdgcn_sched_barrier(0);
                LD_KT(fb, 0); __builtin_amdgcn_sched_barrier(0);
                bf16x8 Vb[2]; Vb[0] = pack2(vn[0], vn[1]); Vb[1] = pack2(vn[2], vn[3]);
#pragma unroll
                for (int ct = 0; ct < 4; ++ct) { oo[ct] = mfma16(fa[2 * ct], Vb[0], oo[ct]); oo[ct] = mfma16(fa[2 * ct + 1], Vb[1], oo[ct]); }
                __builtin_amdgcn_sched_barrier(0);
                LD_KT(fa, 4); __builtin_amdgcn_sched_barrier(0);
#pragma unroll
                for (int dd = 0; dd < 4; ++dd) { S[dd] = S[dd] * egl; S[dd] = mfma16(fb[2 * dd], Vb[0], S[dd]); S[dd] = mfma16(fb[2 * dd + 1], Vb[1], S[dd]); }
                __builtin_amdgcn_sched_barrier(0);
#pragma unroll
                for (int dd = 0; dd < 4; ++dd) { S[4 + dd] = S[4 + dd] * egl; S[4 + dd] = mfma16(fa[2 * dd], Vb[0], S[4 + dd]); S[4 + dd] = mfma16(fa[2 * dd + 1], Vb[1], S[4 + dd]); }
#undef LD_WQ
#undef LD_QK
#undef LD_KT
#undef MM_WQ
                if (step >= 4) { bf16_t* ost = (bf16_t*)(smem + SC_OST + (step & 1) * 2048);
#pragma unroll
                    for (int ct = 0; ct < 4; ++ct) { const unsigned w0 = pk2(oo[ct][0], oo[ct][1]), w1 = pk2(oo[ct][2], oo[ct][3]); const int c0 = ct * 16 + fq * 4;
                        ost[(c0 + 0) * 16 + fr] = (bf16_t)(w0 & 0xffff); ost[(c0 + 1) * 16 + fr] = (bf16_t)(w0 >> 16); ost[(c0 + 2) * 16 + fr] = (bf16_t)(w1 & 0xffff); ost[(c0 + 3) * 16 + fr] = (bf16_t)(w1 >> 16); }
                }
            }
            SC_BARRIER();
        }
    } else {
        u32x4 tA[9], tB[9], tC[9]; float eA = 0.f, eB = 0.f, eC = 0.f;
#define SC_LOAD(T, E, st) do { const int rn_ = scan_rec(b, h, dir, (st)); const unsigned char* rec_ = rec_ptr(a, rn_); \
        _Pragma("unroll") for (int it = 0; it < 9; ++it) { const int p = tid - 64 + it * 448; \
            if (p < SC_NP) { const unsigned char* src = p < 3584 ? rec_ + p * 16 : rec_ + REC_UT + e0 * 128 + (p - 3584) * 16; T[it] = *(const u32x4*)src; } } \
        if (tid == 64) E = EGL[rn_]; } while (0)
#define SC_WRITE(T, E, st) do { char* buf_ = smem + ((st) & 1) * SC_BUF; if (tid == 64) *(float*)(buf_ + SC_EGL) = E; \
        _Pragma("unroll") for (int it = 0; it < 9; ++it) { const int p = tid - 64 + it * 448; \
            if (p < SC_NP) { int off; \
                if (p < 2048) off = (p >> 10) * 18432 + ((p & 1023) >> 4) * 288 + (p & 15) * 16; \
                else if (p < 3584) { const int q = p - 2048; off = SC_KTT + (q >> 3) * 160 + (q & 7) * 16; } \
                else { const int q = p - 3584; off = SC_UT + (q >> 3) * 160 + (q & 7) * 16; } \
                *(u32x4*)(buf_ + off) = T[it]; } } } while (0)
#define SC_ITER(T, E, st) do { if ((st) <= NSTEP) { \
        if ((st) + 1 < NSTEP) SC_WRITE(T, E, (st) + 1); \
        if ((st) - 1 >= 4 && (st) - 1 < NSTEP && tid < 192) { const int ps = (st) - 1, n = ps - 4, chunk = dir ? 255 - n : n; const int q = tid - 64, c = q >> 1, hf = q & 1; \
            const size_t tok = (size_t)b * SEQL + chunk * 64 + (dir ? 63 - c : c); \
            *(u32x4*)(Ob + tok * 512 + h * 128 + e0 + hf * 8) = *(const u32x4*)(smem + SC_OST + (ps & 1) * 2048 + c * 32 + hf * 16); } \
        if ((st) + 4 < NSTEP) SC_LOAD(T, E, (st) + 4); \
        SC_BARRIER(); } } while (0)
        SC_LOAD(tA, eA, 0); SC_LOAD(tB, eB, 1); SC_LOAD(tC, eC, 2);
        for (int st = -1; st <= NSTEP; st += 3) { SC_ITER(tA, eA, st); SC_ITER(tB, eB, st + 1); SC_ITER(tC, eC, st + 2); }
#undef SC_ITER
#undef SC_WRITE
#undef SC_LOAD
    }
}
constexpr int SC_LEAD = 12;
DI void scan_prefetch(const Args& a, int chain, int phase_, int nph) {
    const int tid = tidx(); unsigned acc = 0u;
    unsigned* prog = (unsigned*)(a.ws + OFF_PROG) + chain * 16; int budget = 8192;
    for (int step = phase_; step < 260; step += nph) {
        while (budget > 0 && (int)__hip_atomic_load(prog, __ATOMIC_RELAXED, __HIP_MEMORY_SCOPE_AGENT) + SC_LEAD < step) { __builtin_amdgcn_s_sleep(8); --budget; }
        const unsigned char* rec = rec_ptr(a, chain * 260 + step);
        u32x4 v[9];
#pragma unroll
        for (int it = 0; it < 9; ++it) v[it] = *(const u32x4*)(rec + (size_t)(tid + it * 512) * 16);
#pragma unroll
        for (int it = 0; it < 9; ++it) acc ^= v[it].x ^ v[it].y ^ v[it].z ^ v[it].w;
    }
    if (acc == 0x9e3779b9u) ((unsigned*)(a.ws))[tid] = acc;
}
DI void phase4(const Args& a, char* smem) {
    const int G = (int)gridDim.x, NS = G >= 256 ? 128 : (G >= 2 ? G / 2 : 0), NPF = G >= 256 ? 32 : 0;
    if (NS == 0) { for (int u = 0; u < 128; ++u) scan_unit(a, smem, u);
        { const u32x4* src = (const u32x4*)(a.ws + OFF_ROPE); u32x4* dst = (u32x4*)(smem + AT_ROPE); for (int i = tidx(); i < 2048; i += 512) dst[i] = src[i]; } __syncthreads();
        for (int u = 0; u < N_ATT_UNITS; ++u) attn_unit(a, smem, u);
        __syncthreads(); for (int g = P0_WT_EARLY; g < P0_WT_GROUPS; ++g) p0_wt_group(a, smem, g); return; }
    if ((int)blockIdx.x < NS) {
        if (NS == 128) { const int blk = (int)blockIdx.x, xcd = blk & 7, j = blk >> 3; scan_unit(a, smem, ((xcd * 2 + (j >> 3)) << 3) | (j & 7)); }
        else for (int u = blockIdx.x; u < 128; u += NS) scan_unit(a, smem, u); }
    else if ((int)blockIdx.x < NS + NPF) { const int p = (int)blockIdx.x - NS, xcd = p & 7, j = p >> 3;
        scan_prefetch(a, xcd * 2 + (j & 1), j >> 1, 2); }
    else { const int NA = G - NS - NPF, ab = (int)blockIdx.x - NS - NPF;
        { const u32x4* src = (const u32x4*)(a.ws + OFF_ROPE); u32x4* dst = (u32x4*)(smem + AT_ROPE); for (int i = tidx(); i < 2048; i += 512) dst[i] = src[i]; }
        __syncthreads();
        for (int u = ab; u < N_ATT_UNITS; u += NA) attn_unit(a, smem, u);
        __syncthreads(); for (int g = P0_WT_EARLY + ab; g < P0_WT_GROUPS; g += NA) p0_wt_group(a, smem, g); }
}

DI void phase5(const Args& a) {
    const int lane = tidx() & 63, wid = tidx() >> 6;
    const bf16_t* Of = (const bf16_t*)(a.ws + OFF_O); const bf16_t* Obk = Of + (size_t)NLAT * 512; const bf16_t* Z = (const bf16_t*)(a.ws + OFF_Z);
    bf16_t* MIX = (bf16_t*)(a.ws + OFF_H);
    float ng[8];
#pragma unroll
    for (int e = 0; e < 8; ++e) ng[e] = a.gdn_norm_g[(lane & 15) * 8 + e];
    const int rs = (int)gridDim.x * 8;
    u32x4 nf, nb, nz;
    { const int row0 = blockIdx.x * 8 + wid; if (row0 < NLAT) { nf = *(const u32x4*)(Of + (size_t)row0 * 512 + lane * 8); nb = *(const u32x4*)(Obk + (size_t)row0 * 512 + lane * 8); nz = *(const u32x4*)(Z + (size_t)row0 * 512 + lane * 8); } }
    for (int row = blockIdx.x * 8 + wid; row < NLAT; row += rs) {
        float of[8], ob[8], z[8];
        unpack8(nf, of); unpack8(nb, ob); unpack8(nz, z);
        { const int nrow = row + rs; if (nrow < NLAT) { nf = *(const u32x4*)(Of + (size_t)nrow * 512 + lane * 8); nb = *(const u32x4*)(Obk + (size_t)nrow * 512 + lane * 8); nz = *(const u32x4*)(Z + (size_t)nrow * 512 + lane * 8); } }
        float ss = 0.f;
#pragma unroll
        for (int e = 0; e < 8; ++e) { of[e] += ob[e]; ss += of[e] * of[e]; }
        ss += __shfl_xor(ss, 1); ss += __shfl_xor(ss, 2); ss += __shfl_xor(ss, 4); ss += __shfl_xor(ss, 8);
        const float r = rsqrtf(ss * (1.f / 128.f) + EPS);
#pragma unroll
        for (int e = 0; e < 8; ++e) of[e] = of[e] * r * ng[e] * siluf(z[e]);
        *(u32x4*)(MIX + (size_t)row * DM + 512 + lane * 8) = pack8(of);
    }
}

template <bool IN_F32, bool OUT_F32> DI void rowpass(const Args& a, const void* xin_v, void* xout_v, const float* gate_base, int gate_bstride, const float* post_g,
                const float* next_g, const float* nsh_base, const float* nsc_base, int n_bstride, bool has_next) {
    const int lane = tidx() & 63, wid = tidx() >> 6;
    const bf16_t* Y = (const bf16_t*)(a.ws + OFF_Y); const float* SSQ = (const float*)(a.ws + OFF_SSQ); bf16_t* H = (bf16_t*)(a.ws + OFF_H);
    const int rs = (int)gridDim.x * 8;
    const float* xin = (const float*)xin_v; const bf16_t* xin16 = (const bf16_t*)xin_v; float* xout = (float*)xout_v; bf16_t* xout16 = (bf16_t*)xout_v;
    f32x4 xA[4], xB[4], xC[4]; u32x2 bA[4], bB[4], bC[4], yA[4], yB[4], yC[4]; float sA = 0.f, sB = 0.f, sC = 0.f;
#define RP_LOAD(XF, XB, Yv, S, r) do { _Pragma("unroll") for (int i = 0; i < 4; ++i) { const int k = i * 256 + lane * 4; \
        if constexpr (IN_F32) XF[i] = *(const f32x4*)(xin + (size_t)(r) * DM + k); else XB[i] = *(const u32x2*)(xin16 + (size_t)(r) * DM + k); \
        Yv[i] = *(const u32x2*)(Y + (size_t)(r) * DM + k); } \
        S = lane < 16 ? SSQ[(size_t)(r) * 16 + lane] : 0.f; } while (0)
    f32x4 gp[4], n1[4], n0[4]; int cur_b = -1;
#define RP_PARAMS(b) do { const float* gate = gate_base + (size_t)(b) * gate_bstride; \
        _Pragma("unroll") for (int i = 0; i < 4; ++i) { const int k = i * 256 + lane * 4; const f32x4 gv = *(const f32x4*)(gate + k), pg = *(const f32x4*)(post_g + k); gp[i] = gv * pg; \
            if (has_next) { const f32x4 g = *(const f32x4*)(next_g + k), s1 = *(const f32x4*)(nsh_base + (size_t)(b) * n_bstride + k), c1 = *(const f32x4*)(nsc_base + (size_t)(b) * n_bstride + k); \
                n1[i] = g * (c1 + 1.f); n0[i] = s1; } } } while (0)
#define RP_COMP(XF, XB, Yv, S, row) do { \
        const int b = (row) / SEQL; if (b != cur_b) { RP_PARAMS(b); cur_b = b; } \
        const float ry = rsqrtf(wave_sum(S) * (1.f / 1024.f) + EPS); \
        f32x4 v[4]; float ss = 0.f; \
        _Pragma("unroll") for (int i = 0; i < 4; ++i) { const int k = i * 256 + lane * 4; \
            const f32x4 yv = {bflo(Yv[i].x), bfhi(Yv[i].x), bflo(Yv[i].y), bfhi(Yv[i].y)}; \
            f32x4 xv; if constexpr (IN_F32) xv = XF[i]; else xv = (f32x4){bflo(XB[i].x), bfhi(XB[i].x), bflo(XB[i].y), bfhi(XB[i].y)}; \
            _Pragma("unroll") for (int e = 0; e < 4; ++e) { v[i][e] = xv[e] + gp[i][e] * (yv[e] * ry); ss += v[i][e] * v[i][e]; } \
            if constexpr (OUT_F32) *(f32x4*)(xout + (size_t)(row) * DM + k) = v[i]; else { u32x2 xw; xw.x = pk2(v[i][0], v[i][1]); xw.y = pk2(v[i][2], v[i][3]); *(u32x2*)(xout16 + (size_t)(row) * DM + k) = xw; } } \
        if (has_next) { \
            ss = wave_sum(ss); const float r = rsqrtf(ss * (1.f / 1024.f) + EPS); \
            _Pragma("unroll") for (int i = 0; i < 4; ++i) { const int k = i * 256 + lane * 4; float o[4]; \
                _Pragma("unroll") for (int e = 0; e < 4; ++e) o[e] = v[i][e] * r * n1[i][e] + n0[i][e]; \
                u32x2 w; w.x = pk2(o[0], o[1]); w.y = pk2(o[2], o[3]); *(u32x2*)(H + (size_t)(row) * DM + k) = w; } } } while (0)
    const int r0 = blockIdx.x * 8 + wid;
    if (r0 < NLAT) RP_LOAD(xA, bA, yA, sA, r0);
    if (r0 + rs < NLAT) RP_LOAD(xB, bB, yB, sB, r0 + rs);
    if (r0 + 2 * rs < NLAT) RP_LOAD(xC, bC, yC, sC, r0 + 2 * rs);
    for (int row = r0; row < NLAT; row += 3 * rs) {
        RP_COMP(xA, bA, yA, sA, row); if (row + 3 * rs < NLAT) RP_LOAD(xA, bA, yA, sA, row + 3 * rs);
        if (row + rs < NLAT) { RP_COMP(xB, bB, yB, sB, row + rs); if (row + 4 * rs < NLAT) RP_LOAD(xB, bB, yB, sB, row + 4 * rs); }
        if (row + 2 * rs < NLAT) { RP_COMP(xC, bC, yC, sC, row + 2 * rs); if (row + 5 * rs < NLAT) RP_LOAD(xC, bC, yC, sC, row + 5 * rs); }
    }
#undef RP_LOAD
#undef RP_COMP
#undef RP_PARAMS
}

DI void phase12(const Args& a) {
    const int lane = tidx() & 63, wid = tidx() >> 6;
    const bf16_t* CU = (const bf16_t*)(a.ws + OFF_BIG); const bf16_t* BG = CU + (size_t)NLAT * DM; bf16_t* MIX = (bf16_t*)(a.ws + OFF_H);
    float w0[2][8], w1[2][8], w2[2][8];
#pragma unroll
    for (int part = 0; part < 2; ++part)
#pragma unroll
        for (int e = 0; e < 8; ++e) { const int ch = part * 512 + lane * 8 + e; w0[part][e] = a.sc_conv_w[ch]; w1[part][e] = a.sc_conv_w[1024 + ch]; w2[part][e] = a.sc_conv_w[2048 + ch]; }
    const u32x4 zero4 = {0u, 0u, 0u, 0u};
    for (int blk = blockIdx.x * 8 + wid; blk < NLAT / 16; blk += gridDim.x * 8) {
        const int r0 = blk * 16, t0 = r0 & (SEQL - 1);
        u32x4 xp[2], xc[2], xn[2], xnn[2], bg[2], bgn[2], bgnn[2];
#pragma unroll
        for (int part = 0; part < 2; ++part) { const bf16_t* p = CU + (size_t)r0 * DM + part * 512 + lane * 8; const bf16_t* pb = BG + (size_t)r0 * DM + part * 512 + lane * 8;
            xc[part] = *(const u32x4*)p; xp[part] = t0 > 0 ? *(const u32x4*)(p - DM) : zero4; xn[part] = t0 + 1 < SEQL ? *(const u32x4*)(p + DM) : zero4;
            bg[part] = *(const u32x4*)pb; bgn[part] = *(const u32x4*)(pb + DM); }
        for (int i = 0; i < 16; ++i) {
            const int row = r0 + i, t = t0 + i;
#pragma unroll
            for (int part = 0; part < 2; ++part) { xnn[part] = (i < 15 && t + 2 < SEQL) ? *(const u32x4*)(CU + (size_t)(row + 2) * DM + part * 512 + lane * 8) : zero4;
                bgnn[part] = i < 14 ? *(const u32x4*)(BG + (size_t)(row + 2) * DM + part * 512 + lane * 8) : zero4; }
#pragma unroll
            for (int part = 0; part < 2; ++part) {
                float fc[8], fp[8], fn[8], fb[8], o[8]; unpack8(xc[part], fc); unpack8(xp[part], fp); unpack8(xn[part], fn); unpack8(bg[part], fb);
#pragma unroll
                for (int e = 0; e < 8; ++e) o[e] = fb[e] * (w0[part][e] * fp[e] + w1[part][e] * fc[e] + w2[part][e] * fn[e]);
                *(u32x4*)(MIX + (size_t)row * DM + part * 512 + lane * 8) = pack8(o);
            }
#pragma unroll
            for (int part = 0; part < 2; ++part) { xp[part] = xc[part]; xc[part] = xn[part]; xn[part] = xnn[part]; bg[part] = bgn[part]; bgn[part] = bgnn[part]; }
        }
    }
}

#ifndef ONLY_PH
#define ONLY_PH -1
#endif
#define PHASE_ON(n) ((ONLY_PH) < 0 || (ONLY_PH) == (n))
constexpr int N_PHASES = 18;
__global__ void __launch_bounds__(512, 2) fwd_megakernel(Args a) {
    extern __shared__ __attribute__((aligned(16))) char smem[];
    cg::grid_group grid = cg::this_grid();
    const float* MOD = (const float*)(a.ws + OFF_MOD);
    const bf16_t* WT = (const bf16_t*)(a.ws + OFF_WT);
    bf16_t* H = (bf16_t*)(a.ws + OFF_H);
    bf16_t* BIG = (bf16_t*)(a.ws + OFF_BIG);
    bf16_t* Y = (bf16_t*)(a.ws + OFF_Y); float* SSQ = (float*)(a.ws + OFF_SSQ);
    const int lo = a.ph_lo, hi = a.ph_hi;
#define IN(k) (PHASE_ON(k) && lo <= (k) && (k) < hi)
#define SEAM(k) do { if (lo <= (k) && (k) + 1 < hi) grid.sync(); } while (0)
#ifndef DBL
#define DBL 0u
#endif
#ifndef XSYNC
#define XSYNC 0
#endif
#define PH(k, ...) do { if (IN(k)) { __VA_ARGS__; if (((DBL) >> (k)) & 1u) { grid.sync(); __VA_ARGS__; } } SEAM(k); } while (0)
    PH(0, phase0(a, smem););
    PH(1, phase1(a, smem););
    PH(2, { EpiProj E; E.AT = (bf16_t*)((unsigned char*)a.out + OUT_ATT); E.P = BIG; E.Z = (bf16_t*)(a.ws + OFF_Z); run_gemm(smem, H, WT + WT_IN, MROWS, NPROJ, 1024, E); });
    PH(3, phase3a(a, smem););
    PH(4, phase3b(a, smem););
    PH(5, phase4(a, smem););
    PH(6, phase5(a););
    PH(7, { EpiY E; E.Y = Y; E.SSQ = SSQ; run_gemm(smem, H, WT + WT_OUT, NLAT, 1024, 1024, E); });
    PH(8, rowpass<true, false>(a, a.x, a.ws + OFF_X16, MOD + 2 * 1024, 6144, a.post_mix_g, a.pre_ffn_g, MOD + 3 * 1024, MOD + 4 * 1024, 6144, true););
    PH(9, { EpiAct E; E.O = BIG; run_gemm(smem, H, WT + WT_GU0, NLAT, 5632, 1024, E); });
    PH(10, { EpiY E; E.Y = Y; E.SSQ = SSQ; run_gemm(smem, BIG, WT + WT_DN0, NLAT, 1024, FF, E); });
    PH(11, rowpass<false, false>(a, a.ws + OFF_X16, a.ws + OFF_X16, MOD + 5 * 1024, 6144, a.post_ffn_g, a.pre_mix_g + 1024, MOD + 3 * 6144 + 0 * 1024, MOD + 3 * 6144 + 1 * 1024, 6144, true););
    PH(12, { EpiSc E; E.CU = BIG; E.BG = BIG + (size_t)NLAT * DM; run_gemm(smem, H, WT + WT_SCIN, NLAT, 3072, 1024, E); });
    PH(13, phase12(a););
    PH(14, { EpiY E; E.Y = Y; E.SSQ = SSQ; run_gemm(smem, H, WT + WT_SCOUT, NLAT, 1024, 1024, E); });
    PH(15, rowpass<false, false>(a, a.ws + OFF_X16, a.ws + OFF_X16, MOD + 3 * 6144 + 2 * 1024, 6144, a.post_mix_g + 1024, a.pre_ffn_g + 1024, MOD + 3 * 6144 + 3 * 1024, MOD + 3 * 6144 + 4 * 1024, 6144, true););
    PH(16, { EpiAct E; E.O = BIG; run_gemm(smem, H, WT + WT_GU1, NLAT, 5632, 1024, E); });
    PH(17, { EpiY E; E.Y = Y; E.SSQ = SSQ; run_gemm(smem, BIG, WT + WT_DN1, NLAT, 1024, FF, E); });
    PH(18, rowpass<false, true>(a, a.ws + OFF_X16, a.out, MOD + 3 * 6144 + 5 * 1024, 6144, a.post_ffn_g + 1024, nullptr, nullptr, nullptr, 0, false););
}

extern "C" void kernel_launch(void* const* d_in, const int* in_sizes, int n_in, void* d_out, int out_size, void* d_ws, size_t ws_size, hipStream_t stream) {
    static int grid = 0;
    if (grid == 0) {
        if (n_in != 23 || ws_size < WS_NEED) { fprintf(stderr, "kernel_launch: unexpected n_in %d / ws %zu\n", n_in, ws_size); grid = -1; return; }
        int dev = 0, cus = 0, per_cu = 0;
        hipGetDevice(&dev); hipDeviceGetAttribute(&cus, hipDeviceAttributeMultiprocessorCount, dev);
        hipFuncSetAttribute((const void*)fwd_megakernel, hipFuncAttributeMaxDynamicSharedMemorySize, LDS_BYTES);
        hipOccupancyMaxActiveBlocksPerMultiprocessor(&per_cu, (const void*)fwd_megakernel, 512, LDS_BYTES);
        if (per_cu < 1) { fprintf(stderr, "kernel_launch: occupancy query says %d blocks/CU\n", per_cu); per_cu = 1; }
        grid = cus * 1;
        (void)hipGetLastError();
    }
    if (grid < 0) return;
    Args a{};
    const float** f = (const float**)&a;
    for (int i = 0; i < 23; ++i) f[i] = (const float*)d_in[i];
    a.out = (float*)d_out; a.ws = (unsigned char*)d_ws; a.ph_lo = 0; a.ph_hi = N_PHASES + 1;
    void* args[] = {&a};
    hipError_t e = hipLaunchCooperativeKernel((const void*)fwd_megakernel, dim3(grid), dim3(512), args, LDS_BYTES, stream);
    if (e != hipSuccess) fprintf(stderr, "cooperative launch failed: %s (grid %d)\n", hipGetErrorString(e), grid);
}
```

```cpp
#include <hip/hip_runtime.h>
#include <hip/hip_cooperative_groups.h>
#include <cstdio>
#include <cstdint>
namespace cg = cooperative_groups;

__device__ __forceinline__ int tidx() { int t = (int)threadIdx.x; asm volatile("" : "+v"(t)); return t & 511; }
namespace pg8 {
#define PG8_LAS __attribute__((address_space(3)))
typedef unsigned short bf16_t;
typedef short bf16x8 __attribute__((ext_vector_type(8)));
typedef float f32x4 __attribute__((ext_vector_type(4)));
typedef unsigned u32x4 __attribute__((ext_vector_type(4)));
constexpr int BM = 256, BK = 64, HALF = 128, HTB = HALF * BK * 2  , STAGE_BYTES = 8 * HTB, NXCD = 8, WGM = 8;

__host__ __device__ __forceinline__ int lds_byte(int r, int c) { const int st = (r >> 4) * 2 + (c >> 5), rr = r & 15, cc = c & 31, ob = rr * 64 + cc * 2; return st * 1024 + (ob ^ (((ob >> 9) & 1) << 5)); }
__host__ __device__ __forceinline__ void stage_rc(int b, int& R, int& C) { const int st = b / 1024, sb = b % 1024, swz = sb ^ (((sb >> 9) & 1) << 5); R = (st >> 1) * 16 + swz / 64; C = (st & 1) * 32 + (swz % 64) / 2; }
__host__ __device__ __forceinline__ int perm32(int rho) { const int n = rho >> 4, i = rho & 15; return 8 * (i >> 2) + 4 * n + (i & 3); }

struct Unit { int pm, pn; };
struct Gemm { const bf16_t* A; const bf16_t* Bt; int M, N, K; };

struct StaticOrder {
    int nM, nN, nwg, G, c;
    __host__ __device__ void init(int M, int N, int G_, int c_) { nM = M / BM; nN = N / BM; nwg = nM * nN; G = G_; c = c_; }
    __host__ __device__ bool next(int i, Unit& u) const {
        const long L = (long)i * G + c; if (L >= nwg) return false;
        int wgid = (int)L; { const int q = nwg / NXCD, r = nwg % NXCD, xcd = wgid % NXCD, off = wgid / NXCD; wgid = (xcd < r ? xcd * (q + 1) : r * (q + 1) + (xcd - r) * q) + off; }
        const int nig = WGM * nN, gid = wgid / nig, fm = gid * WGM, gsz = (nM - fm) < WGM ? (nM - fm) : WGM;
        u.pm = fm + ((wgid % nig) % gsz); u.pn = (wgid % nig) / gsz; return true;
    }
    __device__ __forceinline__ void a_ready(const Unit&) const {}
    __device__ __forceinline__ void done(const Unit&) const {}
};

__device__ __forceinline__ unsigned cvt_pk_bf16(float lo, float hi) { unsigned r; asm volatile("v_cvt_pk_bf16_f32 %0, %1, %2" : "=v"(r) : "v"(lo), "v"(hi)); return r; }
template <class Epi, class Sched, bool ALIGN_EPI = false, bool SP2 = false>
__device__ __forceinline__ void gemm_phase(PG8_LAS unsigned char* lds, const Gemm g, const Sched& S, const Epi& E) {
    const int tid = tidx(), wid = __builtin_amdgcn_readfirstlane(tid >> 6), lane = tid & 63, wr = wid >> 2, wc = wid & 3, fr = lane & 15, fq = lane >> 4;
    const int K = g.K, nt = K / BK;
    unsigned voffA[2], voffB[2];
#pragma unroll
    for (int i = 0; i < 2; ++i) { int R, C; stage_rc(tid * 16 + i * 8192, R, C); const int Rb = Epi::PERM ? ((R & ~31) + perm32(R & 31)) : R;
        voffA[i] = (unsigned)(R * K + C) * 2u; voffB[i] = (unsigned)(Rb * K + C) * 2u; }
    const size_t kstep = (size_t)(BK * 2);
    const size_t hstep = (size_t)HALF * K * 2;
    const size_t tstep = 2 * hstep;
    const unsigned ldsw = (unsigned)wid * 1024u;
    const int aoff = lds_byte(wr * 64 + fr, fq * 8), boff = lds_byte(wc * 32 + fr, fq * 8);
#define PG8_SA(b, h) (((b) * 2 + (h)) * HTB)
#define PG8_SB(b, h) ((4 + (b) * 2 + (h)) * HTB)
#define PG8_STAGE(bufoff, gbase, voff) do { _Pragma("unroll") for (int _i = 0; _i < 2; ++_i) \
        __builtin_amdgcn_global_load_lds((const unsigned*)((const char*)(gbase) + (voff)[_i]), (PG8_LAS unsigned*)(lds + (bufoff) + ldsw + _i * 8192), 16, 0, 0); } while (0)
#define PG8_LDA(dst, b, h) do { _Pragma("unroll") for (int m = 0; m < 4; ++m) _Pragma("unroll") for (int k = 0; k < 2; ++k) dst[m][k] = *(const PG8_LAS bf16x8*)(lds + PG8_SA(b, h) + aoff + m * 2048 + k * 1024); } while (0)
#define PG8_LDB(dst, b, h) do { _Pragma("unroll") for (int n = 0; n < 2; ++n) _Pragma("unroll") for (int k = 0; k < 2; ++k) dst[n][k] = *(const PG8_LAS bf16x8*)(lds + PG8_SB(b, h) + boff + n * 2048 + k * 1024); } while (0)
#define PG8_MMA(ai, bj, At, Bt) do { __builtin_amdgcn_s_setprio(1); _Pragma("unroll") for (int m = 0; m < 4; ++m) _Pragma("unroll") for (int n = 0; n < 2; ++n) _Pragma("unroll") for (int k = 0; k < 2; ++k) \
        acc[ai][bj][m][n] = __builtin_amdgcn_mfma_f32_16x16x32_bf16(Bt[n][k], At[m][k], acc[ai][bj][m][n], 0, 0, 0); __builtin_amdgcn_s_setprio(0); } while (0)
#define PG8_WAIT_V(n) asm volatile("s_waitcnt vmcnt(" #n ")" ::: "memory")
#define PG8_WAIT_L(n) asm volatile("s_waitcnt lgkmcnt(" #n ")" ::: "memory")
#define PG8_BAR __builtin_amdgcn_s_barrier()
#define PG8_SCHED __builtin_amdgcn_sched_barrier(0)
    Unit cur, nxt; int ui = 0;
    if (!S.next(0, cur)) return;
    f32x4 acc[2][2][4][2];
#pragma unroll
    for (int a = 0; a < 2; ++a)
#pragma unroll
        for (int b = 0; b < 2; ++b)
#pragma unroll
            for (int m = 0; m < 4; ++m)
#pragma unroll
                for (int n = 0; n < 2; ++n) acc[a][b][m][n] = (f32x4){0.f, 0.f, 0.f, 0.f};
    bf16x8 At[4][2], B0[2][2], B1[2][2];
    const char* cA = (const char*)g.A + (size_t)cur.pm * tstep; const char* cB = (const char*)g.Bt + (size_t)cur.pn * tstep;
    S.a_ready(cur);
    if constexpr (SP2) {
        PG8_STAGE(PG8_SB(0, 0), cB, voffB); PG8_STAGE(PG8_SB(0, 1), cB + hstep, voffB); PG8_STAGE(PG8_SA(0, 0), cA, voffA); PG8_STAGE(PG8_SA(0, 1), cA + hstep, voffA);
        if (wr == 1) PG8_BAR;
        PG8_WAIT_V(2); PG8_BAR;
        PG8_STAGE(PG8_SB(1, 0), cB + kstep, voffB); PG8_STAGE(PG8_SA(1, 0), cA + kstep, voffA); PG8_STAGE(PG8_SB(1, 1), cB + hstep + kstep, voffB);
        PG8_WAIT_V(6); PG8_BAR;
    } else {
        PG8_STAGE(PG8_SB(0, 0), cB, voffB); PG8_STAGE(PG8_SA(0, 0), cA, voffA); PG8_STAGE(PG8_SB(0, 1), cB + hstep, voffB); PG8_STAGE(PG8_SA(0, 1), cA + hstep, voffA);
        if (wr == 1) PG8_BAR;
        PG8_WAIT_V(4); PG8_BAR;
        PG8_STAGE(PG8_SB(1, 0), cB + kstep, voffB); PG8_STAGE(PG8_SA(1, 0), cA + kstep, voffA); PG8_STAGE(PG8_SB(1, 1), cB + hstep + kstep, voffB);
        PG8_WAIT_V(6); PG8_BAR;
    }
    for (;;) {
        const bool has_next = S.next(ui + 1, nxt);
        const char* nA = has_next ? (const char*)g.A + (size_t)nxt.pm * tstep : cA; const char* nB = has_next ? (const char*)g.Bt + (size_t)nxt.pn * tstep : cB;
        for (int t = 0; t < nt; t += 2) {
            const bool last = (t == nt - 2);
            const char* a1 = cA + (size_t)(t + 1) * kstep;
            const char* a2 = last ? nA : cA + (size_t)(t + 2) * kstep; const char* b2 = last ? nB : cB + (size_t)(t + 2) * kstep;
            const char* a3 = a2 + kstep; const char* b3 = b2 + kstep;
            if (last && has_next) S.a_ready(nxt);
            if constexpr (SP2) {
            PG8_LDB(B0, 0, 0); PG8_LDB(B1, 0, 1); PG8_SCHED; PG8_LDA(At, 0, 0); PG8_STAGE(PG8_SA(1, 1), a1 + hstep, voffA);
            PG8_WAIT_V(8); PG8_WAIT_L(0); PG8_BAR; PG8_MMA(0, 0, At, B0); PG8_MMA(0, 1, At, B1); PG8_BAR; PG8_SCHED;
            PG8_LDA(At, 0, 1); PG8_STAGE(PG8_SB(0, 0), b2, voffB); PG8_STAGE(PG8_SB(0, 1), b2 + hstep, voffB); PG8_STAGE(PG8_SA(0, 0), a2, voffA);
            PG8_WAIT_V(8); PG8_WAIT_L(0); PG8_BAR; PG8_MMA(1, 0, At, B0); PG8_MMA(1, 1, At, B1); PG8_BAR; PG8_SCHED;
            PG8_LDB(B0, 1, 0); PG8_LDB(B1, 1, 1); PG8_SCHED; PG8_LDA(At, 1, 0); PG8_STAGE(PG8_SA(0, 1), a2 + hstep, voffA);
            PG8_WAIT_V(8); PG8_WAIT_L(0); PG8_BAR; PG8_MMA(0, 0, At, B0); PG8_MMA(0, 1, At, B1); PG8_BAR; PG8_SCHED;
            PG8_LDA(At, 1, 1); PG8_STAGE(PG8_SB(1, 0), b3, voffB); PG8_STAGE(PG8_SB(1, 1), b3 + hstep, voffB); PG8_STAGE(PG8_SA(1, 0), a3, voffA);
            PG8_WAIT_V(8); PG8_WAIT_L(0); PG8_BAR; PG8_MMA(1, 0, At, B0); PG8_MMA(1, 1, At, B1); PG8_BAR; PG8_SCHED;
            } else {
            PG8_LDB(B0, 0, 0); PG8_SCHED; PG8_LDA(At, 0, 0); PG8_STAGE(PG8_SA(1, 1), a1 + hstep, voffA);
            PG8_WAIT_L(8); PG8_BAR; PG8_WAIT_L(0); PG8_MMA(0, 0, At, B0); PG8_BAR; PG8_SCHED;
            PG8_LDB(B1, 0, 1); PG8_STAGE(PG8_SB(0, 0), b2, voffB);
            PG8_BAR; PG8_WAIT_L(0); PG8_MMA(0, 1, At, B1); PG8_BAR;
            PG8_LDA(At, 0, 1); PG8_STAGE(PG8_SA(0, 0), a2, voffA);
            PG8_BAR; PG8_WAIT_L(0); PG8_MMA(1, 0, At, B0); PG8_BAR; PG8_SCHED;
            PG8_STAGE(PG8_SB(0, 1), b2 + hstep, voffB);
            PG8_WAIT_V(6); PG8_BAR; PG8_MMA(1, 1, At, B1); PG8_BAR;
            PG8_LDB(B0, 1, 0); PG8_SCHED; PG8_LDA(At, 1, 0); PG8_STAGE(PG8_SA(0, 1), a2 + hstep, voffA);
            PG8_WAIT_L(8); PG8_BAR; PG8_WAIT_L(0); PG8_MMA(0, 0, At, B0); PG8_BAR; PG8_SCHED;
            PG8_LDB(B1, 1, 1); PG8_STAGE(PG8_SB(1, 0), b3, voffB);
            PG8_BAR; PG8_WAIT_L(0); PG8_MMA(0, 1, At, B1); PG8_BAR;
            PG8_LDA(At, 1, 1); PG8_STAGE(PG8_SA(1, 0), a3, voffA);
            PG8_BAR; PG8_WAIT_L(0); PG8_MMA(1, 0, At, B0); PG8_BAR; PG8_SCHED;
            PG8_STAGE(PG8_SB(1, 1), b3 + hstep, voffB);
            PG8_WAIT_V(6); PG8_BAR; PG8_MMA(1, 1, At, B1); PG8_BAR;
            }
        }
        if constexpr (ALIGN_EPI) { if (wr == 0) PG8_BAR; }
        if constexpr (!Epi::AFTER_DRAIN) { E(acc, cur, wr, wc, fr, fq); S.done(cur); }
        if (!has_next) break;
#pragma unroll
        for (int a = 0; a < 2; ++a)
#pragma unroll
            for (int b = 0; b < 2; ++b)
#pragma unroll
                for (int m = 0; m < 4; ++m)
#pragma unroll
                    for (int n = 0; n < 2; ++n) acc[a][b][m][n] = (f32x4){0.f, 0.f, 0.f, 0.f};
        cur = nxt; cA = nA; cB = nB; ++ui;
        if constexpr (ALIGN_EPI) { if (wr == 1) PG8_BAR; }
    }
    PG8_WAIT_V(0);
    if constexpr (!ALIGN_EPI) { if (wr == 0) PG8_BAR; }
    PG8_BAR;
    if constexpr (Epi::AFTER_DRAIN) { E.fused(acc, cur, wr, wc, fr, fq, lds, wid, lane); S.done(cur); }
#undef PG8_SA
#undef PG8_SB
#undef PG8_STAGE
#undef PG8_LDA
#undef PG8_LDB
#undef PG8_MMA
#undef PG8_WAIT_V
#undef PG8_WAIT_L
#undef PG8_BAR
#undef PG8_SCHED
}
}

using pg8::bf16_t; using pg8::bf16x8; using pg8::f32x4; using pg8::u32x4;
typedef unsigned u32x2 __attribute__((ext_vector_type(2)));
#define DI __device__ __forceinline__
#define LAS __attribute__((address_space(3)))
constexpr int DM = 1024, SEQL = 16384, NB = 2, NLAT = NB * SEQL, CTXL = 256, NCTX = NB * CTXL, MROWS = NLAT + NCTX;
constexpr int FF = 2816, NPROJ = 2816, PG_LD = 1536, ATT_LD = 768, HYIN = 2832;
constexpr size_t OUT_ATT = (size_t)40 << 20;
constexpr int NCHUNK = MROWS / 64;
constexpr int NREC = NCHUNK * 4 * 2;
constexpr int REC_BYTES = 73728, REC_W = 0, REC_QG = 16384, REC_KTT = 32768, REC_QK = 49152, REC_UT = 57344;
constexpr int REC_IN_WS = 3640;
constexpr float EPS = 1e-6f;
constexpr int LDS_BYTES = 163840;
constexpr size_t MiB = 1u << 20;
constexpr size_t OFF_MOD = 1 * MiB, OFF_ROPE = OFF_MOD + 512 * 1024, OFF_EGL = OFF_ROPE + 256 * 1024, OFF_AB = 2 * MiB, OFF_SSQ = 5 * MiB, OFF_WT = 8 * MiB;
constexpr size_t OFF_H = 58 * MiB, OFF_Z = 124 * MiB, OFF_QN = 157 * MiB, OFF_KN = 190 * MiB, OFF_VN = 223 * MiB, OFF_BIG = 256 * MiB, OFF_Y = 124 * MiB, OFF_O = 190 * MiB, OFF_X16 = 190 * MiB, OFF_PG = 157 * MiB;
constexpr size_t WS_NEED = 512 * MiB;
constexpr size_t OFF_PROG = OFF_EGL + 32 * 1024;
constexpr size_t WT_IN = 0, WT_OUT = WT_IN + (size_t)2816 * 1024, WT_GU0 = WT_OUT + (size_t)1024 * 1024, WT_DN0 = WT_GU0 + (size_t)5632 * 1024, WT_SCIN = WT_DN0 + (size_t)1024 * 2816,
                 WT_SCOUT = WT_SCIN + (size_t)3072 * 1024, WT_GU1 = WT_SCOUT + (size_t)1024 * 1024, WT_DN1 = WT_GU1 + (size_t)5632 * 1024, WT_END = WT_DN1 + (size_t)1024 * 2816;

struct Args {
    const float* x; const float* c; const float* ctx; const float* c_ctx; const float* ada_w; const float* ada_b; const float* pre_mix_g; const float* post_mix_g; const float* pre_ffn_g; const float* post_ffn_g;
    const float* hy_w_in; const float* hy_w_out; const float* attn_sink; const float* gdn_conv_w; const float* gdn_a_log; const float* gdn_dt_bias; const float* gdn_norm_g;
    const float* sc_w_in; const float* sc_conv_w; const float* sc_w_out; const float* ffn_w_gate; const float* ffn_w_up; const float* ffn_w_down;
    float* out; unsigned char* ws; int ph_lo, ph_hi;
};

DI unsigned f2bf(float f) { unsigned u = __float_as_uint(f); return (u + 0x7fffu + ((u >> 16) & 1u)) >> 16; }
typedef float f32x2_t __attribute__((ext_vector_type(2)));
typedef __bf16 bf16x2_t __attribute__((ext_vector_type(2)));
DI unsigned pk2(float lo, float hi) { f32x2_t v = {lo, hi}; bf16x2_t b = __builtin_convertvector(v, bf16x2_t); return __builtin_bit_cast(unsigned, b); }
DI float bflo(unsigned u) { return __uint_as_float(u << 16); }
DI float bfhi(unsigned u) { return __uint_as_float(u & 0xffff0000u); }
DI float bf1(bf16_t h) { return __uint_as_float(((unsigned)h) << 16); }
DI float wave_sum(float v) {
#pragma unroll
    for (int o = 32; o; o >>= 1) v += __shfl_xor(v, o);
    return v;
}
DI float siluf(float x) { return x * __builtin_amdgcn_rcpf(1.f + __expf(-x)); }
DI f32x4 mfma16(bf16x8 a, bf16x8 b, f32x4 c) { return __builtin_amdgcn_mfma_f32_16x16x32_bf16(a, b, c, 0, 0, 0); }
DI bf16x8 pack2(f32x4 a, f32x4 b) { u32x4 p; p.x = pk2(a[0], a[1]); p.y = pk2(a[2], a[3]); p.z = pk2(b[0], b[1]); p.w = pk2(b[2], b[3]); return __builtin_bit_cast(bf16x8, p); }
DI bf16x8 ldf16(const char* p) { return *(const bf16x8*)p; }
DI bf16x8 ldf8x2(const char* p) { u32x2 lo = *(const u32x2*)p; u32x2 hi = *(const u32x2*)(p + 32); u32x4 v; v.x = lo.x; v.y = lo.y; v.z = hi.x; v.w = hi.y; return __builtin_bit_cast(bf16x8, v); }
DI void unpack8(u32x4 v, float (&f)[8]) { f[0] = bflo(v.x); f[1] = bfhi(v.x); f[2] = bflo(v.y); f[3] = bfhi(v.y); f[4] = bflo(v.z); f[5] = bfhi(v.z); f[6] = bflo(v.w); f[7] = bfhi(v.w); }
DI u32x4 pack8(const float (&f)[8]) { u32x4 v; v.x = pk2(f[0], f[1]); v.y = pk2(f[2], f[3]); v.z = pk2(f[4], f[5]); v.w = pk2(f[6], f[7]); return v; }

DI unsigned char* rec_ptr(const Args& a, int r) { return r < REC_IN_WS ? a.ws + OFF_BIG + (size_t)r * REC_BYTES : (unsigned char*)a.out + (size_t)(r - REC_IN_WS) * REC_BYTES; }

struct EpiProj {
    static constexpr bool PERM = true, AFTER_DRAIN = false;
    bf16_t* AT; bf16_t* P; bf16_t* Z;
    DI void operator()(const f32x4 (&acc)[2][2][4][2], const pg8::Unit& u, int wr, int wc, int fr, int fq) const {
        const int row0 = u.pm * 256 + wr * 64 + fr; bf16_t* base; int ld, colt;
        if (u.pn < 3) { base = AT; ld = ATT_LD; colt = u.pn * 256; } else if (u.pn < 9) { base = P; ld = PG_LD; colt = (u.pn - 3) * 256; } else { base = Z; ld = 512; colt = (u.pn - 9) * 256; }
        const int col0 = colt + wc * 32 + 8 * fq;
#pragma unroll
        for (int ai = 0; ai < 2; ++ai)
#pragma unroll
            for (int m = 0; m < 4; ++m) { bf16_t* rowp = base + (size_t)(row0 + ai * 128 + m * 16) * ld + col0;
#pragma unroll
                for (int bj = 0; bj < 2; ++bj) { const f32x4 v0 = acc[ai][bj][m][0], v1 = acc[ai][bj][m][1]; u32x4 w;
                    w.x = pg8::cvt_pk_bf16(v0[0], v0[1]); w.y = pg8::cvt_pk_bf16(v0[2], v0[3]); w.z = pg8::cvt_pk_bf16(v1[0], v1[1]); w.w = pg8::cvt_pk_bf16(v1[2], v1[3]);
                    *(u32x4*)(rowp + bj * 128) = w; } }
    }
};
struct EpiAct {
    static constexpr bool PERM = true, AFTER_DRAIN = false;
    bf16_t* O;
    DI void operator()(const f32x4 (&acc)[2][2][4][2], const pg8::Unit& u, int wr, int wc, int fr, int fq) const {
        const int row0 = u.pm * 256 + wr * 64 + fr, col0 = u.pn * 128 + wc * 32 + 8 * fq;
#pragma unroll
        for (int ai = 0; ai < 2; ++ai)
#pragma unroll
            for (int m = 0; m < 4; ++m) { bf16_t* rowp = O + (size_t)(row0 + ai * 128 + m * 16) * FF + col0; float v[8];
#pragma unroll
                for (int n = 0; n < 2; ++n)
#pragma unroll
                    for (int e = 0; e < 4; ++e) v[4 * n + e] = siluf(acc[ai][0][m][n][e]) * acc[ai][1][m][n][e];
                u32x4 w; w.x = pg8::cvt_pk_bf16(v[0], v[1]); w.y = pg8::cvt_pk_bf16(v[2], v[3]); w.z = pg8::cvt_pk_bf16(v[4], v[5]); w.w = pg8::cvt_pk_bf16(v[6], v[7]);
                *(u32x4*)rowp = w; }
    }
};
struct EpiSc {
    static constexpr bool PERM = true, AFTER_DRAIN = false;
    bf16_t* CU; bf16_t* BG;
    DI void operator()(const f32x4 (&acc)[2][2][4][2], const pg8::Unit& u, int wr, int wc, int fr, int fq) const {
        const int row0 = u.pm * 256 + wr * 64 + fr;
        if (u.pn < 8) {
            const int col0 = u.pn * 128 + wc * 32 + 8 * fq;
#pragma unroll
            for (int ai = 0; ai < 2; ++ai)
#pragma unroll
                for (int m = 0; m < 4; ++m) { bf16_t* rowp = CU + (size_t)(row0 + ai * 128 + m * 16) * DM + col0; float v[8];
#pragma unroll
                    for (int n = 0; n < 2; ++n)
#pragma unroll
                        for (int e = 0; e < 4; ++e) v[4 * n + e] = acc[ai][0][m][n][e] * acc[ai][1][m][n][e];
                    u32x4 w; w.x = pg8::cvt_pk_bf16(v[0], v[1]); w.y = pg8::cvt_pk_bf16(v[2], v[3]); w.z = pg8::cvt_pk_bf16(v[4], v[5]); w.w = pg8::cvt_pk_bf16(v[6], v[7]);
                    *(u32x4*)rowp = w; }
        } else {
            const int col0 = (u.pn - 8) * 256 + wc * 32 + 8 * fq;
#pragma unroll
            for (int ai = 0; ai < 2; ++ai)
#pragma unroll
                for (int m = 0; m < 4; ++m) { bf16_t* rowp = BG + (size_t)(row0 + ai * 128 + m * 16) * DM + col0;
#pragma unroll
                    for (int bj = 0; bj < 2; ++bj) { const f32x4 v0 = acc[ai][bj][m][0], v1 = acc[ai][bj][m][1]; u32x4 w;
                        w.x = pg8::cvt_pk_bf16(v0[0], v0[1]); w.y = pg8::cvt_pk_bf16(v0[2], v0[3]); w.z = pg8::cvt_pk_bf16(v1[0], v1[1]); w.w = pg8::cvt_pk_bf16(v1[2], v1[3]);
                        *(u32x4*)(rowp + bj * 128) = w; } }
        }
    }
};
struct EpiY {
    static constexpr bool PERM = true, AFTER_DRAIN = false;
    bf16_t* Y; float* SSQ;
    DI void operator()(const f32x4 (&acc)[2][2][4][2], const pg8::Unit& u, int wr, int wc, int fr, int fq) const {
        const int row0 = u.pm * 256 + wr * 64 + fr, col0 = u.pn * 256 + wc * 32 + 8 * fq;
#pragma unroll
        for (int ai = 0; ai < 2; ++ai)
#pragma unroll
            for (int m = 0; m < 4; ++m) { const int row = row0 + ai * 128 + m * 16; bf16_t* rowp = Y + (size_t)row * DM + col0; float s = 0.f;
#pragma unroll
                for (int bj = 0; bj < 2; ++bj) { const f32x4 v0 = acc[ai][bj][m][0], v1 = acc[ai][bj][m][1]; u32x4 w;
                    w.x = pg8::cvt_pk_bf16(v0[0], v0[1]); w.y = pg8::cvt_pk_bf16(v0[2], v0[3]); w.z = pg8::cvt_pk_bf16(v1[0], v1[1]); w.w = pg8::cvt_pk_bf16(v1[2], v1[3]);
                    *(u32x4*)(rowp + bj * 128) = w;
                    s += v0[0] * v0[0] + v0[1] * v0[1] + v0[2] * v0[2] + v0[3] * v0[3] + v1[0] * v1[0] + v1[1] * v1[1] + v1[2] * v1[2] + v1[3] * v1[3]; }
                s += __shfl_xor(s, 16); s += __shfl_xor(s, 32);
                if (fq == 0) SSQ[(size_t)row * 16 + u.pn * 4 + wc] = s; }
    }
};

template <class Epi> DI void run_gemm(char* smem, const bf16_t* A, const bf16_t* Bt, int M, int N, int K, const Epi& E) {
    pg8::Gemm g; g.A = A; g.Bt = Bt; g.M = M; g.N = N; g.K = K;
    pg8::StaticOrder S; S.init(M, N, (int)gridDim.x, (int)blockIdx.x);
    pg8::gemm_phase<Epi, pg8::StaticOrder, false, true>((PG8_LAS unsigned char*)smem, g, S, E);
    __syncthreads();
}

DI void p0_ada_unit(const Args& a, char* smem, int u) {
    const int l = u / 96, col0 = (u % 96) * 64, tid = tidx();
    float* sc = (float*)smem;
    float* red = (float*)(smem + 12288);
    for (int i = tid; i < 3072; i += 512) { const int cd = i >> 10, k = i & 1023; const float v = cd < 2 ? a.c[cd * DM + k] : a.c_ctx[k]; sc[i] = siluf(v); }
    __syncthreads();
    const int col = tid & 63, kq = tid >> 6;
    const float* W = a.ada_w + (size_t)l * DM * 6144 + col0 + col;
    float s0 = 0.f, s1 = 0.f, s2 = 0.f;
    for (int k0 = kq * 128; k0 < kq * 128 + 128; k0 += 16) { float w[16];
#pragma unroll
        for (int j = 0; j < 16; ++j) w[j] = W[(size_t)(k0 + j) * 6144];
#pragma unroll
        for (int j = 0; j < 16; ++j) { s0 += sc[k0 + j] * w[j]; s1 += sc[1024 + k0 + j] * w[j]; s2 += sc[2048 + k0 + j] * w[j]; } }
    red[(kq * 3 + 0) * 64 + col] = s0; red[(kq * 3 + 1) * 64 + col] = s1; red[(kq * 3 + 2) * 64 + col] = s2;
    __syncthreads();
    if (tid < 192) { const int cd = tid >> 6, cc = tid & 63; float s = 0.f;
        for (int q = 0; q < 8; ++q) s += red[(q * 3 + cd) * 64 + cc];
        float* MOD = (float*)(a.ws + OFF_MOD);
        MOD[((size_t)l * 3 + cd) * 6144 + col0 + cc] = s + a.ada_b[l * 6144 + col0 + cc]; }
    __syncthreads();
}
DI void p0_rope_unit(const Args& a) {
    if (tidx() < 16) __hip_atomic_store((unsigned*)(a.ws + OFF_PROG) + tidx() * 16, 0u, __ATOMIC_RELAXED, __HIP_MEMORY_SCOPE_AGENT);
    float2* R = (float2*)(a.ws + OFF_ROPE);
    for (int i = tidx(); i < 4096; i += 512) { const int p = i >> 4, f = i & 15;
        const float inv = powf(10000.f, -(float)f / 16.f); const float ang = (float)p * inv;
        R[i] = make_float2(cosf(ang), sinf(ang)); }
}
struct WtTile { const float* src; bf16_t* dst; int ldn, K, scol0, n0, k0; };
DI WtTile p0_wt_desc(const Args& a, int t) {
    bf16_t* WT = (bf16_t*)(a.ws + OFF_WT);
    const int T_IN = 44 * 16, T_OUT = 16 * 16, T_GU = 88 * 16, T_DN = 16 * 44, T_SCIN = 48 * 16, T_SCOUT = 16 * 16;
    int m = 0; int rem = t;
    if (rem >= T_IN) { rem -= T_IN; m = 1;
      if (rem >= T_OUT) { rem -= T_OUT; m = 2;
        if (rem >= T_GU) { rem -= T_GU; m = 3;
          if (rem >= T_DN) { rem -= T_DN; m = 4;
            if (rem >= T_SCIN) { rem -= T_SCIN; m = 5;
              if (rem >= T_SCOUT) { rem -= T_SCOUT; m = 6;
                if (rem >= T_GU) { rem -= T_GU; m = 7; } } } } } } }
    WtTile d; int nb, kb;
    if (m == 0) { d.K = 1024; nb = rem / 16; kb = rem % 16; d.src = a.hy_w_in; d.ldn = HYIN; d.scol0 = nb * 64; d.dst = WT + WT_IN; }
    else if (m == 1) { d.K = 1024; nb = rem / 16; kb = rem % 16; d.src = a.hy_w_out; d.ldn = 1024; d.scol0 = nb * 64; d.dst = WT + WT_OUT; }
    else if (m == 2 || m == 6) { const int l = m == 2 ? 0 : 1; d.K = 1024; nb = rem / 16; kb = rem % 16; const int n0 = nb * 64, pn = n0 >> 8, sg = (n0 >> 7) & 1, i0 = n0 & 127;
        d.src = (sg ? a.ffn_w_up : a.ffn_w_gate) + (size_t)l * DM * FF; d.ldn = FF; d.scol0 = pn * 128 + i0; d.dst = WT + (l ? WT_GU1 : WT_GU0); }
    else if (m == 3 || m == 7) { const int l = m == 3 ? 0 : 1; d.K = 2816; nb = rem / 44; kb = rem % 44; d.src = a.ffn_w_down + (size_t)l * FF * DM; d.ldn = 1024; d.scol0 = nb * 64; d.dst = WT + (l ? WT_DN1 : WT_DN0); }
    else if (m == 4) { d.K = 1024; nb = rem / 16; kb = rem % 16; const int n0 = nb * 64; d.src = a.sc_w_in; d.ldn = 3072; d.dst = WT + WT_SCIN;
        if (n0 < 2048) { const int pn = n0 >> 8, sg = (n0 >> 7) & 1, i0 = n0 & 127; d.scol0 = (sg ? 2048 : 1024) + pn * 128 + i0; } else d.scol0 = n0 - 2048; }
    else { d.K = 1024; nb = rem / 16; kb = rem % 16; d.src = a.sc_w_out; d.ldn = 1024; d.scol0 = nb * 64; d.dst = WT + WT_SCOUT; }
    d.n0 = nb * 64; d.k0 = kb * 64; return d;
}
constexpr int P0_WT_TILES = 44 * 16 + 16 * 16 + 88 * 16 + 16 * 44 + 48 * 16 + 16 * 16 + 88 * 16 + 16 * 44;
constexpr int P0_WT_GROUPS = P0_WT_TILES / 4, P0_WT_EARLY = 44 * 16 / 4;
DI void p0_wt_group(const Args& a, char* smem, int g) {
    const int tid = tidx(); float* T = (float*)smem;
    f32x4 v0[4], v1[4];
#pragma unroll
    for (int j = 0; j < 4; ++j) { const WtTile d = p0_wt_desc(a, g * 4 + j); const int k = tid >> 3, ns = (tid & 7) * 8; const float* p = d.src + (size_t)(d.k0 + k) * d.ldn + d.scol0 + ns;
        v0[j] = *(const f32x4*)p; v1[j] = *(const f32x4*)(p + 4); }
#pragma unroll
    for (int j = 0; j < 4; ++j) { const int k = tid >> 3, ns = (tid & 7) * 8; float* t = T + j * 4160 + k * 65 + ns;
        t[0] = v0[j][0]; t[1] = v0[j][1]; t[2] = v0[j][2]; t[3] = v0[j][3]; t[4] = v1[j][0]; t[5] = v1[j][1]; t[6] = v1[j][2]; t[7] = v1[j][3]; }
    __syncthreads();
#pragma unroll
    for (int j = 0; j < 4; ++j) { const WtTile d = p0_wt_desc(a, g * 4 + j); const int n = tid >> 3, ks = (tid & 7) * 8; float f[8];
#pragma unroll
        for (int e = 0; e < 8; ++e) f[e] = T[j * 4160 + (ks + e) * 65 + n];
        *(u32x4*)(d.dst + (size_t)(d.n0 + n) * d.K + d.k0 + ks) = pack8(f); }
    __syncthreads();
}
DI void phase0(const Args& a, char* smem) {
    for (int u = blockIdx.x; u < 193 + P0_WT_EARLY; u += gridDim.x) {
        if (u < 192) p0_ada_unit(a, smem, u); else if (u == 192) p0_rope_unit(a); else p0_wt_group(a, smem, u - 193);
    }
}

DI void phase1(const Args& a, char* smem) {
    float* WAB = (float*)smem;
    const int tid = tidx(), lane = tid & 63, wid = tid >> 6;
    for (int i = tid; i < 16384; i += 512) { const int k = i >> 4, j = i & 15; WAB[j * 1024 + k] = a.hy_w_in[(size_t)k * HYIN + 2816 + j]; }
    __syncthreads();
    const float* MOD = (const float*)(a.ws + OFF_MOD);
    bf16_t* H = (bf16_t*)(a.ws + OFF_H); float* AB = (float*)(a.ws + OFF_AB);
    f32x4 m1[4], m0[4]; int cur_cd = -1;
    const int rs = (int)gridDim.x * 8;
    f32x4 nv[4];
    { const int row0 = blockIdx.x * 8 + wid; if (row0 < MROWS) { const float* src0 = row0 < NLAT ? a.x + (size_t)row0 * DM : a.ctx + (size_t)(row0 - NLAT) * DM;
#pragma unroll
        for (int i = 0; i < 4; ++i) nv[i] = *(const f32x4*)(src0 + i * 256 + lane * 4); } }
    for (int row = blockIdx.x * 8 + wid; row < MROWS; row += rs) {
        const int cd = row < NLAT ? row / SEQL : 2;
        if (cd != cur_cd) { const float* sh = MOD + (size_t)cd * 6144, *scl = sh + 1024;
#pragma unroll
            for (int i = 0; i < 4; ++i) { const int k = i * 256 + lane * 4; const f32x4 g = *(const f32x4*)(a.pre_mix_g + k), s1 = *(const f32x4*)(sh + k), c1 = *(const f32x4*)(scl + k); m1[i] = g * (c1 + 1.f); m0[i] = s1; }
            cur_cd = cd; }
        f32x4 v[4]; float ss = 0.f;
#pragma unroll
        for (int i = 0; i < 4; ++i) { v[i] = nv[i]; ss += v[i][0] * v[i][0] + v[i][1] * v[i][1] + v[i][2] * v[i][2] + v[i][3] * v[i][3]; }
        { const int nrow = row + rs; if (nrow < MROWS) { const float* srcn = nrow < NLAT ? a.x + (size_t)nrow * DM : a.ctx + (size_t)(nrow - NLAT) * DM;
#pragma unroll
            for (int i = 0; i < 4; ++i) nv[i] = *(const f32x4*)(srcn + i * 256 + lane * 4); } }
        ss = wave_sum(ss); const float r = rsqrtf(ss * (1.f / 1024.f) + EPS);
#pragma unroll
        for (int i = 0; i < 4; ++i) { const int k = i * 256 + lane * 4;
#pragma unroll
            for (int e = 0; e < 4; ++e) v[i][e] = v[i][e] * r * m1[i][e] + m0[i][e];
            u32x2 w; w.x = pk2(v[i][0], v[i][1]); w.y = pk2(v[i][2], v[i][3]); *(u32x2*)(H + (size_t)row * DM + k) = w; }
        float p[16];
#pragma unroll
        for (int j = 0; j < 16; ++j) { float sj = 0.f;
#pragma unroll
            for (int i = 0; i < 4; ++i) { const f32x4 w = *(const f32x4*)(WAB + j * 1024 + i * 256 + lane * 4); sj += v[i][0] * w[0] + v[i][1] * w[1] + v[i][2] * w[2] + v[i][3] * w[3]; }
            p[j] = sj; __builtin_amdgcn_sched_barrier(0); }
        float q8[8], q4[4], q2[2], q1;
        { const bool hi = (lane & 32) != 0;
#pragma unroll
          for (int t = 0; t < 8; ++t) { const float snd = hi ? p[t] : p[t + 8], kp = hi ? p[t + 8] : p[t]; q8[t] = kp + __shfl_xor(snd, 32); } }
        { const bool hi = (lane & 16) != 0;
#pragma unroll
          for (int t = 0; t < 4; ++t) { const float snd = hi ? q8[t] : q8[t + 4], kp = hi ? q8[t + 4] : q8[t]; q4[t] = kp + __shfl_xor(snd, 16); } }
        { const bool hi = (lane & 8) != 0;
#pragma unroll
          for (int t = 0; t < 2; ++t) { const float snd = hi ? q4[t] : q4[t + 2], kp = hi ? q4[t + 2] : q4[t]; q2[t] = kp + __shfl_xor(snd, 8); } }
        { const bool hi = (lane & 4) != 0; const float snd = hi ? q2[0] : q2[1], kp = hi ? q2[1] : q2[0]; q1 = kp + __shfl_xor(snd, 4); }
        q1 += __shfl_xor(q1, 2); q1 += __shfl_xor(q1, 1);
        if ((lane & 3) == 0) AB[(size_t)row * 16 + (lane >> 2)] = q1;
    }
    __syncthreads();
}

DI void conv_rows(const Args& a) {
    const int lane = tidx() & 63, wid = tidx() >> 6;
    const bf16_t* P = (const bf16_t*)(a.ws + OFF_BIG);
    bf16_t* QN = (bf16_t*)(a.ws + OFF_QN); bf16_t* KN = (bf16_t*)(a.ws + OFF_KN); bf16_t* VN = (bf16_t*)(a.ws + OFF_VN);
    float w0[3][8], w1[3][8], w2[3][8];
#pragma unroll
    for (int part = 0; part < 3; ++part)
#pragma unroll
        for (int e = 0; e < 8; ++e) { const int ch = part * 512 + lane * 8 + e; w0[part][e] = a.gdn_conv_w[ch]; w1[part][e] = a.gdn_conv_w[1536 + ch]; w2[part][e] = a.gdn_conv_w[3072 + ch]; }
    const u32x4 zero4 = {0u, 0u, 0u, 0u};
    for (int blk = blockIdx.x * 8 + wid; blk < MROWS / 16; blk += gridDim.x * 8) {
        const int r0 = blk * 16;
        int t0, len; if (r0 < NLAT) { t0 = r0 & (SEQL - 1); len = SEQL; } else { t0 = (r0 - NLAT) & (CTXL - 1); len = CTXL; }
        u32x4 xp[3], xc[3], xn[3], xnn[3];
#pragma unroll
        for (int part = 0; part < 3; ++part) { const bf16_t* p = P + (size_t)r0 * PG_LD + part * 512 + lane * 8;
            xc[part] = *(const u32x4*)p; xp[part] = t0 > 0 ? *(const u32x4*)(p - PG_LD) : zero4; xn[part] = t0 + 1 < len ? *(const u32x4*)(p + PG_LD) : zero4; }
        for (int i = 0; i < 16; ++i) {
            const int row = r0 + i, t = t0 + i;
#pragma unroll
            for (int part = 0; part < 3; ++part) xnn[part] = (i < 15 && t + 2 < len) ? *(const u32x4*)(P + (size_t)(row + 2) * PG_LD + part * 512 + lane * 8) : zero4;
#pragma unroll
            for (int part = 0; part < 3; ++part) {
                float fc[8], fp[8], fn[8]; unpack8(xc[part], fc); unpack8(xp[part], fp); unpack8(xn[part], fn);
                float y[8]; float ss = 0.f;
#pragma unroll
                for (int e = 0; e < 8; ++e) { const float cv = w0[part][e] * fp[e] + w1[part][e] * fc[e] + w2[part][e] * fn[e]; y[e] = siluf(cv); ss += y[e] * y[e]; }
                if (part < 2) {
                    ss += __shfl_xor(ss, 1); ss += __shfl_xor(ss, 2); ss += __shfl_xor(ss, 4); ss += __shfl_xor(ss, 8);
                    const float r = rsqrtf(ss + EPS) * (part == 0 ? 0.08838834764831845f : 1.f);
#pragma unroll
                    for (int e = 0; e < 8; ++e) y[e] *= r;
                }
                bf16_t* dst = (part == 0 ? QN : part == 1 ? KN : VN) + (size_t)row * 512 + lane * 8;
                *(u32x4*)dst = pack8(y);
            }
#pragma unroll
            for (int part = 0; part < 3; ++part) { xp[part] = xc[part]; xc[part] = xn[part]; xn[part] = xnn[part]; }
        }
    }
}

constexpr int AT_QS = 0, AT_KS = 36864, AT_VT = AT_KS + 320 * 144, AT_VT_STRIDE = 656, AT_ROPE = AT_VT + 64 * 656;
static_assert(AT_ROPE + 32768 <= LDS_BYTES, "attention LDS map");
constexpr int N_ATT_UNITS = 1024;
DI int vt_pos(int i) { return (i & ~31) + ((i >> 2) & 3) * 8 + ((i >> 4) & 1) * 4 + (i & 3); }
DI void attn_load_kv(const Args& a, char* smem, const bf16_t* P, long grow0, int tpos0, int tlen, int nrows, int kvh, bool rope) {
    const int tid = tidx();
    const float2* R = (const float2*)(smem + AT_ROPE);
    u32x4 ka[3], kb[3], vv[5];
#pragma unroll
    for (int it = 0; it < 3; ++it) { const int idx = tid + it * 512, i = idx >> 2, q = idx & 3, t = tpos0 + i; const bool ok = idx < nrows * 4 && t >= 0 && t < tlen;
        ka[it] = (u32x4){0u, 0u, 0u, 0u}; kb[it] = (u32x4){0u, 0u, 0u, 0u};
        if (ok) { const bf16_t* p = P + (grow0 + i) * ATT_LD + 512 + kvh * 64 + q * 8; ka[it] = *(const u32x4*)p; kb[it] = *(const u32x4*)(p + 32); } }
#pragma unroll
    for (int it = 0; it < 5; ++it) { const int idx = tid + it * 512, q = idx / nrows, i = idx - q * nrows, t = tpos0 + i; const bool ok = idx < nrows * 8 && t >= 0 && t < tlen;
        vv[it] = (u32x4){0u, 0u, 0u, 0u};
        if (ok) vv[it] = *(const u32x4*)(P + (grow0 + i) * ATT_LD + 640 + kvh * 64 + q * 8); }
#pragma unroll
    for (int it = 0; it < 3; ++it) { const int idx = tid + it * 512, i = idx >> 2, q = idx & 3, t = tpos0 + i;
        if (idx < nrows * 4) {
            float x1[8], x2[8]; unpack8(ka[it], x1); unpack8(kb[it], x2);
            if (rope && t >= 0 && t < tlen) { const int pp = (q < 2) ? (t >> 6) : (t & 63); const float2* rp = R + pp * 16 + (q & 1) * 8;
#pragma unroll
                for (int e = 0; e < 8; ++e) { const float2 cs = rp[e]; const float o1 = x1[e] * cs.x - x2[e] * cs.y, o2 = x2[e] * cs.x + x1[e] * cs.y; x1[e] = o1; x2[e] = o2; } }
            *(u32x4*)(smem + AT_KS + i * 144 + q * 16) = pack8(x1);
            *(u32x4*)(smem + AT_KS + i * 144 + 64 + q * 16) = pack8(x2); } }
#pragma unroll
    for (int it = 0; it < 5; ++it) { const int idx = tid + it * 512, q = idx / nrows, i = idx - q * nrows;
        if (idx < nrows * 8) { const u32x4 v = vv[it];
            bf16_t* vt = (bf16_t*)(smem + AT_VT) + vt_pos(i); const int d0 = q * 8;
            vt[(d0 + 0) * 328] = (bf16_t)(v.x & 0xffff); vt[(d0 + 1) * 328] = (bf16_t)(v.x >> 16);
            vt[(d0 + 2) * 328] = (bf16_t)(v.y & 0xffff); vt[(d0 + 3) * 328] = (bf16_t)(v.y >> 16);
            vt[(d0 + 4) * 328] = (bf16_t)(v.z & 0xffff); vt[(d0 + 5) * 328] = (bf16_t)(v.z >> 16);
            vt[(d0 + 6) * 328] = (bf16_t)(v.w & 0xffff); vt[(d0 + 7) * 328] = (bf16_t)(v.w >> 16); } }
}
DI void attn_unit(const Args& a, char* smem, int u) {
    const int b = u >> 9, kvh = (u >> 8) & 1, qb = u & 255, q0 = qb * 64;
    const int tid = tidx(), lane = tid & 63, wid = tid >> 6, fr = lane & 15, fq = lane >> 4;
    const bf16_t* P = (const bf16_t*)((const unsigned char*)a.out + OUT_ATT);
    const float2* R = (const float2*)(smem + AT_ROPE);
    bf16_t* MIX = (bf16_t*)(a.ws + OFF_H);
    constexpr float QSCALE = 0.125f * 1.4426950408889634f;
#pragma unroll
    for (int it = 0; it < 2; ++it) { const int idx = tid + it * 512, hr = idx >> 2, q = idx & 3, g = hr >> 6, r = hr & 63; const int t = q0 + r;
      const bf16_t* p = P + ((size_t)b * SEQL + t) * ATT_LD + (kvh * 4 + g) * 64 + q * 8; float x1[8], x2[8];
      unpack8(*(const u32x4*)p, x1); unpack8(*(const u32x4*)(p + 32), x2);
      const int pp = (q < 2) ? (t >> 6) : (t & 63); const float2* rp = R + pp * 16 + (q & 1) * 8;
#pragma unroll
      for (int e = 0; e < 8; ++e) { const float2 cs = rp[e]; const float o1 = (x1[e] * cs.x - x2[e] * cs.y) * QSCALE, o2 = (x2[e] * cs.x + x1[e] * cs.y) * QSCALE; x1[e] = o1; x2[e] = o2; }
      *(u32x4*)(smem + AT_QS + hr * 144 + q * 16) = pack8(x1); *(u32x4*)(smem + AT_QS + hr * 144 + 64 + q * 16) = pack8(x2); }
    const int g = wid >> 1, qs = wid & 1, hq = kvh * 4 + g;
    const int qi0 = q0 + qs * 32 + fr;
    float m_run[2], l_run[2];
    m_run[0] = m_run[1] = a.attn_sink[hq] * 1.4426950408889634f; l_run[0] = l_run[1] = (fq == 0) ? 1.f : 0.f;
    f32x4 O[2][4];
#pragma unroll
    for (int j = 0; j < 2; ++j)
#pragma unroll
        for (int dt = 0; dt < 4; ++dt) O[j][dt] = (f32x4){0.f, 0.f, 0.f, 0.f};
    bf16x8 Qf[2][2];
#pragma unroll
    for (int pass = 0; pass < 2; ++pass) {
        if (pass == 0) attn_load_kv(a, smem, P, (long)b * SEQL + q0 - 128, q0 - 128, SEQL, 320, kvh, true);
        else attn_load_kv(a, smem, P, (long)NLAT + b * CTXL, 0, CTXL, 256, kvh, false);
        __syncthreads();
        if (pass == 0) {
#pragma unroll
            for (int j = 0; j < 2; ++j) { const char* qp = smem + AT_QS + (g * 64 + qs * 32 + j * 16 + fr) * 144 + fq * 16; Qf[j][0] = ldf16(qp); Qf[j][1] = ldf16(qp + 64); } }
        const int ngrp = pass == 0 ? 5 : 4;
#pragma unroll 1
        for (int kk = 0; kk < ngrp; ++kk) {
            f32x4 sc[2][4];
            { const char* kp = smem + AT_KS + (kk * 64 + fr) * 144 + fq * 16;
#pragma unroll
              for (int kt = 0; kt < 4; ++kt) { const bf16x8 k0 = ldf16(kp + kt * 16 * 144), k1 = ldf16(kp + kt * 16 * 144 + 64);
#pragma unroll
                  for (int j = 0; j < 2; ++j) { f32x4 z = {0.f, 0.f, 0.f, 0.f}; z = mfma16(k0, Qf[j][0], z); sc[j][kt] = mfma16(k1, Qf[j][1], z); } } }
            const int kbase = q0 - 128 + kk * 64;
            const bool need_mask = pass == 0 && (kk == 0 || kk == 4 || kbase < 0 || kbase + 64 > SEQL);
            if (need_mask) {
#pragma unroll
                for (int j = 0; j < 2; ++j) { const int qi = qi0 + j * 16;
#pragma unroll
                    for (int kt = 0; kt < 4; ++kt)
#pragma unroll
                        for (int r = 0; r < 4; ++r) { const int k = kbase + kt * 16 + fq * 4 + r; const bool v = k >= 0 && k < SEQL && (qi - k) <= 128 && (k - qi) <= 128; sc[j][kt][r] = v ? sc[j][kt][r] : -1e30f; } }
            }
            bf16x8 Pb[2][2];
#pragma unroll
            for (int j = 0; j < 2; ++j) {
                float mx = m_run[j];
#pragma unroll
                for (int kt = 0; kt < 4; ++kt) mx = fmaxf(fmaxf(mx, fmaxf(sc[j][kt][0], sc[j][kt][1])), fmaxf(sc[j][kt][2], sc[j][kt][3]));
                mx = fmaxf(mx, __shfl_xor(mx, 16)); mx = fmaxf(mx, __shfl_xor(mx, 32));
                const float alpha = __builtin_amdgcn_exp2f(m_run[j] - mx); m_run[j] = mx;
                float ps = 0.f;
#pragma unroll
                for (int kt = 0; kt < 4; ++kt)
#pragma unroll
                    for (int r = 0; r < 4; ++r) { const float pv = __builtin_amdgcn_exp2f(sc[j][kt][r] - mx); sc[j][kt][r] = pv; ps += pv; }
                l_run[j] = l_run[j] * alpha + ps;
                Pb[j][0] = pack2(sc[j][0], sc[j][1]); Pb[j][1] = pack2(sc[j][2], sc[j][3]);
#pragma unroll
                for (int dt = 0; dt < 4; ++dt) O[j][dt] = O[j][dt] * alpha;
            }
            { const char* vp = smem + AT_VT + fr * AT_VT_STRIDE + (kk * 64 + fq * 8) * 2;
#pragma unroll
              for (int dt = 0; dt < 4; ++dt)
#pragma unroll
                  for (int kp = 0; kp < 2; ++kp) { const bf16x8 vf = ldf16(vp + dt * 16 * AT_VT_STRIDE + kp * 64);
                      O[0][dt] = mfma16(vf, Pb[0][kp], O[0][dt]); O[1][dt] = mfma16(vf, Pb[1][kp], O[1][dt]); } }
        }
        __syncthreads();
    }
#pragma unroll
    for (int j = 0; j < 2; ++j) {
        float l = l_run[j]; l += __shfl_xor(l, 16); l += __shfl_xor(l, 32);
        const float inv = 1.f / l;
        bf16_t* op = MIX + ((size_t)b * SEQL + qi0 + j * 16) * DM + hq * 64 + fq * 4;
#pragma unroll
        for (int dt = 0; dt < 4; ++dt) { u32x2 w; w.x = pk2(O[j][dt][0] * inv, O[j][dt][1] * inv); w.y = pk2(O[j][dt][2] * inv, O[j][dt][3] * inv); *(u32x2*)(op + dt * 16) = w; }
    }
}
DI void phase3a(const Args& a, char* smem) { conv_rows(a); }

constexpr int PR_Q = 0, PR_K = 17408, PR_KT = 34816, PR_KB = 53248, PR_VT = 71680, PR_AS = 90112, PR_TS = 107520, PR_TB = 124928, PR_GC = 134144, PR_BETA = 134400;
DI float softplusf(float x) { return fmaxf(x, 0.f) + log1pf(expf(-fabsf(x))); }
struct PrepIn { u32x4 x[2][3], ed[2][3]; float av, bv; };
constexpr int PR_CW = 134656;
DI void prep_load(const Args& a, int r, PrepIn& in) {
    const int dir = r & 1, h = (r >> 1) & 3, cidx = r >> 3, base = cidx * 64;
    const int tid = tidx(), lane = tid & 63;
    const bf16_t* PG = (const bf16_t*)(a.ws + OFF_PG);
    const float* AB = (const float*)(a.ws + OFF_AB);
    int t0, len; if (base < NLAT) { t0 = base & (SEQL - 1); len = SEQL; } else { t0 = (base - NLAT) & (CTXL - 1); len = CTXL; }
    const u32x4 zero4 = {0u, 0u, 0u, 0u};
    const bool lo_side = (lane == 0) != (dir != 0);
    const bool edge = lane == 0 || lane == 63;
    const bool ev = edge && (lo_side ? t0 > 0 : t0 + 64 < len);
    const int etok = lo_side ? base - 1 : base + 64;
#pragma unroll
    for (int it = 0; it < 2; ++it) { const int q = (tid >> 6) + it * 8; const int tok = dir ? base + 63 - lane : base + lane;
#pragma unroll
        for (int part = 0; part < 3; ++part) { const int col = part * 512 + h * 128 + q * 8;
            in.x[it][part] = *(const u32x4*)(PG + (size_t)tok * PG_LD + col);
            in.ed[it][part] = ev ? *(const u32x4*)(PG + (size_t)etok * PG_LD + col) : zero4; } }
    { const int tok = dir ? base + 63 - lane : base + lane; in.av = AB[(size_t)tok * 16 + dir * 4 + h]; in.bv = AB[(size_t)tok * 16 + 8 + dir * 4 + h]; }
}
DI u32x4 shfl4_up(u32x4 v) { u32x4 r; r.x = __shfl_up(v.x, 1); r.y = __shfl_up(v.y, 1); r.z = __shfl_up(v.z, 1); r.w = __shfl_up(v.w, 1); return r; }
DI u32x4 shfl4_dn(u32x4 v) { u32x4 r; r.x = __shfl_down(v.x, 1); r.y = __shfl_down(v.y, 1); r.z = __shfl_down(v.z, 1); r.w = __shfl_down(v.w, 1); return r; }
#define LDS_BARRIER() do { asm volatile("s_waitcnt lgkmcnt(0)" ::: "memory"); __builtin_amdgcn_s_barrier(); asm volatile("" ::: "memory"); } while (0)
DI void prep_unit(const Args& a, char* smem, int r, const PrepIn& in) {
    const int dir = r & 1, h = (r >> 1) & 3, cidx = r >> 3;
    const int tid = tidx(), lane = tid & 63, wid = tid >> 6, fr = lane & 15, fq = lane >> 4;
    float* gc = (float*)(smem + PR_GC); float* beta = (float*)(smem + PR_BETA);
    int slot_;
    { int bb, st; if (cidx < 512) { bb = cidx >> 8; const int n = cidx & 255; st = 4 + (dir ? 255 - n : n); } else { bb = (cidx - 512) >> 2; const int n = (cidx - 512) & 3; st = dir ? 3 - n : n; }
      slot_ = ((bb * 4 + h) * 2 + dir) * 260 + st; }
    const int slot = slot_;
    unsigned char* rec = rec_ptr(a, slot);
    const float* CW = (const float*)(smem + PR_CW); float* SSP = (float*)(smem + PR_AS);
    float yv[2][3][8];
#pragma unroll
    for (int it = 0; it < 2; ++it) { const int idx = tid + it * 512, rr = idx & 63, q = idx >> 6;
#pragma unroll
        for (int part = 0; part < 3; ++part) { float fc[8], fp[8], fn[8];
            const u32x4 xc = in.x[it][part], up = shfl4_up(xc), dn = shfl4_dn(xc), ed = in.ed[it][part];
            const u32x4 fromlo = lane == 0 ? ed : up, fromhi = lane == 63 ? ed : dn;
            unpack8(xc, fc); unpack8(dir ? fromhi : fromlo, fp); unpack8(dir ? fromlo : fromhi, fn);
            const float* cw = CW + part * 512 + h * 128 + q * 8; float ss = 0.f;
#pragma unroll
            for (int e = 0; e < 8; ++e) { const float cv = cw[e] * fp[e] + cw[1536 + e] * fc[e] + cw[3072 + e] * fn[e]; const float y = siluf(cv); yv[it][part][e] = y; ss += y * y; }
            if (part < 2) SSP[(part * 64 + rr) * 16 + q] = ss; } }
    if (wid == 0) {
        const float av = in.av, bv = in.bv;
        float gv = -expf(a.gdn_a_log[dir * 4 + h]) * softplusf(av + a.gdn_dt_bias[dir * 4 + h]);
#pragma unroll
        for (int o = 1; o < 64; o <<= 1) { const float t = __shfl_up(gv, o); if (lane >= o) gv += t; }
        gc[lane] = gv; beta[lane] = 1.f / (1.f + expf(-bv));
        if (lane == 63) ((float*)(a.ws + OFF_EGL))[slot] = expf(gv);
    }
    LDS_BARRIER();
#pragma unroll
    for (int it = 0; it < 2; ++it) {
        const int idx = tid + it * 512, rr = idx & 63, q = idx >> 6;
        float sq = 0.f, sk = 0.f;
#pragma unroll
        for (int j = 0; j < 16; ++j) { sq += SSP[rr * 16 + j]; sk += SSP[(64 + rr) * 16 + j]; }
        const float rq = rsqrtf(sq + EPS) * 0.08838834764831845f, rk = rsqrtf(sk + EPS);
#pragma unroll
        for (int e = 0; e < 8; ++e) { yv[it][0][e] *= rq; yv[it][1][e] *= rk; }
        const u32x4 qv = pack8(yv[it][0]), kv = pack8(yv[it][1]), vv = pack8(yv[it][2]);
        *(u32x4*)(smem + PR_Q + rr * 272 + q * 16) = qv; *(u32x4*)(smem + PR_K + rr * 272 + q * 16) = kv;
        float kf[8], vf[8]; unpack8(kv, kf); unpack8(vv, vf);
        const float bt = beta[rr], be = bt * __expf(gc[rr]);
        bf16_t* kt = (bf16_t*)(smem + PR_KT) + (q * 8) * 72 + rr; bf16_t* kb = (bf16_t*)(smem + PR_KB) + (q * 8) * 72 + rr; bf16_t* vt = (bf16_t*)(smem + PR_VT) + (q * 8) * 72 + rr;
#pragma unroll
        for (int e = 0; e < 8; ++e) { kt[e * 72] = (bf16_t)f2bf(kf[e]); kb[e * 72] = (bf16_t)f2bf(kf[e] * be); vt[e * 72] = (bf16_t)f2bf(vf[e] * bt); }
    }
    LDS_BARRIER();
    float* As = (float*)(smem + PR_AS); float* Ts = (float*)(smem + PR_TS);
#pragma unroll
    for (int tt = 0; tt < 2; ++tt) {
        const int t = wid * 2 + tt, mt = t >> 2, nt = t & 3;
        f32x4 kk = {0.f, 0.f, 0.f, 0.f}, qk = {0.f, 0.f, 0.f, 0.f};
#pragma unroll
        for (int ks = 0; ks < 4; ++ks) {
            const bf16x8 am = ldf16(smem + PR_K + (mt * 16 + fr) * 272 + ks * 64 + fq * 16);
            const bf16x8 bk = ldf16(smem + PR_K + (nt * 16 + fr) * 272 + ks * 64 + fq * 16);
            const bf16x8 bq = ldf16(smem + PR_Q + (nt * 16 + fr) * 272 + ks * 64 + fq * 16);
            kk = mfma16(am, bk, kk); qk = mfma16(am, bq, qk);
        }
        const int i = nt * 16 + fr; const float gi = gc[i], bi = beta[i];
        f32x4 av; u32x2 qw; float qv[4];
#pragma unroll
        for (int j4 = 0; j4 < 4; ++j4) { const int j = mt * 16 + fq * 4 + j4; const float dg = gi - gc[j];
            const float edg = __expf(dg); av[j4] = (i > j) ? bi * kk[j4] * edg : 0.f; qv[j4] = (i >= j) ? qk[j4] * edg : 0.f; }
        *(f32x4*)(As + i * 68 + mt * 16 + fq * 4) = av;
        qw.x = pk2(qv[0], qv[1]); qw.y = pk2(qv[2], qv[3]);
        *(u32x2*)(rec + REC_QK + (i * 64 + (mt >> 1) * 32 + fq * 8 + (mt & 1) * 4) * 2) = qw;
    }
    LDS_BARRIER();
    if (wid == 0) {
        const int bI = lane >> 4, c = lane & 15; float x[16];
#pragma unroll
        for (int i = 0; i < 16; ++i) { float sacc = (i == c) ? 1.f : 0.f; const float* ar = As + (bI * 16 + i) * 68 + bI * 16;
#pragma unroll
            for (int j = 0; j < i; ++j) sacc -= ar[j] * x[j];
            x[i] = sacc; }
#pragma unroll
        for (int i = 0; i < 16; ++i) Ts[(bI * 16 + i) * 68 + bI * 16 + c] = x[i];
    }
    LDS_BARRIER();
    { float* scr = (float*)(smem + PR_TB) + wid * 16 * 17;
#pragma unroll
      for (int bI = 1; bI < 4; ++bI) {
          if (wid < bI) { const int bJ = wid; f32x4 racc = {0.f, 0.f, 0.f, 0.f};
              for (int bK = bJ; bK < bI; ++bK) {
#pragma unroll
                  for (int kk = 0; kk < 4; ++kk) { const float av = As[(bI * 16 + fr) * 68 + bK * 16 + kk * 4 + fq], bv = Ts[(bK * 16 + kk * 4 + fq) * 68 + bJ * 16 + fr];
                      racc = __builtin_amdgcn_mfma_f32_16x16x4f32(av, bv, racc, 0, 0, 0); } }
#pragma unroll
              for (int j = 0; j < 4; ++j) scr[(fq * 4 + j) * 17 + fr] = racc[j];
              asm volatile("s_waitcnt lgkmcnt(0)" ::: "memory"); __builtin_amdgcn_wave_barrier();
              f32x4 tacc = {0.f, 0.f, 0.f, 0.f};
#pragma unroll
              for (int kk = 0; kk < 4; ++kk) { const float av = Ts[(bI * 16 + fr) * 68 + bI * 16 + kk * 4 + fq], bv = scr[(kk * 4 + fq) * 17 + fr];
                  tacc = __builtin_amdgcn_mfma_f32_16x16x4f32(av, bv, tacc, 0, 0, 0); }
#pragma unroll
              for (int j = 0; j < 4; ++j) Ts[(bI * 16 + fq * 4 + j) * 68 + bJ * 16 + fr] = -tacc[j];
          }
          LDS_BARRIER();
      } }
    for (int idx = tid; idx < 2048; idx += 512) { const int i = idx >> 5, j2 = (idx & 31) * 2; const bool up = (j2 >> 4) > (i >> 4);
        *(unsigned*)(smem + PR_TB + i * 144 + j2 * 2) = up ? 0u : pk2(Ts[i * 68 + j2], Ts[i * 68 + j2 + 1]); }
    LDS_BARRIER();
#pragma unroll
    for (int tt = 0; tt < 4; ++tt) {
        const int t = wid * 4 + tt;
        { const int ct = t & 3, et = t >> 2; f32x4 acc = {0.f, 0.f, 0.f, 0.f};
#pragma unroll
          for (int ks = 0; ks < 2; ++ks) acc = mfma16(ldf16(smem + PR_TB + (ct * 16 + fr) * 144 + ks * 64 + fq * 16), ldf16(smem + PR_VT + (et * 16 + fr) * 144 + ks * 64 + fq * 16), acc);
          u32x2 w; w.x = pk2(acc[0], acc[1]); w.y = pk2(acc[2], acc[3]);
          *(u32x2*)(rec + REC_UT + ((et * 16 + fr) * 64 + ct * 16 + fq * 4) * 2) = w; }
        { const int ct = t & 3, dt = t >> 2; f32x4 acc = {0.f, 0.f, 0.f, 0.f};
#pragma unroll
          for (int ks = 0; ks < 2; ++ks) acc = mfma16(ldf16(smem + PR_KB + (dt * 16 + fr) * 144 + ks * 64 + fq * 16), ldf16(smem + PR_TB + (ct * 16 + fr) * 144 + ks * 64 + fq * 16), acc);
          u32x2 w; w.x = pk2(acc[0], acc[1]); w.y = pk2(acc[2], acc[3]);
          *(u32x2*)(rec + REC_W + ((ct * 16 + fr) * 128 + (dt >> 1) * 32 + fq * 8 + (dt & 1) * 4) * 2) = w; }
    }
    const float glast = gc[63];
    for (int idx = tid; idx < 1024; idx += 512) {
        { const int rr = idx >> 4, q = idx & 15; float f[8]; unpack8(*(const u32x4*)(smem + PR_Q + rr * 272 + q * 16), f); const float e = __expf(gc[rr]);
#pragma unroll
          for (int j = 0; j < 8; ++j) f[j] *= e;
          const int p0 = (q >> 2) * 32 + ((q >> 1) & 1) * 4; u32x2 w0, w1; w0.x = pk2(f[0], f[1]); w0.y = pk2(f[2], f[3]); w1.x = pk2(f[4], f[5]); w1.y = pk2(f[6], f[7]);
          *(u32x2*)(rec + REC_QG + (rr * 128 + p0 + ((2 * q) & 3) * 8) * 2) = w0; *(u32x2*)(rec + REC_QG + (rr * 128 + p0 + ((2 * q + 1) & 3) * 8) * 2) = w1; }
        { const int d = idx >> 3, q = idx & 7; float f[8]; unpack8(*(const u32x4*)(smem + PR_KT + d * 144 + q * 16), f);
#pragma unroll
          for (int j = 0; j < 8; ++j) f[j] *= __expf(glast - gc[q * 8 + j]);
          const int p0 = (q >> 2) * 32 + ((q >> 1) & 1) * 4; u32x2 w0, w1; w0.x = pk2(f[0], f[1]); w0.y = pk2(f[2], f[3]); w1.x = pk2(f[4], f[5]); w1.y = pk2(f[6], f[7]);
          *(u32x2*)(rec + REC_KTT + (d * 64 + p0 + ((2 * q) & 3) * 8) * 2) = w0; *(u32x2*)(rec + REC_KTT + (d * 64 + p0 + ((2 * q + 1) & 3) * 8) * 2) = w1; }
    }
    LDS_BARRIER();
}
DI void phase3b(const Args& a, char* smem) {
    const int G = (int)gridDim.x; int r = (int)blockIdx.x;
    { float* CWs = (float*)(smem + PR_CW); for (int i = tidx(); i < 4608; i += 512) CWs[i] = a.gdn_conv_w[i]; }
    __syncthreads();
    PrepIn cur, nxt;
    if (r < NREC) prep_load(a, r, cur);
    for (; r < NREC; r += G) {
        if (r + G < NREC) prep_load(a, r + G, nxt);
        prep_unit(a, smem, r, cur);
        cur = nxt;
    }
}

constexpr int SC_W = 0, SC_QG = 18432, SC_KTT = 36864, SC_QK = 57344, SC_UT = 67584, SC_EGL = 70144, SC_BUF = 70160, SC_NP = 3712, SC_OST = 2 * 70160;
DI int scan_rec(int b, int h, int dir, int step) { return ((b * 4 + h) * 2 + dir) * 260 + step; }
#define SC_BARRIER() do { asm volatile("s_waitcnt lgkmcnt(0)" ::: "memory"); __builtin_amdgcn_s_barrier(); asm volatile("" ::: "memory"); } while (0)
DI void scan_unit(const Args& a, char* smem, int u) {
    const int sl = u & 7, chain = u >> 3, dir = chain & 1, h = (chain >> 1) & 3, b = chain >> 3, e0 = sl * 16;
    const int tid = tidx(), lane = tid & 63, wid = __builtin_amdgcn_readfirstlane(tid >> 6), fr = lane & 15, fq = lane >> 4;
    const float* EGL = (const float*)(a.ws + OFF_EGL);
    bf16_t* Ob = (bf16_t*)(a.ws + OFF_O) + (size_t)dir * NLAT * 512;
    constexpr int NSTEP = 260;
    if (wid == 0) {
        f32x4 S[8];
#pragma unroll
        for (int i = 0; i < 8; ++i) S[i] = (f32x4){0.f, 0.f, 0.f, 0.f};
        for (int step = -1; step <= NSTEP; ++step) {
            if (step >= 0 && step < NSTEP) {
                const char* buf = smem + (step & 1) * SC_BUF;
                const float egl = *(const float*)(buf + SC_EGL);
                if (sl == 0 && lane == 0) __hip_atomic_store((unsigned*)(a.ws + OFF_PROG) + chain * 16, (unsigned)step, __ATOMIC_RELAXED, __HIP_MEMORY_SCOPE_AGENT);
                const char* pw = buf + SC_W + fr * 288 + fq * 16; const char* pq = buf + SC_QG + fr * 288 + fq * 16;
                const char* pk = buf + SC_QK + fr * 160 + fq * 16; const char* pt = buf + SC_KTT + fr * 160 + fq * 16;
                bf16x8 fa[8], fb[8];
#define LD_WQ(F, ct) do { _Pragma("unroll") for (int kk = 0; kk < 4; ++kk) { F[kk] = ldf16(pw + (ct) * 16 * 288 + kk * 64); F[4 + kk] = ldf16(pq + (ct) * 16 * 288 + kk * 64); } } while (0)
#define LD_QK(F) do { _Pragma("unroll") for (int ct = 0; ct < 4; ++ct) { F[2 * ct] = ldf16(pk + ct * 16 * 160); F[2 * ct + 1] = ldf16(pk + ct * 16 * 160 + 64); } } while (0)
#define LD_KT(F, d0) do { _Pragma("unroll") for (int dd = 0; dd < 4; ++dd) { F[2 * dd] = ldf16(pt + ((d0) + dd) * 16 * 160); F[2 * dd + 1] = ldf16(pt + ((d0) + dd) * 16 * 160 + 64); } } while (0)
#define MM_WQ(F, ct) do { f32x4 acc = {0.f, 0.f, 0.f, 0.f}, accq = {0.f, 0.f, 0.f, 0.f}; \
        _Pragma("unroll") for (int kk = 0; kk < 4; ++kk) { acc = mfma16(F[kk], Sb[kk], acc); accq = mfma16(F[4 + kk], Sb[kk], accq); } \
        vn[ct][0] = bflo(uu[ct].x) - acc[0]; vn[ct][1] = bfhi(uu[ct].x) - acc[1]; vn[ct][2] = bflo(uu[ct].y) - acc[2]; vn[ct][3] = bfhi(uu[ct].y) - acc[3]; oo[ct] = accq; } while (0)
                LD_WQ(fa, 0);
                u32x2 uu[4];
#pragma unroll
                for (int ct = 0; ct < 4; ++ct) uu[ct] = *(const u32x2*)(buf + SC_UT + fr * 160 + (ct * 16 + fq * 4) * 2);
                bf16x8 Sb[4];
#pragma unroll
                for (int kk = 0; kk < 4; ++kk) Sb[kk] = pack2(S[2 * kk], S[2 * kk + 1]);
                f32x4 vn[4], oo[4];
                LD_WQ(fb, 1); __builtin_amdgcn_sched_barrier(0);
                MM_WQ(fa, 0); __builtin_amdgcn_sched_barrier(0);
                LD_WQ(fa, 2); __builtin_amdgcn_sched_barrier(0);
                MM_WQ(fb, 1); __builtin_amdgcn_sched_barrier(0);
                LD_WQ(fb, 3); __builtin_amdgcn_sched_barrier(0);
                MM_WQ(fa, 2); __builtin_amdgcn_sched_barrier(0);
                LD_QK(fa); __builtin_amdgcn_sched_barrier(0);
                MM_WQ(fb, 3); __builtin_amdgcn_sched_barrier(0);
                LD_KT(fb, 0); __builtin_amdgcn_sched_barrier(0);
                bf16x8 Vb[2]; Vb[0] = pack2(vn[0], vn[1]); Vb[1] = pack2(vn[2], vn[3]);
#pragma unroll
                for (int ct = 0; ct < 4; ++ct) { oo[ct] = mfma16(fa[2 * ct], Vb[0], oo[ct]); oo[ct] = mfma16(fa[2 * ct + 1], Vb[1], oo[ct]); }
                __builtin_amdgcn_sched_barrier(0);
                LD_KT(fa, 4); __builtin_amdgcn_sched_barrier(0);
#pragma unroll
                for (int dd = 0; dd < 4; ++dd) { S[dd] = S[dd] * egl; S[dd] = mfma16(fb[2 * dd], Vb[0], S[dd]); S[dd] = mfma16(fb[2 * dd + 1], Vb[1], S[dd]); }
                __builtin_amdgcn_sched_barrier(0);
#pragma unroll
                for (int dd = 0; dd < 4; ++dd) { S[4 + dd] = S[4 + dd] * egl; S[4 + dd] = mfma16(fa[2 * dd], Vb[0], S[4 + dd]); S[4 + dd] = mfma16(fa[2 * dd + 1], Vb[1], S[4 + dd]); }
#undef LD_WQ
#undef LD_QK
#undef LD_KT
#undef MM_WQ
                if (step >= 4) { bf16_t* ost = (bf16_t*)(smem + SC_OST + (step & 1) * 2048);
#pragma unroll
                    for (int ct = 0; ct < 4; ++ct) { const unsigned w0 = pk2(oo[ct][0], oo[ct][1]), w1 = pk2(oo[ct][2], oo[ct][3]); const int c0 = ct * 16 + fq * 4;
                        ost[(c0 + 0) * 16 + fr] = (bf16_t)(w0 & 0xffff); ost[(c0 + 1) * 16 + fr] = (bf16_t)(w0 >> 16); ost[(c0 + 2) * 16 + fr] = (bf16_t)(w1 & 0xffff); ost[(c0 + 3) * 16 + fr] = (bf16_t)(w1 >> 16); }
                }
            }
            SC_BARRIER();
        }
    } else {
        u32x4 tA[9], tB[9], tC[9]; float eA = 0.f, eB = 0.f, eC = 0.f;
#define SC_LOAD(T, E, st) do { const int rn_ = scan_rec(b, h, dir, (st)); const unsigned char* rec_ = rec_ptr(a, rn_); \
        _Pragma("unroll") for (int it = 0; it < 9; ++it) { const int p = tid - 64 + it * 448; \
            if (p < SC_NP) { const unsigned char* src = p < 3584 ? rec_ + p * 16 : rec_ + REC_UT + e0 * 128 + (p - 3584) * 16; T[it] = *(const u32x4*)src; } } \
        if (tid == 64) E = EGL[rn_]; } while (0)
#define SC_WRITE(T, E, st) do { char* buf_ = smem + ((st) & 1) * SC_BUF; if (tid == 64) *(float*)(buf_ + SC_EGL) = E; \
        _Pragma("unroll") for (int it = 0; it < 9; ++it) { const int p = tid - 64 + it * 448; \
            if (p < SC_NP) { int off; \
                if (p < 2048) off = (p >> 10) * 18432 + ((p & 1023) >> 4) * 288 + (p & 15) * 16; \
                else if (p < 3584) { const int q = p - 2048; off = SC_KTT + (q >> 3) * 160 + (q & 7) * 16; } \
                else { const int q = p - 3584; off = SC_UT + (q >> 3) * 160 + (q & 7) * 16; } \
                *(u32x4*)(buf_ + off) = T[it]; } } } while (0)
#define SC_ITER(T, E, st) do { if ((st) <= NSTEP) { \
        if ((st) + 1 < NSTEP) SC_WRITE(T, E, (st) + 1); \
        if ((st) - 1 >= 4 && (st) - 1 < NSTEP && tid < 192) { const int ps = (st) - 1, n = ps - 4, chunk = dir ? 255 - n : n; const int q = tid - 64, c = q >> 1, hf = q & 1; \
            const size_t tok = (size_t)b * SEQL + chunk * 64 + (dir ? 63 - c : c); \
            *(u32x4*)(Ob + tok * 512 + h * 128 + e0 + hf * 8) = *(const u32x4*)(smem + SC_OST + (ps & 1) * 2048 + c * 32 + hf * 16); } \
        if ((st) + 4 < NSTEP) SC_LOAD(T, E, (st) + 4); \
        SC_BARRIER(); } } while (0)
        SC_LOAD(tA, eA, 0); SC_LOAD(tB, eB, 1); SC_LOAD(tC, eC, 2);
        for (int st = -1; st <= NSTEP; st += 3) { SC_ITER(tA, eA, st); SC_ITER(tB, eB, st + 1); SC_ITER(tC, eC, st + 2); }
#undef SC_ITER
#undef SC_WRITE
#undef SC_LOAD
    }
}
constexpr int SC_LEAD = 12;
DI void scan_prefetch(const Args& a, int chain, int phase_, int nph) {
    const int tid = tidx(); unsigned acc = 0u;
    unsigned* prog = (unsigned*)(a.ws + OFF_PROG) + chain * 16; int budget = 8192;
    for (int step = phase_; step < 260; step += nph) {
        while (budget > 0 && (int)__hip_atomic_load(prog, __ATOMIC_RELAXED, __HIP_MEMORY_SCOPE_AGENT) + SC_LEAD < step) { __builtin_amdgcn_s_sleep(8); --budget; }
        const unsigned char* rec = rec_ptr(a, chain * 260 + step);
        u32x4 v[9];
#pragma unroll
        for (int it = 0; it < 9; ++it) v[it] = *(const u32x4*)(rec + (size_t)(tid + it * 512) * 16);
#pragma unroll
        for (int it = 0; it < 9; ++it) acc ^= v[it].x ^ v[it].y ^ v[it].z ^ v[it].w;
    }
    if (acc == 0x9e3779b9u) ((unsigned*)(a.ws))[tid] = acc;
}
DI void phase4(const Args& a, char* smem) {
    const int G = (int)gridDim.x, NS = G >= 256 ? 128 : (G >= 2 ? G / 2 : 0), NPF = G >= 256 ? 32 : 0;
    if (NS == 0) { for (int u = 0; u < 128; ++u) scan_unit(a, smem, u);
        { const u32x4* src = (const u32x4*)(a.ws + OFF_ROPE); u32x4* dst = (u32x4*)(smem + AT_ROPE); for (int i = tidx(); i < 2048; i += 512) dst[i] = src[i]; } __syncthreads();
        for (int u = 0; u < N_ATT_UNITS; ++u) attn_unit(a, smem, u);
        __syncthreads(); for (int g = P0_WT_EARLY; g < P0_WT_GROUPS; ++g) p0_wt_group(a, smem, g); return; }
    if ((int)blockIdx.x < NS) {
        if (NS == 128) { const int blk = (int)blockIdx.x, xcd = blk & 7, j = blk >> 3; scan_unit(a, smem, ((xcd * 2 + (j >> 3)) << 3) | (j & 7)); }
        else for (int u = blockIdx.x; u < 128; u += NS) scan_unit(a, smem, u); }
    else if ((int)blockIdx.x < NS + NPF) { const int p = (int)blockIdx.x - NS, xcd = p & 7, j = p >> 3;
        scan_prefetch(a, xcd * 2 + (j & 1), j >> 1, 2); }
    else { const int NA = G - NS - NPF, ab = (int)blockIdx.x - NS - NPF;
        { const u32x4* src = (const u32x4*)(a.ws + OFF_ROPE); u32x4* dst = (u32x4*)(smem + AT_ROPE); for (int i = tidx(); i < 2048; i += 512) dst[i] = src[i]; }
        __syncthreads();
        for (int u = ab; u < N_ATT_UNITS; u += NA) attn_unit(a, smem, u);
        __syncthreads(); for (int g = P0_WT_EARLY + ab; g < P0_WT_GROUPS; g += NA) p0_wt_group(a, smem, g); }
}

DI void phase5(const Args& a) {
    const int lane = tidx() & 63, wid = tidx() >> 6;
    const bf16_t* Of = (const bf16_t*)(a.ws + OFF_O); const bf16_t* Obk = Of + (size_t)NLAT * 512; const bf16_t* Z = (const bf16_t*)(a.ws + OFF_Z);
    bf16_t* MIX = (bf16_t*)(a.ws + OFF_H);
    float ng[8];
#pragma unroll
    for (int e = 0; e < 8; ++e) ng[e] = a.gdn_norm_g[(lane & 15) * 8 + e];
    const int rs = (int)gridDim.x * 8;
    u32x4 nf, nb, nz;
    { const int row0 = blockIdx.x * 8 + wid; if (row0 < NLAT) { nf = *(const u32x4*)(Of + (size_t)row0 * 512 + lane * 8); nb = *(const u32x4*)(Obk + (size_t)row0 * 512 + lane * 8); nz = *(const u32x4*)(Z + (size_t)row0 * 512 + lane * 8); } }
    for (int row = blockIdx.x * 8 + wid; row < NLAT; row += rs) {
        float of[8], ob[8], z[8];
        unpack8(nf, of); unpack8(nb, ob); unpack8(nz, z);
        { const int nrow = row + rs; if (nrow < NLAT) { nf = *(const u32x4*)(Of + (size_t)nrow * 512 + lane * 8); nb = *(const u32x4*)(Obk + (size_t)nrow * 512 + lane * 8); nz = *(const u32x4*)(Z + (size_t)nrow * 512 + lane * 8); } }
        float ss = 0.f;
#pragma unroll
        for (int e = 0; e < 8; ++e) { of[e] += ob[e]; ss += of[e] * of[e]; }
        ss += __shfl_xor(ss, 1); ss += __shfl_xor(ss, 2); ss += __shfl_xor(ss, 4); ss += __shfl_xor(ss, 8);
        const float r = rsqrtf(ss * (1.f / 128.f) + EPS);
#pragma unroll
        for (int e = 0; e < 8; ++e) of[e] = of[e] * r * ng[e] * siluf(z[e]);
        *(u32x4*)(MIX + (size_t)row * DM + 512 + lane * 8) = pack8(of);
    }
}

template <bool IN_F32, bool OUT_F32> DI void rowpass(const Args& a, const void* xin_v, void* xout_v, const float* gate_base, int gate_bstride, const float* post_g,
                const float* next_g, const float* nsh_base, const float* nsc_base, int n_bstride, bool has_next) {
    const int lane = tidx() & 63, wid = tidx() >> 6;
    const bf16_t* Y = (const bf16_t*)(a.ws + OFF_Y); const float* SSQ = (const float*)(a.ws + OFF_SSQ); bf16_t* H = (bf16_t*)(a.ws + OFF_H);
    const int rs = (int)gridDim.x * 8;
    const float* xin = (const float*)xin_v; const bf16_t* xin16 = (const bf16_t*)xin_v; float* xout = (float*)xout_v; bf16_t* xout16 = (bf16_t*)xout_v;
    f32x4 xA[4], xB[4], xC[4]; u32x2 bA[4], bB[4], bC[4], yA[4], yB[4], yC[4]; float sA = 0.f, sB = 0.f, sC = 0.f;
#define RP_LOAD(XF, XB, Yv, S, r) do { _Pragma("unroll") for (int i = 0; i < 4; ++i) { const int k = i * 256 + lane * 4; \
        if constexpr (IN_F32) XF[i] = *(const f32x4*)(xin + (size_t)(r) * DM + k); else XB[i] = *(const u32x2*)(xin16 + (size_t)(r) * DM + k); \
        Yv[i] = *(const u32x2*)(Y + (size_t)(r) * DM + k); } \
        S = lane < 16 ? SSQ[(size_t)(r) * 16 + lane] : 0.f; } while (0)
    f32x4 gp[4], n1[4], n0[4]; int cur_b = -1;
#define RP_PARAMS(b) do { const float* gate = gate_base + (size_t)(b) * gate_bstride; \
        _Pragma("unroll") for (int i = 0; i < 4; ++i) { const int k = i * 256 + lane * 4; const f32x4 gv = *(const f32x4*)(gate + k), pg = *(const f32x4*)(post_g + k); gp[i] = gv * pg; \
            if (has_next) { const f32x4 g = *(const f32x4*)(next_g + k), s1 = *(const f32x4*)(nsh_base + (size_t)(b) * n_bstride + k), c1 = *(const f32x4*)(nsc_base + (size_t)(b) * n_bstride + k); \
                n1[i] = g * (c1 + 1.f); n0[i] = s1; } } } while (0)
#define RP_COMP(XF, XB, Yv, S, row) do { \
        const int b = (row) / SEQL; if (b != cur_b) { RP_PARAMS(b); cur_b = b; } \
        const float ry = rsqrtf(wave_sum(S) * (1.f / 1024.f) + EPS); \
        f32x4 v[4]; float ss = 0.f; \
        _Pragma("unroll") for (int i = 0; i < 4; ++i) { const int k = i * 256 + lane * 4; \
            const f32x4 yv = {bflo(Yv[i].x), bfhi(Yv[i].x), bflo(Yv[i].y), bfhi(Yv[i].y)}; \
            f32x4 xv; if constexpr (IN_F32) xv = XF[i]; else xv = (f32x4){bflo(XB[i].x), bfhi(XB[i].x), bflo(XB[i].y), bfhi(XB[i].y)}; \
            _Pragma("unroll") for (int e = 0; e < 4; ++e) { v[i][e] = xv[e] + gp[i][e] * (yv[e] * ry); ss += v[i][e] * v[i][e]; } \
            if constexpr (OUT_F32) *(f32x4*)(xout + (size_t)(row) * DM + k) = v[i]; else { u32x2 xw; xw.x = pk2(v[i][0], v[i][1]); xw.y = pk2(v[i][2], v[i][3]); *(u32x2*)(xout16 + (size_t)(row) * DM + k) = xw; } } \
        if (has_next) { \
            ss = wave_sum(ss); const float r = rsqrtf(ss * (1.f / 1024.f) + EPS); \
            _Pragma("unroll") for (int i = 0; i < 4; ++i) { const int k = i * 256 + lane * 4; float o[4]; \
                _Pragma("unroll") for (int e = 0; e < 4; ++e) o[e] = v[i][e] * r * n1[i][e] + n0[i][e]; \
                u32x2 w; w.x = pk2(o[0], o[1]); w.y = pk2(o[2], o[3]); *(u32x2*)(H + (size_t)(row) * DM + k) = w; } } } while (0)
    const int r0 = blockIdx.x * 8 + wid;
    if (r0 < NLAT) RP_LOAD(xA, bA, yA, sA, r0);
    if (r0 + rs < NLAT) RP_LOAD(xB, bB, yB, sB, r0 + rs);
    if (r0 + 2 * rs < NLAT) RP_LOAD(xC, bC, yC, sC, r0 + 2 * rs);
    for (int row = r0; row < NLAT; row += 3 * rs) {
        RP_COMP(xA, bA, yA, sA, row); if (row + 3 * rs < NLAT) RP_LOAD(xA, bA, yA, sA, row + 3 * rs);
        if (row + rs < NLAT) { RP_COMP(xB, bB, yB, sB, row + rs); if (row + 4 * rs < NLAT) RP_LOAD(xB, bB, yB, sB, row + 4 * rs); }
        if (row + 2 * rs < NLAT) { RP_COMP(xC, bC, yC, sC, row + 2 * rs); if (row + 5 * rs < NLAT) RP_LOAD(xC, bC, yC, sC, row + 5 * rs); }
    }
#undef RP_LOAD
#undef RP_COMP
#undef RP_PARAMS
}

DI void phase12(const Args& a) {
    const int lane = tidx() & 63, wid = tidx() >> 6;
    const bf16_t* CU = (const bf16_t*)(a.ws + OFF_BIG); const bf16_t* BG = CU + (size_t)NLAT * DM; bf16_t* MIX = (bf16_t*)(a.ws + OFF_H);
    float w0[2][8], w1[2][8], w2[2][8];
#pragma unroll
    for (int part = 0; part < 2; ++part)
#pragma unroll
        for (int e = 0; e < 8; ++e) { const int ch = part * 512 + lane * 8 + e; w0[part][e] = a.sc_conv_w[ch]; w1[part][e] = a.sc_conv_w[1024 + ch]; w2[part][e] = a.sc_conv_w[2048 + ch]; }
    const u32x4 zero4 = {0u, 0u, 0u, 0u};
    for (int blk = blockIdx.x * 8 + wid; blk < NLAT / 16; blk += gridDim.x * 8) {
        const int r0 = blk * 16, t0 = r0 & (SEQL - 1);
        u32x4 xp[2], xc[2], xn[2], xnn[2], bg[2], bgn[2], bgnn[2];
#pragma unroll
        for (int part = 0; part < 2; ++part) { const bf16_t* p = CU + (size_t)r0 * DM + part * 512 + lane * 8; const bf16_t* pb = BG + (size_t)r0 * DM + part * 512 + lane * 8;
            xc[part] = *(const u32x4*)p; xp[part] = t0 > 0 ? *(const u32x4*)(p - DM) : zero4; xn[part] = t0 + 1 < SEQL ? *(const u32x4*)(p + DM) : zero4;
            bg[part] = *(const u32x4*)pb; bgn[part] = *(const u32x4*)(pb + DM); }
        for (int i = 0; i < 16; ++i) {
            const int row = r0 + i, t = t0 + i;
#pragma unroll
            for (int part = 0; part < 2; ++part) { xnn[part] = (i < 15 && t + 2 < SEQL) ? *(const u32x4*)(CU + (size_t)(row + 2) * DM + part * 512 + lane * 8) : zero4;
                bgnn[part] = i < 14 ? *(const u32x4*)(BG + (size_t)(row + 2) * DM + part * 512 + lane * 8) : zero4; }
#pragma unroll
            for (int part = 0; part < 2; ++part) {
                float fc[8], fp[8], fn[8], fb[8], o[8]; unpack8(xc[part], fc); unpack8(xp[part], fp); unpack8(xn[part], fn); unpack8(bg[part], fb);
#pragma unroll
                for (int e = 0; e < 8; ++e) o[e] = fb[e] * (w0[part][e] * fp[e] + w1[part][e] * fc[e] + w2[part][e] * fn[e]);
                *(u32x4*)(MIX + (size_t)row * DM + part * 512 + lane * 8) = pack8(o);
            }
#pragma unroll
            for (int part = 0; part < 2; ++part) { xp[part] = xc[part]; xc[part] = xn[part]; xn[part] = xnn[part]; bg[part] = bgn[part]; bgn[part] = bgnn[part]; }
        }
    }
}

#ifndef ONLY_PH
#define ONLY_PH -1
#endif
#define PHASE_ON(n) ((ONLY_PH) < 0 || (ONLY_PH) == (n))
constexpr int N_PHASES = 18;
__global__ void __launch_bounds__(512, 2) fwd_megakernel(Args a) {
    extern __shared__ __attribute__((aligned(16))) char smem[];
    cg::grid_group grid = cg::this_grid();
    const float* MOD = (const float*)(a.ws + OFF_MOD);
    const bf16_t* WT = (const bf16_t*)(a.ws + OFF_WT);
    bf16_t* H = (bf16_t*)(a.ws + OFF_H);
    bf16_t* BIG = (bf16_t*)(a.ws + OFF_BIG);
    bf16_t* Y = (bf16_t*)(a.ws + OFF_Y); float* SSQ = (float*)(a.ws + OFF_SSQ);
    const int lo = a.ph_lo, hi = a.ph_hi;
#define IN(k) (PHASE_ON(k) && lo <= (k) && (k) < hi)
#define SEAM(k) do { if (lo <= (k) && (k) + 1 < hi) grid.sync(); } while (0)
#ifndef DBL
#define DBL 0u
#endif
#ifndef XSYNC
#define XSYNC 0
#endif
#define PH(k, ...) do { if (IN(k)) { __VA_ARGS__; if (((DBL) >> (k)) & 1u) { grid.sync(); __VA_ARGS__; } } SEAM(k); } while (0)
    PH(0, phase0(a, smem););
    PH(1, phase1(a, smem););
    PH(2, { EpiProj E; E.AT = (bf16_t*)((unsigned char*)a.out + OUT_ATT); E.P = (bf16_t*)(a.ws + OFF_PG); E.Z = (bf16_t*)(a.ws + OFF_Z); run_gemm(smem, H, WT + WT_IN, MROWS, NPROJ, 1024, E); });
    PH(4, phase3b(a, smem););
    PH(5, phase4(a, smem););
    PH(6, phase5(a););
    PH(7, { EpiY E; E.Y = Y; E.SSQ = SSQ; run_gemm(smem, H, WT + WT_OUT, NLAT, 1024, 1024, E); });
    PH(8, rowpass<true, false>(a, a.x, a.ws + OFF_X16, MOD + 2 * 1024, 6144, a.post_mix_g, a.pre_ffn_g, MOD + 3 * 1024, MOD + 4 * 1024, 6144, true););
    PH(9, { EpiAct E; E.O = BIG; run_gemm(smem, H, WT + WT_GU0, NLAT, 5632, 1024, E); });
    PH(10, { EpiY E; E.Y = Y; E.SSQ = SSQ; run_gemm(smem, BIG, WT + WT_DN0, NLAT, 1024, FF, E); });
    PH(11, rowpass<false, false>(a, a.ws + OFF_X16, a.ws + OFF_X16, MOD + 5 * 1024, 6144, a.post_ffn_g, a.pre_mix_g + 1024, MOD + 3 * 6144 + 0 * 1024, MOD + 3 * 6144 + 1 * 1024, 6144, true););
    PH(12, { EpiSc E; E.CU = BIG; E.BG = BIG + (size_t)NLAT * DM; run_gemm(smem, H, WT + WT_SCIN, NLAT, 3072, 1024, E); });
    PH(13, phase12(a););
    PH(14, { EpiY E; E.Y = Y; E.SSQ = SSQ; run_gemm(smem, H, WT + WT_SCOUT, NLAT, 1024, 1024, E); });
    PH(15, rowpass<false, false>(a, a.ws + OFF_X16, a.ws + OFF_X16, MOD + 3 * 6144 + 2 * 1024, 6144, a.post_mix_g + 1024, a.pre_ffn_g + 1024, MOD + 3 * 6144 + 3 * 1024, MOD + 3 * 6144 + 4 * 1024, 6144, true););
    PH(16, { EpiAct E; E.O = BIG; run_gemm(smem, H, WT + WT_GU1, NLAT, 5632, 1024, E); });
    PH(17, { EpiY E; E.Y = Y; E.SSQ = SSQ; run_gemm(smem, BIG, WT + WT_DN1, NLAT, 1024, FF, E); });
    PH(18, rowpass<false, true>(a, a.ws + OFF_X16, a.out, MOD + 3 * 6144 + 5 * 1024, 6144, a.post_ffn_g + 1024, nullptr, nullptr, nullptr, 0, false););
}

extern "C" void kernel_launch(void* const* d_in, const int* in_sizes, int n_in, void* d_out, int out_size, void* d_ws, size_t ws_size, hipStream_t stream) {
    static int grid = 0;
    if (grid == 0) {
        if (n_in != 23 || ws_size < WS_NEED) { fprintf(stderr, "kernel_launch: unexpected n_in %d / ws %zu\n", n_in, ws_size); grid = -1; return; }
        int dev = 0, cus = 0, per_cu = 0;
        hipGetDevice(&dev); hipDeviceGetAttribute(&cus, hipDeviceAttributeMultiprocessorCount, dev);
        hipFuncSetAttribute((const void*)fwd_megakernel, hipFuncAttributeMaxDynamicSharedMemorySize, LDS_BYTES);
        hipOccupancyMaxActiveBlocksPerMultiprocessor(&per_cu, (const void*)fwd_megakernel, 512, LDS_BYTES);
        if (per_cu < 1) { fprintf(stderr, "kernel_launch: occupancy query says %d blocks/CU\n", per_cu); per_cu = 1; }
        grid = cus * 1;
        (void)hipGetLastError();
    }
    if (grid < 0) return;
    Args a{};
    const float** f = (const float**)&a;
    for (int i = 0; i < 23; ++i) f[i] = (const float*)d_in[i];
    a.out = (float*)d_out; a.ws = (unsigned char*)d_ws; a.ph_lo = 0; a.ph_hi = N_PHASES + 1;
    void* args[] = {&a};
    hipError_t e = hipLaunchCooperativeKernel((const void*)fwd_megakernel, dim3(grid), dim3(512), args, LDS_BYTES, stream);
    if (e != hipSuccess) fprintf(stderr, "cooperative launch failed: %s (grid %d)\n", hipGetErrorString(e), grid);
}
```

```cpp
#include <hip/hip_runtime.h>
#include <hip/hip_cooperative_groups.h>
#include <cstdio>
#include <cstdint>
namespace cg = cooperative_groups;

__device__ __forceinline__ int tidx() { int t = (int)threadIdx.x; asm volatile("" : "+v"(t)); return t & 511; }
namespace pg8 {
#define PG8_LAS __attribute__((address_space(3)))
typedef unsigned short bf16_t;
typedef short bf16x8 __attribute__((ext_vector_type(8)));
typedef float f32x4 __attribute__((ext_vector_type(4)));
typedef unsigned u32x4 __attribute__((ext_vector_type(4)));
constexpr int BM = 256, BK = 64, HALF = 128, HTB = HALF * BK * 2  , STAGE_BYTES = 8 * HTB, NXCD = 8, WGM = 8;

__host__ __device__ __forceinline__ int lds_byte(int r, int c) { const int st = (r >> 4) * 2 + (c >> 5), rr = r & 15, cc = c & 31, ob = rr * 64 + cc * 2; return st * 1024 + (ob ^ (((ob >> 9) & 1) << 5)); }
__host__ __device__ __forceinline__ void stage_rc(int b, int& R, int& C) { const int st = b / 1024, sb = b % 1024, swz = sb ^ (((sb >> 9) & 1) << 5); R = (st >> 1) * 16 + swz / 64; C = (st & 1) * 32 + (swz % 64) / 2; }
__host__ __device__ __forceinline__ int perm32(int rho) { const int n = rho >> 4, i = rho & 15; return 8 * (i >> 2) + 4 * n + (i & 3); }

struct Unit { int pm, pn; };
struct Gemm { const bf16_t* A; const bf16_t* Bt; int M, N, K; };

struct StaticOrder {
    int nM, nN, nwg, G, c;
    __host__ __device__ void init(int M, int N, int G_, int c_) { nM = M / BM; nN = N / BM; nwg = nM * nN; G = G_; c = c_; }
    __host__ __device__ bool next(int i, Unit& u) const {
        const long L = (long)i * G + c; if (L >= nwg) return false;
        int wgid = (int)L; { const int q = nwg / NXCD, r = nwg % NXCD, xcd = wgid % NXCD, off = wgid / NXCD; wgid = (xcd < r ? xcd * (q + 1) : r * (q + 1) + (xcd - r) * q) + off; }
        const int nig = WGM * nN, gid = wgid / nig, fm = gid * WGM, gsz = (nM - fm) < WGM ? (nM - fm) : WGM;
        u.pm = fm + ((wgid % nig) % gsz); u.pn = (wgid % nig) / gsz; return true;
    }
    __device__ __forceinline__ void a_ready(const Unit&) const {}
    __device__ __forceinline__ void done(const Unit&) const {}
};

__device__ __forceinline__ unsigned cvt_pk_bf16(float lo, float hi) { unsigned r; asm volatile("v_cvt_pk_bf16_f32 %0, %1, %2" : "=v"(r) : "v"(lo), "v"(hi)); return r; }
template <class Epi, class Sched, bool ALIGN_EPI = false, bool SP2 = false>
__device__ __forceinline__ void gemm_phase(PG8_LAS unsigned char* lds, const Gemm g, const Sched& S, const Epi& E) {
    const int tid = tidx(), wid = __builtin_amdgcn_readfirstlane(tid >> 6), lane = tid & 63, wr = wid >> 2, wc = wid & 3, fr = lane & 15, fq = lane >> 4;
    const int K = g.K, nt = K / BK;
    unsigned voffA[2], voffB[2];
#pragma unroll
    for (int i = 0; i < 2; ++i) { int R, C; stage_rc(tid * 16 + i * 8192, R, C); const int Rb = Epi::PERM ? ((R & ~31) + perm32(R & 31)) : R;
        voffA[i] = (unsigned)(R * K + C) * 2u; voffB[i] = (unsigned)(Rb * K + C) * 2u; }
    const size_t kstep = (size_t)(BK * 2);
    const size_t hstep = (size_t)HALF * K * 2;
    const size_t tstep = 2 * hstep;
    const unsigned ldsw = (unsigned)wid * 1024u;
    const int aoff = lds_byte(wr * 64 + fr, fq * 8), boff = lds_byte(wc * 32 + fr, fq * 8);
#define PG8_SA(b, h) (((b) * 2 + (h)) * HTB)
#define PG8_SB(b, h) ((4 + (b) * 2 + (h)) * HTB)
#define PG8_STAGE(bufoff, gbase, voff) do { _Pragma("unroll") for (int _i = 0; _i < 2; ++_i) \
        __builtin_amdgcn_global_load_lds((const unsigned*)((const char*)(gbase) + (voff)[_i]), (PG8_LAS unsigned*)(lds + (bufoff) + ldsw + _i * 8192), 16, 0, 0); } while (0)
#define PG8_LDA(dst, b, h) do { _Pragma("unroll") for (int m = 0; m < 4; ++m) _Pragma("unroll") for (int k = 0; k < 2; ++k) dst[m][k] = *(const PG8_LAS bf16x8*)(lds + PG8_SA(b, h) + aoff + m * 2048 + k * 1024); } while (0)
#define PG8_LDB(dst, b, h) do { _Pragma("unroll") for (int n = 0; n < 2; ++n) _Pragma("unroll") for (int k = 0; k < 2; ++k) dst[n][k] = *(const PG8_LAS bf16x8*)(lds + PG8_SB(b, h) + boff + n * 2048 + k * 1024); } while (0)
#define PG8_MMA(ai, bj, At, Bt) do { __builtin_amdgcn_s_setprio(1); _Pragma("unroll") for (int m = 0; m < 4; ++m) _Pragma("unroll") for (int n = 0; n < 2; ++n) _Pragma("unroll") for (int k = 0; k < 2; ++k) \
        acc[ai][bj][m][n] = __builtin_amdgcn_mfma_f32_16x16x32_bf16(Bt[n][k], At[m][k], acc[ai][bj][m][n], 0, 0, 0); __builtin_amdgcn_s_setprio(0); } while (0)
#define PG8_WAIT_V(n) asm volatile("s_waitcnt vmcnt(" #n ")" ::: "memory")
#define PG8_WAIT_L(n) asm volatile("s_waitcnt lgkmcnt(" #n ")" ::: "memory")
#define PG8_BAR __builtin_amdgcn_s_barrier()
#define PG8_SCHED __builtin_amdgcn_sched_barrier(0)
    Unit cur, nxt; int ui = 0;
    if (!S.next(0, cur)) return;
    f32x4 acc[2][2][4][2];
#pragma unroll
    for (int a = 0; a < 2; ++a)
#pragma unroll
        for (int b = 0; b < 2; ++b)
#pragma unroll
            for (int m = 0; m < 4; ++m)
#pragma unroll
                for (int n = 0; n < 2; ++n) acc[a][b][m][n] = (f32x4){0.f, 0.f, 0.f, 0.f};
    bf16x8 At[4][2], B0[2][2], B1[2][2];
    const char* cA = (const char*)g.A + (size_t)cur.pm * tstep; const char* cB = (const char*)g.Bt + (size_t)cur.pn * tstep;
    S.a_ready(cur);
    if constexpr (SP2) {
        PG8_STAGE(PG8_SB(0, 0), cB, voffB); PG8_STAGE(PG8_SB(0, 1), cB + hstep, voffB); PG8_STAGE(PG8_SA(0, 0), cA, voffA); PG8_STAGE(PG8_SA(0, 1), cA + hstep, voffA);
        if (wr == 1) PG8_BAR;
        PG8_WAIT_V(2); PG8_BAR;
        PG8_STAGE(PG8_SB(1, 0), cB + kstep, voffB); PG8_STAGE(PG8_SA(1, 0), cA + kstep, voffA); PG8_STAGE(PG8_SB(1, 1), cB + hstep + kstep, voffB);
        PG8_WAIT_V(6); PG8_BAR;
    } else {
        PG8_STAGE(PG8_SB(0, 0), cB, voffB); PG8_STAGE(PG8_SA(0, 0), cA, voffA); PG8_STAGE(PG8_SB(0, 1), cB + hstep, voffB); PG8_STAGE(PG8_SA(0, 1), cA + hstep, voffA);
        if (wr == 1) PG8_BAR;
        PG8_WAIT_V(4); PG8_BAR;
        PG8_STAGE(PG8_SB(1, 0), cB + kstep, voffB); PG8_STAGE(PG8_SA(1, 0), cA + kstep, voffA); PG8_STAGE(PG8_SB(1, 1), cB + hstep + kstep, voffB);
        PG8_WAIT_V(6); PG8_BAR;
    }
    for (;;) {
        const bool has_next = S.next(ui + 1, nxt);
        const char* nA = has_next ? (const char*)g.A + (size_t)nxt.pm * tstep : cA; const char* nB = has_next ? (const char*)g.Bt + (size_t)nxt.pn * tstep : cB;
        for (int t = 0; t < nt; t += 2) {
            const bool last = (t == nt - 2);
            const char* a1 = cA + (size_t)(t + 1) * kstep;
            const char* a2 = last ? nA : cA + (size_t)(t + 2) * kstep; const char* b2 = last ? nB : cB + (size_t)(t + 2) * kstep;
            const char* a3 = a2 + kstep; const char* b3 = b2 + kstep;
            if (last && has_next) S.a_ready(nxt);
            if constexpr (SP2) {
            PG8_LDB(B0, 0, 0); PG8_LDB(B1, 0, 1); PG8_SCHED; PG8_LDA(At, 0, 0); PG8_STAGE(PG8_SA(1, 1), a1 + hstep, voffA);
            PG8_WAIT_V(8); PG8_WAIT_L(0); PG8_BAR; PG8_MMA(0, 0, At, B0); PG8_MMA(0, 1, At, B1); PG8_BAR; PG8_SCHED;
            PG8_LDA(At, 0, 1); PG8_STAGE(PG8_SB(0, 0), b2, voffB); PG8_STAGE(PG8_SB(0, 1), b2 + hstep, voffB); PG8_STAGE(PG8_SA(0, 0), a2, voffA);
            PG8_WAIT_V(8); PG8_WAIT_L(0); PG8_BAR; PG8_MMA(1, 0, At, B0); PG8_MMA(1, 1, At, B1); PG8_BAR; PG8_SCHED;
            PG8_LDB(B0, 1, 0); PG8_LDB(B1, 1, 1); PG8_SCHED; PG8_LDA(At, 1, 0); PG8_STAGE(PG8_SA(0, 1), a2 + hstep, voffA);
            PG8_WAIT_V(8); PG8_WAIT_L(0); PG8_BAR; PG8_MMA(0, 0, At, B0); PG8_MMA(0, 1, At, B1); PG8_BAR; PG8_SCHED;
            PG8_LDA(At, 1, 1); PG8_STAGE(PG8_SB(1, 0), b3, voffB); PG8_STAGE(PG8_SB(1, 1), b3 + hstep, voffB); PG8_STAGE(PG8_SA(1, 0), a3, voffA);
            PG8_WAIT_V(8); PG8_WAIT_L(0); PG8_BAR; PG8_MMA(1, 0, At, B0); PG8_MMA(1, 1, At, B1); PG8_BAR; PG8_SCHED;
            } else {
            PG8_LDB(B0, 0, 0); PG8_SCHED; PG8_LDA(At, 0, 0); PG8_STAGE(PG8_SA(1, 1), a1 + hstep, voffA);
            PG8_WAIT_L(8); PG8_BAR; PG8_WAIT_L(0); PG8_MMA(0, 0, At, B0); PG8_BAR; PG8_SCHED;
            PG8_LDB(B1, 0, 1); PG8_STAGE(PG8_SB(0, 0), b2, voffB);
            PG8_BAR; PG8_WAIT_L(0); PG8_MMA(0, 1, At, B1); PG8_BAR;
            PG8_LDA(At, 0, 1); PG8_STAGE(PG8_SA(0, 0), a2, voffA);
            PG8_BAR; PG8_WAIT_L(0); PG8_MMA(1, 0, At, B0); PG8_BAR; PG8_SCHED;
            PG8_STAGE(PG8_SB(0, 1), b2 + hstep, voffB);
            PG8_WAIT_V(6); PG8_BAR; PG8_MMA(1, 1, At, B1); PG8_BAR;
            PG8_LDB(B0, 1, 0); PG8_SCHED; PG8_LDA(At, 1, 0); PG8_STAGE(PG8_SA(0, 1), a2 + hstep, voffA);
            PG8_WAIT_L(8); PG8_BAR; PG8_WAIT_L(0); PG8_MMA(0, 0, At, B0); PG8_BAR; PG8_SCHED;
            PG8_LDB(B1, 1, 1); PG8_STAGE(PG8_SB(1, 0), b3, voffB);
            PG8_BAR; PG8_WAIT_L(0); PG8_MMA(0, 1, At, B1); PG8_BAR;
            PG8_LDA(At, 1, 1); PG8_STAGE(PG8_SA(1, 0), a3, voffA);
            PG8_BAR; PG8_WAIT_L(0); PG8_MMA(1, 0, At, B0); PG8_BAR; PG8_SCHED;
            PG8_STAGE(PG8_SB(1, 1), b3 + hstep, voffB);
            PG8_WAIT_V(6); PG8_BAR; PG8_MMA(1, 1, At, B1); PG8_BAR;
            }
        }
        if constexpr (ALIGN_EPI) { if (wr == 0) PG8_BAR; }
        if constexpr (!Epi::AFTER_DRAIN) { E(acc, cur, wr, wc, fr, fq); S.done(cur); }
        if (!has_next) break;
#pragma unroll
        for (int a = 0; a < 2; ++a)
#pragma unroll
            for (int b = 0; b < 2; ++b)
#pragma unroll
                for (int m = 0; m < 4; ++m)
#pragma unroll
                    for (int n = 0; n < 2; ++n) acc[a][b][m][n] = (f32x4){0.f, 0.f, 0.f, 0.f};
        cur = nxt; cA = nA; cB = nB; ++ui;
        if constexpr (ALIGN_EPI) { if (wr == 1) PG8_BAR; }
    }
    PG8_WAIT_V(0);
    if constexpr (!ALIGN_EPI) { if (wr == 0) PG8_BAR; }
    PG8_BAR;
    if constexpr (Epi::AFTER_DRAIN) { E.fused(acc, cur, wr, wc, fr, fq, lds, wid, lane); S.done(cur); }
#undef PG8_SA
#undef PG8_SB
#undef PG8_STAGE
#undef PG8_LDA
#undef PG8_LDB
#undef PG8_MMA
#undef PG8_WAIT_V
#undef PG8_WAIT_L
#undef PG8_BAR
#undef PG8_SCHED
}
}

using pg8::bf16_t; using pg8::bf16x8; using pg8::f32x4; using pg8::u32x4;
typedef unsigned u32x2 __attribute__((ext_vector_type(2)));
#define DI __device__ __forceinline__
#define LAS __attribute__((address_space(3)))
constexpr int DM = 1024, SEQL = 16384, NB = 2, NLAT = NB * SEQL, CTXL = 256, NCTX = NB * CTXL, MROWS = NLAT + NCTX;
constexpr int FF = 2816, NPROJ = 2816, PG_LD = 1536, ATT_LD = 768, HYIN = 2832;
constexpr size_t OUT_ATT = (size_t)40 << 20;
constexpr int NCHUNK = MROWS / 64;
constexpr int NREC = NCHUNK * 4 * 2;
constexpr int REC_BYTES = 73728, REC_W = 0, REC_QG = 16384, REC_KTT = 32768, REC_QK = 49152, REC_UT = 57344;
constexpr int REC_IN_WS = 3640;
constexpr float EPS = 1e-6f;
constexpr int LDS_BYTES = 163840;
constexpr size_t MiB = 1u << 20;
constexpr size_t OFF_MOD = 1 * MiB, OFF_ROPE = OFF_MOD + 512 * 1024, OFF_EGL = OFF_ROPE + 256 * 1024, OFF_AB = 2 * MiB, OFF_SSQ = 5 * MiB, OFF_WT = 8 * MiB;
constexpr size_t OFF_H = 58 * MiB, OFF_Z = 124 * MiB, OFF_QN = 157 * MiB, OFF_KN = 190 * MiB, OFF_VN = 223 * MiB, OFF_BIG = 256 * MiB, OFF_Y = 124 * MiB, OFF_O = 190 * MiB, OFF_X16 = 190 * MiB, OFF_PG = 157 * MiB;
constexpr size_t WS_NEED = 512 * MiB;
constexpr size_t OFF_PROG = OFF_EGL + 32 * 1024;
constexpr size_t WT_IN = 0, WT_OUT = WT_IN + (size_t)2816 * 1024, WT_GU0 = WT_OUT + (size_t)1024 * 1024, WT_DN0 = WT_GU0 + (size_t)5632 * 1024, WT_SCIN = WT_DN0 + (size_t)1024 * 2816,
                 WT_SCOUT = WT_SCIN + (size_t)3072 * 1024, WT_GU1 = WT_SCOUT + (size_t)1024 * 1024, WT_DN1 = WT_GU1 + (size_t)5632 * 1024, WT_END = WT_DN1 + (size_t)1024 * 2816;

struct Args {
    const float* x; const float* c; const float* ctx; const float* c_ctx; const float* ada_w; const float* ada_b; const float* pre_mix_g; const float* post_mix_g; const float* pre_ffn_g; const float* post_ffn_g;
    const float* hy_w_in; const float* hy_w_out; const float* attn_sink; const float* gdn_conv_w; const float* gdn_a_log; const float* gdn_dt_bias; const float* gdn_norm_g;
    const float* sc_w_in; const float* sc_conv_w; const float* sc_w_out; const float* ffn_w_gate; const float* ffn_w_up; const float* ffn_w_down;
    float* out; unsigned char* ws; int ph_lo, ph_hi;
};

DI unsigned f2bf(float f) { unsigned u = __float_as_uint(f); return (u + 0x7fffu + ((u >> 16) & 1u)) >> 16; }
typedef float f32x2_t __attribute__((ext_vector_type(2)));
typedef __bf16 bf16x2_t __attribute__((ext_vector_type(2)));
DI unsigned pk2(float lo, float hi) { f32x2_t v = {lo, hi}; bf16x2_t b = __builtin_convertvector(v, bf16x2_t); return __builtin_bit_cast(unsigned, b); }
DI float bflo(unsigned u) { return __uint_as_float(u << 16); }
DI float bfhi(unsigned u) { return __uint_as_float(u & 0xffff0000u); }
DI float bf1(bf16_t h) { return __uint_as_float(((unsigned)h) << 16); }
DI float wave_sum(float v) {
#pragma unroll
    for (int o = 32; o; o >>= 1) v += __shfl_xor(v, o);
    return v;
}
DI float siluf(float x) { return x * __builtin_amdgcn_rcpf(1.f + __expf(-x)); }
DI f32x4 mfma16(bf16x8 a, bf16x8 b, f32x4 c) { return __builtin_amdgcn_mfma_f32_16x16x32_bf16(a, b, c, 0, 0, 0); }
DI bf16x8 pack2(f32x4 a, f32x4 b) { u32x4 p; p.x = pk2(a[0], a[1]); p.y = pk2(a[2], a[3]); p.z = pk2(b[0], b[1]); p.w = pk2(b[2], b[3]); return __builtin_bit_cast(bf16x8, p); }
DI bf16x8 ldf16(const char* p) { return *(const bf16x8*)p; }
DI bf16x8 ldf8x2(const char* p) { u32x2 lo = *(const u32x2*)p; u32x2 hi = *(const u32x2*)(p + 32); u32x4 v; v.x = lo.x; v.y = lo.y; v.z = hi.x; v.w = hi.y; return __builtin_bit_cast(bf16x8, v); }
DI void unpack8(u32x4 v, float (&f)[8]) { f[0] = bflo(v.x); f[1] = bfhi(v.x); f[2] = bflo(v.y); f[3] = bfhi(v.y); f[4] = bflo(v.z); f[5] = bfhi(v.z); f[6] = bflo(v.w); f[7] = bfhi(v.w); }
DI u32x4 pack8(const float (&f)[8]) { u32x4 v; v.x = pk2(f[0], f[1]); v.y = pk2(f[2], f[3]); v.z = pk2(f[4], f[5]); v.w = pk2(f[6], f[7]); return v; }

DI unsigned char* rec_ptr(const Args& a, int r) { return r < REC_IN_WS ? a.ws + OFF_BIG + (size_t)r * REC_BYTES : (unsigned char*)a.out + (size_t)(r - REC_IN_WS) * REC_BYTES; }

struct EpiProj {
    static constexpr bool PERM = true, AFTER_DRAIN = false;
    bf16_t* AT; bf16_t* P; bf16_t* Z;
    DI void operator()(const f32x4 (&acc)[2][2][4][2], const pg8::Unit& u, int wr, int wc, int fr, int fq) const {
        const int row0 = u.pm * 256 + wr * 64 + fr; bf16_t* base; int ld, colt;
        if (u.pn < 3) { base = AT; ld = ATT_LD; colt = u.pn * 256; } else if (u.pn < 9) { base = P; ld = PG_LD; colt = (u.pn - 3) * 256; } else { base = Z; ld = 512; colt = (u.pn - 9) * 256; }
        const int col0 = colt + wc * 32 + 8 * fq;
#pragma unroll
        for (int ai = 0; ai < 2; ++ai)
#pragma unroll
            for (int m = 0; m < 4; ++m) { bf16_t* rowp = base + (size_t)(row0 + ai * 128 + m * 16) * ld + col0;
#pragma unroll
                for (int bj = 0; bj < 2; ++bj) { const f32x4 v0 = acc[ai][bj][m][0], v1 = acc[ai][bj][m][1]; u32x4 w;
                    w.x = pg8::cvt_pk_bf16(v0[0], v0[1]); w.y = pg8::cvt_pk_bf16(v0[2], v0[3]); w.z = pg8::cvt_pk_bf16(v1[0], v1[1]); w.w = pg8::cvt_pk_bf16(v1[2], v1[3]);
                    *(u32x4*)(rowp + bj * 128) = w; } }
    }
};
struct EpiAct {
    static constexpr bool PERM = true, AFTER_DRAIN = false;
    bf16_t* O;
    DI void operator()(const f32x4 (&acc)[2][2][4][2], const pg8::Unit& u, int wr, int wc, int fr, int fq) const {
        const int row0 = u.pm * 256 + wr * 64 + fr, col0 = u.pn * 128 + wc * 32 + 8 * fq;
#pragma unroll
        for (int ai = 0; ai < 2; ++ai)
#pragma unroll
            for (int m = 0; m < 4; ++m) { bf16_t* rowp = O + (size_t)(row0 + ai * 128 + m * 16) * FF + col0; float v[8];
#pragma unroll
                for (int n = 0; n < 2; ++n)
#pragma unroll
                    for (int e = 0; e < 4; ++e) v[4 * n + e] = siluf(acc[ai][0][m][n][e]) * acc[ai][1][m][n][e];
                u32x4 w; w.x = pg8::cvt_pk_bf16(v[0], v[1]); w.y = pg8::cvt_pk_bf16(v[2], v[3]); w.z = pg8::cvt_pk_bf16(v[4], v[5]); w.w = pg8::cvt_pk_bf16(v[6], v[7]);
                *(u32x4*)rowp = w; }
    }
};
struct EpiSc {
    static constexpr bool PERM = true, AFTER_DRAIN = false;
    bf16_t* CU; bf16_t* BG;
    DI void operator()(const f32x4 (&acc)[2][2][4][2], const pg8::Unit& u, int wr, int wc, int fr, int fq) const {
        const int row0 = u.pm * 256 + wr * 64 + fr;
        if (u.pn < 8) {
            const int col0 = u.pn * 128 + wc * 32 + 8 * fq;
#pragma unroll
            for (int ai = 0; ai < 2; ++ai)
#pragma unroll
                for (int m = 0; m < 4; ++m) { bf16_t* rowp = CU + (size_t)(row0 + ai * 128 + m * 16) * DM + col0; float v[8];
#pragma unroll
                    for (int n = 0; n < 2; ++n)
#pragma unroll
                        for (int e = 0; e < 4; ++e) v[4 * n + e] = acc[ai][0][m][n][e] * acc[ai][1][m][n][e];
                    u32x4 w; w.x = pg8::cvt_pk_bf16(v[0], v[1]); w.y = pg8::cvt_pk_bf16(v[2], v[3]); w.z = pg8::cvt_pk_bf16(v[4], v[5]); w.w = pg8::cvt_pk_bf16(v[6], v[7]);
                    *(u32x4*)rowp = w; }
        } else {
            const int col0 = (u.pn - 8) * 256 + wc * 32 + 8 * fq;
#pragma unroll
            for (int ai = 0; ai < 2; ++ai)
#pragma unroll
                for (int m = 0; m < 4; ++m) { bf16_t* rowp = BG + (size_t)(row0 + ai * 128 + m * 16) * DM + col0;
#pragma unroll
                    for (int bj = 0; bj < 2; ++bj) { const f32x4 v0 = acc[ai][bj][m][0], v1 = acc[ai][bj][m][1]; u32x4 w;
                        w.x = pg8::cvt_pk_bf16(v0[0], v0[1]); w.y = pg8::cvt_pk_bf16(v0[2], v0[3]); w.z = pg8::cvt_pk_bf16(v1[0], v1[1]); w.w = pg8::cvt_pk_bf16(v1[2], v1[3]);
                        *(u32x4*)(rowp + bj * 128) = w; } }
        }
    }
};
struct EpiY {
    static constexpr bool PERM = true, AFTER_DRAIN = false;
    bf16_t* Y; float* SSQ;
    DI void operator()(const f32x4 (&acc)[2][2][4][2], const pg8::Unit& u, int wr, int wc, int fr, int fq) const {
        const int row0 = u.pm * 256 + wr * 64 + fr, col0 = u.pn * 256 + wc * 32 + 8 * fq;
#pragma unroll
        for (int ai = 0; ai < 2; ++ai)
#pragma unroll
            for (int m = 0; m < 4; ++m) { const int row = row0 + ai * 128 + m * 16; bf16_t* rowp = Y + (size_t)row * DM + col0; float s = 0.f;
#pragma unroll
                for (int bj = 0; bj < 2; ++bj) { const f32x4 v0 = acc[ai][bj][m][0], v1 = acc[ai][bj][m][1]; u32x4 w;
                    w.x = pg8::cvt_pk_bf16(v0[0], v0[1]); w.y = pg8::cvt_pk_bf16(v0[2], v0[3]); w.z = pg8::cvt_pk_bf16(v1[0], v1[1]); w.w = pg8::cvt_pk_bf16(v1[2], v1[3]);
                    *(u32x4*)(rowp + bj * 128) = w;
                    s += v0[0] * v0[0] + v0[1] * v0[1] + v0[2] * v0[2] + v0[3] * v0[3] + v1[0] * v1[0] + v1[1] * v1[1] + v1[2] * v1[2] + v1[3] * v1[3]; }
                s += __shfl_xor(s, 16); s += __shfl_xor(s, 32);
                if (fq == 0) SSQ[(size_t)row * 16 + u.pn * 4 + wc] = s; }
    }
};

template <class Epi> DI void run_gemm(char* smem, const bf16_t* A, const bf16_t* Bt, int M, int N, int K, const Epi& E) {
    pg8::Gemm g; g.A = A; g.Bt = Bt; g.M = M; g.N = N; g.K = K;
    pg8::StaticOrder S; S.init(M, N, (int)gridDim.x, (int)blockIdx.x);
    pg8::gemm_phase<Epi, pg8::StaticOrder, false, true>((PG8_LAS unsigned char*)smem, g, S, E);
    __syncthreads();
}

DI void p0_ada_unit(const Args& a, char* smem, int u) {
    const int l = u / 96, col0 = (u % 96) * 64, tid = tidx();
    float* sc = (float*)smem;
    float* red = (float*)(smem + 12288);
    for (int i = tid; i < 3072; i += 512) { const int cd = i >> 10, k = i & 1023; const float v = cd < 2 ? a.c[cd * DM + k] : a.c_ctx[k]; sc[i] = siluf(v); }
    __syncthreads();
    const int col = tid & 63, kq = tid >> 6;
    const float* W = a.ada_w + (size_t)l * DM * 6144 + col0 + col;
    float s0 = 0.f, s1 = 0.f, s2 = 0.f;
    for (int k0 = kq * 128; k0 < kq * 128 + 128; k0 += 16) { float w[16];
#pragma unroll
        for (int j = 0; j < 16; ++j) w[j] = W[(size_t)(k0 + j) * 6144];
#pragma unroll
        for (int j = 0; j < 16; ++j) { s0 += sc[k0 + j] * w[j]; s1 += sc[1024 + k0 + j] * w[j]; s2 += sc[2048 + k0 + j] * w[j]; } }
    red[(kq * 3 + 0) * 64 + col] = s0; red[(kq * 3 + 1) * 64 + col] = s1; red[(kq * 3 + 2) * 64 + col] = s2;
    __syncthreads();
    if (tid < 192) { const int cd = tid >> 6, cc = tid & 63; float s = 0.f;
        for (int q = 0; q < 8; ++q) s += red[(q * 3 + cd) * 64 + cc];
        float* MOD = (float*)(a.ws + OFF_MOD);
        MOD[((size_t)l * 3 + cd) * 6144 + col0 + cc] = s + a.ada_b[l * 6144 + col0 + cc]; }
    __syncthreads();
}
DI void p0_rope_unit(const Args& a) {
    if (tidx() < 16) __hip_atomic_store((unsigned*)(a.ws + OFF_PROG) + tidx() * 16, 0u, __ATOMIC_RELAXED, __HIP_MEMORY_SCOPE_AGENT);
    float2* R = (float2*)(a.ws + OFF_ROPE);
    for (int i = tidx(); i < 4096; i += 512) { const int p = i >> 4, f = i & 15;
        const float inv = powf(10000.f, -(float)f / 16.f); const float ang = (float)p * inv;
        R[i] = make_float2(cosf(ang), sinf(ang)); }
}
struct WtTile { const float* src; bf16_t* dst; int ldn, K, scol0, n0, k0; };
DI WtTile p0_wt_desc(const Args& a, int t) {
    bf16_t* WT = (bf16_t*)(a.ws + OFF_WT);
    const int T_IN = 44 * 16, T_OUT = 16 * 16, T_GU = 88 * 16, T_DN = 16 * 44, T_SCIN = 48 * 16, T_SCOUT = 16 * 16;
    int m = 0; int rem = t;
    if (rem >= T_IN) { rem -= T_IN; m = 1;
      if (rem >= T_OUT) { rem -= T_OUT; m = 2;
        if (rem >= T_GU) { rem -= T_GU; m = 3;
          if (rem >= T_DN) { rem -= T_DN; m = 4;
            if (rem >= T_SCIN) { rem -= T_SCIN; m = 5;
              if (rem >= T_SCOUT) { rem -= T_SCOUT; m = 6;
                if (rem >= T_GU) { rem -= T_GU; m = 7; } } } } } } }
    WtTile d; int nb, kb;
    if (m == 0) { d.K = 1024; nb = rem / 16; kb = rem % 16; d.src = a.hy_w_in; d.ldn = HYIN; d.scol0 = nb * 64; d.dst = WT + WT_IN; }
    else if (m == 1) { d.K = 1024; nb = rem / 16; kb = rem % 16; d.src = a.hy_w_out; d.ldn = 1024; d.scol0 = nb * 64; d.dst = WT + WT_OUT; }
    else if (m == 2 || m == 6) { const int l = m == 2 ? 0 : 1; d.K = 1024; nb = rem / 16; kb = rem % 16; const int n0 = nb * 64, pn = n0 >> 8, sg = (n0 >> 7) & 1, i0 = n0 & 127;
        d.src = (sg ? a.ffn_w_up : a.ffn_w_gate) + (size_t)l * DM * FF; d.ldn = FF; d.scol0 = pn * 128 + i0; d.dst = WT + (l ? WT_GU1 : WT_GU0); }
    else if (m == 3 || m == 7) { const int l = m == 3 ? 0 : 1; d.K = 2816; nb = rem / 44; kb = rem % 44; d.src = a.ffn_w_down + (size_t)l * FF * DM; d.ldn = 1024; d.scol0 = nb * 64; d.dst = WT + (l ? WT_DN1 : WT_DN0); }
    else if (m == 4) { d.K = 1024; nb = rem / 16; kb = rem % 16; const int n0 = nb * 64; d.src = a.sc_w_in; d.ldn = 3072; d.dst = WT + WT_SCIN;
        if (n0 < 2048) { const int pn = n0 >> 8, sg = (n0 >> 7) & 1, i0 = n0 & 127; d.scol0 = (sg ? 2048 : 1024) + pn * 128 + i0; } else d.scol0 = n0 - 2048; }
    else { d.K = 1024; nb = rem / 16; kb = rem % 16; d.src = a.sc_w_out; d.ldn = 1024; d.scol0 = nb * 64; d.dst = WT + WT_SCOUT; }
    d.n0 = nb * 64; d.k0 = kb * 64; return d;
}
constexpr int P0_WT_TILES = 44 * 16 + 16 * 16 + 88 * 16 + 16 * 44 + 48 * 16 + 16 * 16 + 88 * 16 + 16 * 44;
constexpr int P0_WT_GROUPS = P0_WT_TILES / 4, P0_WT_EARLY = 44 * 16 / 4;
DI void p0_wt_group(const Args& a, char* smem, int g) {
    const int tid = tidx(); float* T = (float*)smem;
    f32x4 v0[4], v1[4];
#pragma unroll
    for (int j = 0; j < 4; ++j) { const WtTile d = p0_wt_desc(a, g * 4 + j); const int k = tid >> 3, ns = (tid & 7) * 8; const float* p = d.src + (size_t)(d.k0 + k) * d.ldn + d.scol0 + ns;
        v0[j] = *(const f32x4*)p; v1[j] = *(const f32x4*)(p + 4); }
#pragma unroll
    for (int j = 0; j < 4; ++j) { const int k = tid >> 3, ns = (tid & 7) * 8; float* t = T + j * 4160 + k * 65 + ns;
        t[0] = v0[j][0]; t[1] = v0[j][1]; t[2] = v0[j][2]; t[3] = v0[j][3]; t[4] = v1[j][0]; t[5] = v1[j][1]; t[6] = v1[j][2]; t[7] = v1[j][3]; }
    __syncthreads();
#pragma unroll
    for (int j = 0; j < 4; ++j) { const WtTile d = p0_wt_desc(a, g * 4 + j); const int n = tid >> 3, ks = (tid & 7) * 8; float f[8];
#pragma unroll
        for (int e = 0; e < 8; ++e) f[e] = T[j * 4160 + (ks + e) * 65 + n];
        *(u32x4*)(d.dst + (size_t)(d.n0 + n) * d.K + d.k0 + ks) = pack8(f); }
    __syncthreads();
}
DI void phase0(const Args& a, char* smem) {
    for (int u = blockIdx.x; u < 193 + P0_WT_EARLY; u += gridDim.x) {
        if (u < 192) p0_ada_unit(a, smem, u); else if (u == 192) p0_rope_unit(a); else p0_wt_group(a, smem, u - 193);
    }
}

DI void phase1(const Args& a, char* smem) {
    float* WAB = (float*)smem;
    const int tid = tidx(), lane = tid & 63, wid = tid >> 6;
    for (int i = tid; i < 16384; i += 512) { const int k = i >> 4, j = i & 15; WAB[j * 1024 + k] = a.hy_w_in[(size_t)k * HYIN + 2816 + j]; }
    __syncthreads();
    const float* MOD = (const float*)(a.ws + OFF_MOD);
    bf16_t* H = (bf16_t*)(a.ws + OFF_H); float* AB = (float*)(a.ws + OFF_AB);
    f32x4 m1[4], m0[4]; int cur_cd = -1;
    const int rs = (int)gridDim.x * 8;
    f32x4 nv[4];
    { const int row0 = blockIdx.x * 8 + wid; if (row0 < MROWS) { const float* src0 = row0 < NLAT ? a.x + (size_t)row0 * DM : a.ctx + (size_t)(row0 - NLAT) * DM;
#pragma unroll
        for (int i = 0; i < 4; ++i) nv[i] = *(const f32x4*)(src0 + i * 256 + lane * 4); } }
    for (int row = blockIdx.x * 8 + wid; row < MROWS; row += rs) {
        const int cd = row < NLAT ? row / SEQL : 2;
        if (cd != cur_cd) { const float* sh = MOD + (size_t)cd * 6144, *scl = sh + 1024;
#pragma unroll
            for (int i = 0; i < 4; ++i) { const int k = i * 256 + lane * 4; const f32x4 g = *(const f32x4*)(a.pre_mix_g + k), s1 = *(const f32x4*)(sh + k), c1 = *(const f32x4*)(scl + k); m1[i] = g * (c1 + 1.f); m0[i] = s1; }
            cur_cd = cd; }
        f32x4 v[4]; float ss = 0.f;
#pragma unroll
        for (int i = 0; i < 4; ++i) { v[i] = nv[i]; ss += v[i][0] * v[i][0] + v[i][1] * v[i][1] + v[i][2] * v[i][2] + v[i][3] * v[i][3]; }
        { const int nrow = row + rs; if (nrow < MROWS) { const float* srcn = nrow < NLAT ? a.x + (size_t)nrow * DM : a.ctx + (size_t)(nrow - NLAT) * DM;
#pragma unroll
            for (int i = 0; i < 4; ++i) nv[i] = *(const f32x4*)(srcn + i * 256 + lane * 4); } }
        ss = wave_sum(ss); const float r = rsqrtf(ss * (1.f / 1024.f) + EPS);
#pragma unroll
        for (int i = 0; i < 4; ++i) { const int k = i * 256 + lane * 4;
#pragma unroll
            for (int e = 0; e < 4; ++e) v[i][e] = v[i][e] * r * m1[i][e] + m0[i][e];
            u32x2 w; w.x = pk2(v[i][0], v[i][1]); w.y = pk2(v[i][2], v[i][3]); *(u32x2*)(H + (size_t)row * DM + k) = w; }
        float p[16];
#pragma unroll
        for (int j = 0; j < 16; ++j) { float sj = 0.f;
#pragma unroll
            for (int i = 0; i < 4; ++i) { const f32x4 w = *(const f32x4*)(WAB + j * 1024 + i * 256 + lane * 4); sj += v[i][0] * w[0] + v[i][1] * w[1] + v[i][2] * w[2] + v[i][3] * w[3]; }
            p[j] = sj; __builtin_amdgcn_sched_barrier(0); }
        float q8[8], q4[4], q2[2], q1;
        { const bool hi = (lane & 32) != 0;
#pragma unroll
          for (int t = 0; t < 8; ++t) { const float snd = hi ? p[t] : p[t + 8], kp = hi ? p[t + 8] : p[t]; q8[t] = kp + __shfl_xor(snd, 32); } }
        { const bool hi = (lane & 16) != 0;
#pragma unroll
          for (int t = 0; t < 4; ++t) { const float snd = hi ? q8[t] : q8[t + 4], kp = hi ? q8[t + 4] : q8[t]; q4[t] = kp + __shfl_xor(snd, 16); } }
        { const bool hi = (lane & 8) != 0;
#pragma unroll
          for (int t = 0; t < 2; ++t) { const float snd = hi ? q4[t] : q4[t + 2], kp = hi ? q4[t + 2] : q4[t]; q2[t] = kp + __shfl_xor(snd, 8); } }
        { const bool hi = (lane & 4) != 0; const float snd = hi ? q2[0] : q2[1], kp = hi ? q2[1] : q2[0]; q1 = kp + __shfl_xor(snd, 4); }
        q1 += __shfl_xor(q1, 2); q1 += __shfl_xor(q1, 1);
        if ((lane & 3) == 0) AB[(size_t)row * 16 + (lane >> 2)] = q1;
    }
    __syncthreads();
}

DI void conv_rows(const Args& a) {
    const int lane = tidx() & 63, wid = tidx() >> 6;
    const bf16_t* P = (const bf16_t*)(a.ws + OFF_BIG);
    bf16_t* QN = (bf16_t*)(a.ws + OFF_QN); bf16_t* KN = (bf16_t*)(a.ws + OFF_KN); bf16_t* VN = (bf16_t*)(a.ws + OFF_VN);
    float w0[3][8], w1[3][8], w2[3][8];
#pragma unroll
    for (int part = 0; part < 3; ++part)
#pragma unroll
        for (int e = 0; e < 8; ++e) { const int ch = part * 512 + lane * 8 + e; w0[part][e] = a.gdn_conv_w[ch]; w1[part][e] = a.gdn_conv_w[1536 + ch]; w2[part][e] = a.gdn_conv_w[3072 + ch]; }
    const u32x4 zero4 = {0u, 0u, 0u, 0u};
    for (int blk = blockIdx.x * 8 + wid; blk < MROWS / 16; blk += gridDim.x * 8) {
        const int r0 = blk * 16;
        int t0, len; if (r0 < NLAT) { t0 = r0 & (SEQL - 1); len = SEQL; } else { t0 = (r0 - NLAT) & (CTXL - 1); len = CTXL; }
        u32x4 xp[3], xc[3], xn[3], xnn[3];
#pragma unroll
        for (int part = 0; part < 3; ++part) { const bf16_t* p = P + (size_t)r0 * PG_LD + part * 512 + lane * 8;
            xc[part] = *(const u32x4*)p; xp[part] = t0 > 0 ? *(const u32x4*)(p - PG_LD) : zero4; xn[part] = t0 + 1 < len ? *(const u32x4*)(p + PG_LD) : zero4; }
        for (int i = 0; i < 16; ++i) {
            const int row = r0 + i, t = t0 + i;
#pragma unroll
            for (int part = 0; part < 3; ++part) xnn[part] = (i < 15 && t + 2 < len) ? *(const u32x4*)(P + (size_t)(row + 2) * PG_LD + part * 512 + lane * 8) : zero4;
#pragma unroll
            for (int part = 0; part < 3; ++part) {
                float fc[8], fp[8], fn[8]; unpack8(xc[part], fc); unpack8(xp[part], fp); unpack8(xn[part], fn);
                float y[8]; float ss = 0.f;
#pragma unroll
                for (int e = 0; e < 8; ++e) { const float cv = w0[part][e] * fp[e] + w1[part][e] * fc[e] + w2[part][e] * fn[e]; y[e] = siluf(cv); ss += y[e] * y[e]; }
                if (part < 2) {
                    ss += __shfl_xor(ss, 1); ss += __shfl_xor(ss, 2); ss += __shfl_xor(ss, 4); ss += __shfl_xor(ss, 8);
                    const float r = rsqrtf(ss + EPS) * (part == 0 ? 0.08838834764831845f : 1.f);
#pragma unroll
                    for (int e = 0; e < 8; ++e) y[e] *= r;
                }
                bf16_t* dst = (part == 0 ? QN : part == 1 ? KN : VN) + (size_t)row * 512 + lane * 8;
                *(u32x4*)dst = pack8(y);
            }
#pragma unroll
            for (int part = 0; part < 3; ++part) { xp[part] = xc[part]; xc[part] = xn[part]; xn[part] = xnn[part]; }
        }
    }
}

constexpr int AT_QS = 0, AT_KS = 36864, AT_VT = AT_KS + 320 * 144, AT_VT_STRIDE = 656, AT_ROPE = AT_VT + 64 * 656;
static_assert(AT_ROPE + 32768 <= LDS_BYTES, "attention LDS map");
constexpr int N_ATT_UNITS = 1024;
DI int vt_pos(int i) { return (i & ~31) + ((i >> 2) & 3) * 8 + ((i >> 4) & 1) * 4 + (i & 3); }
DI void attn_load_kv(const Args& a, char* smem, const bf16_t* P, long grow0, int tpos0, int tlen, int nrows, int kvh, bool rope) {
    const int tid = tidx();
    const float2* R = (const float2*)(smem + AT_ROPE);
    u32x4 ka[3], kb[3], vv[5];
#pragma unroll
    for (int it = 0; it < 3; ++it) { const int idx = tid + it * 512, i = idx >> 2, q = idx & 3, t = tpos0 + i; const bool ok = idx < nrows * 4 && t >= 0 && t < tlen;
        ka[it] = (u32x4){0u, 0u, 0u, 0u}; kb[it] = (u32x4){0u, 0u, 0u, 0u};
        if (ok) { const bf16_t* p = P + (grow0 + i) * ATT_LD + 512 + kvh * 64 + q * 8; ka[it] = *(const u32x4*)p; kb[it] = *(const u32x4*)(p + 32); } }
#pragma unroll
    for (int it = 0; it < 5; ++it) { const int idx = tid + it * 512, q = idx / nrows, i = idx - q * nrows, t = tpos0 + i; const bool ok = idx < nrows * 8 && t >= 0 && t < tlen;
        vv[it] = (u32x4){0u, 0u, 0u, 0u};
        if (ok) vv[it] = *(const u32x4*)(P + (grow0 + i) * ATT_LD + 640 + kvh * 64 + q * 8); }
#pragma unroll
    for (int it = 0; it < 3; ++it) { const int idx = tid + it * 512, i = idx >> 2, q = idx & 3, t = tpos0 + i;
        if (idx < nrows * 4) {
            float x1[8], x2[8]; unpack8(ka[it], x1); unpack8(kb[it], x2);
            if (rope && t >= 0 && t < tlen) { const int pp = (q < 2) ? (t >> 6) : (t & 63); const float2* rp = R + pp * 16 + (q & 1) * 8;
#pragma unroll
                for (int e = 0; e < 8; ++e) { const float2 cs = rp[e]; const float o1 = x1[e] * cs.x - x2[e] * cs.y, o2 = x2[e] * cs.x + x1[e] * cs.y; x1[e] = o1; x2[e] = o2; } }
            *(u32x4*)(smem + AT_KS + i * 144 + q * 16) = pack8(x1);
            *(u32x4*)(smem + AT_KS + i * 144 + 64 + q * 16) = pack8(x2); } }
#pragma unroll
    for (int it = 0; it < 5; ++it) { const int idx = tid + it * 512, q = idx / nrows, i = idx - q * nrows;
        if (idx < nrows * 8) { const u32x4 v = vv[it];
            bf16_t* vt = (bf16_t*)(smem + AT_VT) + vt_pos(i); const int d0 = q * 8;
            vt[(d0 + 0) * 328] = (bf16_t)(v.x & 0xffff); vt[(d0 + 1) * 328] = (bf16_t)(v.x >> 16);
            vt[(d0 + 2) * 328] = (bf16_t)(v.y & 0xffff); vt[(d0 + 3) * 328] = (bf16_t)(v.y >> 16);
            vt[(d0 + 4) * 328] = (bf16_t)(v.z & 0xffff); vt[(d0 + 5) * 328] = (bf16_t)(v.z >> 16);
            vt[(d0 + 6) * 328] = (bf16_t)(v.w & 0xffff); vt[(d0 + 7) * 328] = (bf16_t)(v.w >> 16); } }
}
DI void attn_unit(const Args& a, char* smem, int u) {
    const int b = u >> 9, kvh = (u >> 8) & 1, qb = u & 255, q0 = qb * 64;
    const int tid = tidx(), lane = tid & 63, wid = tid >> 6, fr = lane & 15, fq = lane >> 4;
    const bf16_t* P = (const bf16_t*)((const unsigned char*)a.out + OUT_ATT);
    const float2* R = (const float2*)(smem + AT_ROPE);
    bf16_t* MIX = (bf16_t*)(a.ws + OFF_H);
    constexpr float QSCALE = 0.125f * 1.4426950408889634f;
#pragma unroll
    for (int it = 0; it < 2; ++it) { const int idx = tid + it * 512, hr = idx >> 2, q = idx & 3, g = hr >> 6, r = hr & 63; const int t = q0 + r;
      const bf16_t* p = P + ((size_t)b * SEQL + t) * ATT_LD + (kvh * 4 + g) * 64 + q * 8; float x1[8], x2[8];
      unpack8(*(const u32x4*)p, x1); unpack8(*(const u32x4*)(p + 32), x2);
      const int pp = (q < 2) ? (t >> 6) : (t & 63); const float2* rp = R + pp * 16 + (q & 1) * 8;
#pragma unroll
      for (int e = 0; e < 8; ++e) { const float2 cs = rp[e]; const float o1 = (x1[e] * cs.x - x2[e] * cs.y) * QSCALE, o2 = (x2[e] * cs.x + x1[e] * cs.y) * QSCALE; x1[e] = o1; x2[e] = o2; }
      *(u32x4*)(smem + AT_QS + hr * 144 + q * 16) = pack8(x1); *(u32x4*)(smem + AT_QS + hr * 144 + 64 + q * 16) = pack8(x2); }
    const int g = wid >> 1, qs = wid & 1, hq = kvh * 4 + g;
    const int qi0 = q0 + qs * 32 + fr;
    float m_run[2], l_run[2];
    m_run[0] = m_run[1] = a.attn_sink[hq] * 1.4426950408889634f; l_run[0] = l_run[1] = (fq == 0) ? 1.f : 0.f;
    f32x4 O[2][4];
#pragma unroll
    for (int j = 0; j < 2; ++j)
#pragma unroll
        for (int dt = 0; dt < 4; ++dt) O[j][dt] = (f32x4){0.f, 0.f, 0.f, 0.f};
    bf16x8 Qf[2][2];
#pragma unroll
    for (int pass = 0; pass < 2; ++pass) {
        if (pass == 0) attn_load_kv(a, smem, P, (long)b * SEQL + q0 - 128, q0 - 128, SEQL, 320, kvh, true);
        else attn_load_kv(a, smem, P, (long)NLAT + b * CTXL, 0, CTXL, 256, kvh, false);
        __syncthreads();
        if (pass == 0) {
#pragma unroll
            for (int j = 0; j < 2; ++j) { const char* qp = smem + AT_QS + (g * 64 + qs * 32 + j * 16 + fr) * 144 + fq * 16; Qf[j][0] = ldf16(qp); Qf[j][1] = ldf16(qp + 64); } }
        const int ngrp = pass == 0 ? 5 : 4;
#pragma unroll 1
        for (int kk = 0; kk < ngrp; ++kk) {
            f32x4 sc[2][4];
            { const char* kp = smem + AT_KS + (kk * 64 + fr) * 144 + fq * 16;
#pragma unroll
              for (int kt = 0; kt < 4; ++kt) { const bf16x8 k0 = ldf16(kp + kt * 16 * 144), k1 = ldf16(kp + kt * 16 * 144 + 64);
#pragma unroll
                  for (int j = 0; j < 2; ++j) { f32x4 z = {0.f, 0.f, 0.f, 0.f}; z = mfma16(k0, Qf[j][0], z); sc[j][kt] = mfma16(k1, Qf[j][1], z); } } }
            const int kbase = q0 - 128 + kk * 64;
            const bool need_mask = pass == 0 && (kk == 0 || kk == 4 || kbase < 0 || kbase + 64 > SEQL);
            if (need_mask) {
#pragma unroll
                for (int j = 0; j < 2; ++j) { const int qi = qi0 + j * 16;
#pragma unroll
                    for (int kt = 0; kt < 4; ++kt)
#pragma unroll
                        for (int r = 0; r < 4; ++r) { const int k = kbase + kt * 16 + fq * 4 + r; const bool v = k >= 0 && k < SEQL && (qi - k) <= 128 && (k - qi) <= 128; sc[j][kt][r] = v ? sc[j][kt][r] : -1e30f; } }
            }
            bf16x8 Pb[2][2];
#pragma unroll
            for (int j = 0; j < 2; ++j) {
                float mx = m_run[j];
#pragma unroll
                for (int kt = 0; kt < 4; ++kt) mx = fmaxf(fmaxf(mx, fmaxf(sc[j][kt][0], sc[j][kt][1])), fmaxf(sc[j][kt][2], sc[j][kt][3]));
                mx = fmaxf(mx, __shfl_xor(mx, 16)); mx = fmaxf(mx, __shfl_xor(mx, 32));
                const float alpha = __builtin_amdgcn_exp2f(m_run[j] - mx); m_run[j] = mx;
                float ps = 0.f;
#pragma unroll
                for (int kt = 0; kt < 4; ++kt)
#pragma unroll
                    for (int r = 0; r < 4; ++r) { const float pv = __builtin_amdgcn_exp2f(sc[j][kt][r] - mx); sc[j][kt][r] = pv; ps += pv; }
                l_run[j] = l_run[j] * alpha + ps;
                Pb[j][0] = pack2(sc[j][0], sc[j][1]); Pb[j][1] = pack2(sc[j][2], sc[j][3]);
#pragma unroll
                for (int dt = 0; dt < 4; ++dt) O[j][dt] = O[j][dt] * alpha;
            }
            { const char* vp = smem + AT_VT + fr * AT_VT_STRIDE + (kk * 64 + fq * 8) * 2;
#pragma unroll
              for (int dt = 0; dt < 4; ++dt)
#pragma unroll
                  for (int kp = 0; kp < 2; ++kp) { const bf16x8 vf = ldf16(vp + dt * 16 * AT_VT_STRIDE + kp * 64);
                      O[0][dt] = mfma16(vf, Pb[0][kp], O[0][dt]); O[1][dt] = mfma16(vf, Pb[1][kp], O[1][dt]); } }
        }
        __syncthreads();
    }
#pragma unroll
    for (int j = 0; j < 2; ++j) {
        float l = l_run[j]; l += __shfl_xor(l, 16); l += __shfl_xor(l, 32);
        const float inv = 1.f / l;
        bf16_t* op = MIX + ((size_t)b * SEQL + qi0 + j * 16) * DM + hq * 64 + fq * 4;
#pragma unroll
        for (int dt = 0; dt < 4; ++dt) { u32x2 w; w.x = pk2(O[j][dt][0] * inv, O[j][dt][1] * inv); w.y = pk2(O[j][dt][2] * inv, O[j][dt][3] * inv); *(u32x2*)(op + dt * 16) = w; }
    }
}
DI void phase3a(const Args& a, char* smem) { conv_rows(a); }

constexpr int PR_Q = 0, PR_K = 17408, PR_KT = 34816, PR_KB = 53248, PR_VT = 71680, PR_AS = 90112, PR_TS = 107520, PR_TB = 124928, PR_GC = 134144, PR_BETA = 134400;
DI float softplusf(float x) { return fmaxf(x, 0.f) + log1pf(expf(-fabsf(x))); }
struct PrepIn { u32x4 x[2][3], ed[2][3]; float av[2], bv[2]; };
constexpr int PR_CW = 134656;
DI void prep_load(const Args& a, int p, PrepIn& in) {
    const int h = p & 3, cidx = p >> 2, base = cidx * 64;
    const int tid = tidx(), lane = tid & 63;
    const bf16_t* PG = (const bf16_t*)(a.ws + OFF_PG);
    const float* AB = (const float*)(a.ws + OFF_AB);
    int t0, len; if (base < NLAT) { t0 = base & (SEQL - 1); len = SEQL; } else { t0 = (base - NLAT) & (CTXL - 1); len = CTXL; }
    const u32x4 zero4 = {0u, 0u, 0u, 0u};
    const bool ev = (lane == 0 && t0 > 0) || (lane == 63 && t0 + 64 < len);
    const int etok = lane == 0 ? base - 1 : base + 64;
#pragma unroll
    for (int it = 0; it < 2; ++it) { const int q = (tid >> 6) + it * 8; const int tok = base + lane;
#pragma unroll
        for (int part = 0; part < 3; ++part) { const int col = part * 512 + h * 128 + q * 8;
            in.x[it][part] = *(const u32x4*)(PG + (size_t)tok * PG_LD + col);
            in.ed[it][part] = ev ? *(const u32x4*)(PG + (size_t)etok * PG_LD + col) : zero4; } }
#pragma unroll
    for (int d = 0; d < 2; ++d) { const int tok = d ? base + 63 - lane : base + lane; in.av[d] = AB[(size_t)tok * 16 + d * 4 + h]; in.bv[d] = AB[(size_t)tok * 16 + 8 + d * 4 + h]; }
}
DI u32x4 shfl4_up(u32x4 v) { u32x4 r; r.x = __shfl_up(v.x, 1); r.y = __shfl_up(v.y, 1); r.z = __shfl_up(v.z, 1); r.w = __shfl_up(v.w, 1); return r; }
DI u32x4 shfl4_dn(u32x4 v) { u32x4 r; r.x = __shfl_down(v.x, 1); r.y = __shfl_down(v.y, 1); r.z = __shfl_down(v.z, 1); r.w = __shfl_down(v.w, 1); return r; }
#define LDS_BARRIER() do { asm volatile("s_waitcnt lgkmcnt(0)" ::: "memory"); __builtin_amdgcn_s_barrier(); asm volatile("" ::: "memory"); } while (0)
DI void prep_pair(const Args& a, char* smem, int p, int dmask, const PrepIn& in) {
    const int h = p & 3, cidx = p >> 2;
    const int tid = tidx(), lane = tid & 63, wid = tid >> 6, fr = lane & 15, fq = lane >> 4;
    float* gc = (float*)(smem + PR_GC); float* beta = (float*)(smem + PR_BETA);
    const float* CW = (const float*)(smem + PR_CW); float* SSP = (float*)(smem + PR_AS);
    u32x4 qvv[2], kvv[2], vvv[2];
    { float yv[2][3][8];
#pragma unroll
      for (int it = 0; it < 2; ++it) { const int idx = tid + it * 512, rr = idx & 63, q = idx >> 6;
#pragma unroll
        for (int part = 0; part < 3; ++part) { float fc[8], fp[8], fn[8];
            const u32x4 xc = in.x[it][part], up = shfl4_up(xc), dn = shfl4_dn(xc), ed = in.ed[it][part];
            unpack8(xc, fc); unpack8(lane == 0 ? ed : up, fp); unpack8(lane == 63 ? ed : dn, fn);
            const float* cw = CW + part * 512 + h * 128 + q * 8; float ss = 0.f;
#pragma unroll
            for (int e = 0; e < 8; ++e) { const float cv = cw[e] * fp[e] + cw[1536 + e] * fc[e] + cw[3072 + e] * fn[e]; const float y = siluf(cv); yv[it][part][e] = y; ss += y * y; }
            if (part < 2) SSP[(part * 64 + rr) * 16 + q] = ss; } }
      LDS_BARRIER();
#pragma unroll
      for (int it = 0; it < 2; ++it) { const int rr = lane;
        float sq = 0.f, sk = 0.f;
#pragma unroll
        for (int j = 0; j < 16; ++j) { sq += SSP[rr * 16 + j]; sk += SSP[(64 + rr) * 16 + j]; }
        const float rq = rsqrtf(sq + EPS) * 0.08838834764831845f, rk = rsqrtf(sk + EPS);
#pragma unroll
        for (int e = 0; e < 8; ++e) { yv[it][0][e] *= rq; yv[it][1][e] *= rk; }
        qvv[it] = pack8(yv[it][0]); kvv[it] = pack8(yv[it][1]); vvv[it] = pack8(yv[it][2]); }
      LDS_BARRIER();
    }
#pragma unroll 1
  for (int dir = 0; dir < 2; ++dir) {
    if (!((dmask >> dir) & 1)) continue;
    int slot_;
    { int bb, st; if (cidx < 512) { bb = cidx >> 8; const int n = cidx & 255; st = 4 + (dir ? 255 - n : n); } else { bb = (cidx - 512) >> 2; const int n = (cidx - 512) & 3; st = dir ? 3 - n : n; }
      slot_ = ((bb * 4 + h) * 2 + dir) * 260 + st; }
    const int slot = slot_;
    unsigned char* rec = rec_ptr(a, slot);
    if (wid == 0) {
        const float av = dir ? in.av[1] : in.av[0], bv = dir ? in.bv[1] : in.bv[0];
        float gv = -expf(a.gdn_a_log[dir * 4 + h]) * softplusf(av + a.gdn_dt_bias[dir * 4 + h]);
#pragma unroll
        for (int o = 1; o < 64; o <<= 1) { const float t = __shfl_up(gv, o); if (lane >= o) gv += t; }
        gc[lane] = gv; beta[lane] = 1.f / (1.f + expf(-bv));
        if (lane == 63) ((float*)(a.ws + OFF_EGL))[slot] = expf(gv);
    }
    LDS_BARRIER();
#pragma unroll
    for (int it = 0; it < 2; ++it) {
        const int idx = tid + it * 512, q = idx >> 6, rr = dir ? 63 - lane : lane;
        const u32x4 qv = qvv[it], kv = kvv[it], vv = vvv[it];
        *(u32x4*)(smem + PR_Q + rr * 272 + q * 16) = qv; *(u32x4*)(smem + PR_K + rr * 272 + q * 16) = kv;
        float kf[8], vf[8]; unpack8(kv, kf); unpack8(vv, vf);
        const float bt = beta[rr], be = bt * __expf(gc[rr]);
        bf16_t* kt = (bf16_t*)(smem + PR_KT) + (q * 8) * 72 + rr; bf16_t* kb = (bf16_t*)(smem + PR_KB) + (q * 8) * 72 + rr; bf16_t* vt = (bf16_t*)(smem + PR_VT) + (q * 8) * 72 + rr;
#pragma unroll
        for (int e = 0; e < 8; ++e) { kt[e * 72] = (bf16_t)f2bf(kf[e]); kb[e * 72] = (bf16_t)f2bf(kf[e] * be); vt[e * 72] = (bf16_t)f2bf(vf[e] * bt); }
    }
    LDS_BARRIER();
    float* As = (float*)(smem + PR_AS); float* Ts = (float*)(smem + PR_TS);
#pragma unroll
    for (int tt = 0; tt < 2; ++tt) {
        const int t = wid * 2 + tt, mt = t >> 2, nt = t & 3;
        f32x4 kk = {0.f, 0.f, 0.f, 0.f}, qk = {0.f, 0.f, 0.f, 0.f};
#pragma unroll
        for (int ks = 0; ks < 4; ++ks) {
            const bf16x8 am = ldf16(smem + PR_K + (mt * 16 + fr) * 272 + ks * 64 + fq * 16);
            const bf16x8 bk = ldf16(smem + PR_K + (nt * 16 + fr) * 272 + ks * 64 + fq * 16);
            const bf16x8 bq = ldf16(smem + PR_Q + (nt * 16 + fr) * 272 + ks * 64 + fq * 16);
            kk = mfma16(am, bk, kk); qk = mfma16(am, bq, qk);
        }
        const int i = nt * 16 + fr; const float gi = gc[i], bi = beta[i];
        f32x4 av; u32x2 qw; float qv[4];
#pragma unroll
        for (int j4 = 0; j4 < 4; ++j4) { const int j = mt * 16 + fq * 4 + j4; const float dg = gi - gc[j];
            const float edg = __expf(dg); av[j4] = (i > j) ? bi * kk[j4] * edg : 0.f; qv[j4] = (i >= j) ? qk[j4] * edg : 0.f; }
        *(f32x4*)(As + i * 68 + mt * 16 + fq * 4) = av;
        qw.x = pk2(qv[0], qv[1]); qw.y = pk2(qv[2], qv[3]);
        *(u32x2*)(rec + REC_QK + (i * 64 + (mt >> 1) * 32 + fq * 8 + (mt & 1) * 4) * 2) = qw;
    }
    LDS_BARRIER();
    if (wid == 0) {
        const int bI = lane >> 4, c = lane & 15; float x[16];
#pragma unroll
        for (int i = 0; i < 16; ++i) { float sacc = (i == c) ? 1.f : 0.f; const float* ar = As + (bI * 16 + i) * 68 + bI * 16;
#pragma unroll
            for (int j = 0; j < i; ++j) sacc -= ar[j] * x[j];
            x[i] = sacc; }
#pragma unroll
        for (int i = 0; i < 16; ++i) Ts[(bI * 16 + i) * 68 + bI * 16 + c] = x[i];
    }
    LDS_BARRIER();
    { float* scr = (float*)(smem + PR_TB) + wid * 16 * 17;
#pragma unroll
      for (int bI = 1; bI < 4; ++bI) {
          if (wid < bI) { const int bJ = wid; f32x4 racc = {0.f, 0.f, 0.f, 0.f};
              for (int bK = bJ; bK < bI; ++bK) {
#pragma unroll
                  for (int kk = 0; kk < 4; ++kk) { const float av = As[(bI * 16 + fr) * 68 + bK * 16 + kk * 4 + fq], bv = Ts[(bK * 16 + kk * 4 + fq) * 68 + bJ * 16 + fr];
                      racc = __builtin_amdgcn_mfma_f32_16x16x4f32(av, bv, racc, 0, 0, 0); } }
#pragma unroll
              for (int j = 0; j < 4; ++j) scr[(fq * 4 + j) * 17 + fr] = racc[j];
              asm volatile("s_waitcnt lgkmcnt(0)" ::: "memory"); __builtin_amdgcn_wave_barrier();
              f32x4 tacc = {0.f, 0.f, 0.f, 0.f};
#pragma unroll
              for (int kk = 0; kk < 4; ++kk) { const float av = Ts[(bI * 16 + fr) * 68 + bI * 16 + kk * 4 + fq], bv = scr[(kk * 4 + fq) * 17 + fr];
                  tacc = __builtin_amdgcn_mfma_f32_16x16x4f32(av, bv, tacc, 0, 0, 0); }
#pragma unroll
              for (int j = 0; j < 4; ++j) Ts[(bI * 16 + fq * 4 + j) * 68 + bJ * 16 + fr] = -tacc[j];
          }
          LDS_BARRIER();
      } }
    for (int idx = tid; idx < 2048; idx += 512) { const int i = idx >> 5, j2 = (idx & 31) * 2; const bool up = (j2 >> 4) > (i >> 4);
        *(unsigned*)(smem + PR_TB + i * 144 + j2 * 2) = up ? 0u : pk2(Ts[i * 68 + j2], Ts[i * 68 + j2 + 1]); }
    LDS_BARRIER();
#pragma unroll
    for (int tt = 0; tt < 4; ++tt) {
        const int t = wid * 4 + tt;
        { const int ct = t & 3, et = t >> 2; f32x4 acc = {0.f, 0.f, 0.f, 0.f};
#pragma unroll
          for (int ks = 0; ks < 2; ++ks) acc = mfma16(ldf16(smem + PR_TB + (ct * 16 + fr) * 144 + ks * 64 + fq * 16), ldf16(smem + PR_VT + (et * 16 + fr) * 144 + ks * 64 + fq * 16), acc);
          u32x2 w; w.x = pk2(acc[0], acc[1]); w.y = pk2(acc[2], acc[3]);
          *(u32x2*)(rec + REC_UT + ((et * 16 + fr) * 64 + ct * 16 + fq * 4) * 2) = w; }
        { const int ct = t & 3, dt = t >> 2; f32x4 acc = {0.f, 0.f, 0.f, 0.f};
#pragma unroll
          for (int ks = 0; ks < 2; ++ks) acc = mfma16(ldf16(smem + PR_KB + (dt * 16 + fr) * 144 + ks * 64 + fq * 16), ldf16(smem + PR_TB + (ct * 16 + fr) * 144 + ks * 64 + fq * 16), acc);
          u32x2 w; w.x = pk2(acc[0], acc[1]); w.y = pk2(acc[2], acc[3]);
          *(u32x2*)(rec + REC_W + ((ct * 16 + fr) * 128 + (dt >> 1) * 32 + fq * 8 + (dt & 1) * 4) * 2) = w; }
    }
    const float glast = gc[63];
    for (int idx = tid; idx < 1024; idx += 512) {
        { const int rr = idx >> 4, q = idx & 15; float f[8]; unpack8(*(const u32x4*)(smem + PR_Q + rr * 272 + q * 16), f); const float e = __expf(gc[rr]);
#pragma unroll
          for (int j = 0; j < 8; ++j) f[j] *= e;
          const int p0 = (q >> 2) * 32 + ((q >> 1) & 1) * 4; u32x2 w0, w1; w0.x = pk2(f[0], f[1]); w0.y = pk2(f[2], f[3]); w1.x = pk2(f[4], f[5]); w1.y = pk2(f[6], f[7]);
          *(u32x2*)(rec + REC_QG + (rr * 128 + p0 + ((2 * q) & 3) * 8) * 2) = w0; *(u32x2*)(rec + REC_QG + (rr * 128 + p0 + ((2 * q + 1) & 3) * 8) * 2) = w1; }
        { const int d = idx >> 3, q = idx & 7; float f[8]; unpack8(*(const u32x4*)(smem + PR_KT + d * 144 + q * 16), f);
#pragma unroll
          for (int j = 0; j < 8; ++j) f[j] *= __expf(glast - gc[q * 8 + j]);
          const int p0 = (q >> 2) * 32 + ((q >> 1) & 1) * 4; u32x2 w0, w1; w0.x = pk2(f[0], f[1]); w0.y = pk2(f[2], f[3]); w1.x = pk2(f[4], f[5]); w1.y = pk2(f[6], f[7]);
          *(u32x2*)(rec + REC_KTT + (d * 64 + p0 + ((2 * q) & 3) * 8) * 2) = w0; *(u32x2*)(rec + REC_KTT + (d * 64 + p0 + ((2 * q + 1) & 3) * 8) * 2) = w1; }
    }
    LDS_BARRIER();
  }
}
DI bool prep_item(int i, int G, int b, int& p, int& dmask) {
    constexpr int NPAIR = NREC / 2; const int nmain = NPAIR / G;
    if (i < nmain) { p = i * G + b; dmask = 3; return true; }
    const int u = (i - nmain) * G + b, left = NPAIR - nmain * G;
    if (u < 2 * left) { p = nmain * G + (u >> 1); dmask = 1 << (u & 1); return true; }
    return false;
}
DI void phase3b(const Args& a, char* smem) {
    const int G = (int)gridDim.x, b = (int)blockIdx.x;
    { float* CWs = (float*)(smem + PR_CW); for (int i = tidx(); i < 4608; i += 512) CWs[i] = a.gdn_conv_w[i]; }
    __syncthreads();
    PrepIn cur, nxt; int p, dm, pn, dmn;
    bool have = prep_item(0, G, b, p, dm);
    if (have) prep_load(a, p, cur);
    for (int i = 0; have; ++i) {
        const bool hn = prep_item(i + 1, G, b, pn, dmn);
        if (hn) prep_load(a, pn, nxt);
        prep_pair(a, smem, p, dm, cur);
        cur = nxt; p = pn; dm = dmn; have = hn;
    }
}

constexpr int SC_W = 0, SC_QG = 18432, SC_KTT = 36864, SC_QK = 57344, SC_UT = 67584, SC_EGL = 70144, SC_BUF = 70160, SC_NP = 3712, SC_OST = 2 * 70160;
DI int scan_rec(int b, int h, int dir, int step) { return ((b * 4 + h) * 2 + dir) * 260 + step; }
#define SC_BARRIER() do { asm volatile("s_waitcnt lgkmcnt(0)" ::: "memory"); __builtin_amdgcn_s_barrier(); asm volatile("" ::: "memory"); } while (0)
DI void scan_unit(const Args& a, char* smem, int u) {
    const int sl = u & 7, chain = u >> 3, dir = chain & 1, h = (chain >> 1) & 3, b = chain >> 3, e0 = sl * 16;
    const int tid = tidx(), lane = tid & 63, wid = __builtin_amdgcn_readfirstlane(tid >> 6), fr = lane & 15, fq = lane >> 4;
    const float* EGL = (const float*)(a.ws + OFF_EGL);
    bf16_t* Ob = (bf16_t*)(a.ws + OFF_O) + (size_t)dir * NLAT * 512;
    constexpr int NSTEP = 260;
    if (wid == 0) {
        f32x4 S[8];
#pragma unroll
        for (int i = 0; i < 8; ++i) S[i] = (f32x4){0.f, 0.f, 0.f, 0.f};
        for (int step = -1; step <= NSTEP; ++step) {
            if (step >= 0 && step < NSTEP) {
                const char* buf = smem + (step & 1) * SC_BUF;
                const float egl = *(const float*)(buf + SC_EGL);
                if (sl == 0 && lane == 0) __hip_atomic_store((unsigned*)(a.ws + OFF_PROG) + chain * 16, (unsigned)step, __ATOMIC_RELAXED, __HIP_MEMORY_SCOPE_AGENT);
                const char* pw = buf + SC_W + fr * 288 + fq * 16; const char* pq = buf + SC_QG + fr * 288 + fq * 16;
                const char* pk = buf + SC_QK + fr * 160 + fq * 16; const char* pt = buf + SC_KTT + fr * 160 + fq * 16;
                bf16x8 fa[8], fb[8];
#define LD_WQ(F, ct) do { _Pragma("unroll") for (int kk = 0; kk < 4; ++kk) { F[kk] = ldf16(pw + (ct) * 16 * 288 + kk * 64); F[4 + kk] = ldf16(pq + (ct) * 16 * 288 + kk * 64); } } while (0)
#define LD_QK(F) do { _Pragma("unroll") for (int ct = 0; ct < 4; ++ct) { F[2 * ct] = ldf16(pk + ct * 16 * 160); F[2 * ct + 1] = ldf16(pk + ct * 16 * 160 + 64); } } while (0)
#define LD_KT(F, d0) do { _Pragma("unroll") for (int dd = 0; dd < 4; ++dd) { F[2 * dd] = ldf16(pt + ((d0) + dd) * 16 * 160); F[2 * dd + 1] = ldf16(pt + ((d0) + dd) * 16 * 160 + 64); } } while (0)
#define MM_WQ(F, ct) do { f32x4 acc = {0.f, 0.f, 0.f, 0.f}, accq = {0.f, 0.f, 0.f, 0.f}; \
        _Pragma("unroll") for (int kk = 0; kk < 4; ++kk) { acc = mfma16(F[kk], Sb[kk], acc); accq = mfma16(F[4 + kk], Sb[kk], accq); } \
        vn[ct][0] = bflo(uu[ct].x) - acc[0]; vn[ct][1] = bfhi(uu[ct].x) - acc[1]; vn[ct][2] = bflo(uu[ct].y) - acc[2]; vn[ct][3] = bfhi(uu[ct].y) - acc[3]; oo[ct] = accq; } while (0)
                LD_WQ(fa, 0);
                u32x2 uu[4];
#pragma unroll
                for (int ct = 0; ct < 4; ++ct) uu[ct] = *(const u32x2*)(buf + SC_UT + fr * 160 + (ct * 16 + fq * 4) * 2);
                bf16x8 Sb[4];
#pragma unroll
                for (int kk = 0; kk < 4; ++kk) Sb[kk] = pack2(S[2 * kk], S[2 * kk + 1]);
                f32x4 vn[4], oo[4];
                LD_WQ(fb, 1); __builtin_amdgcn_sched_barrier(0);
                MM_WQ(fa, 0); __builtin_amdgcn_sched_barrier(0);
                LD_WQ(fa, 2); __builtin_amdgcn_sched_barrier(0);
                MM_WQ(fb, 1); __builtin_amdgcn_sched_barrier(0);
                LD_WQ(fb, 3); __builtin_amdgcn_sched_barrier(0);
                MM_WQ(fa, 2); __builtin_amdgcn_sched_barrier(0);
                LD_QK(fa); __builtin_amdgcn_sched_barrier(0);
                MM_WQ(fb, 3); __builtin_amdgcn_sched_barrier(0);
                LD_KT(fb, 0); __builtin_amdgcn_sched_barrier(0);
                bf16x8 Vb[2]; Vb[0] = pack2(vn[0], vn[1]); Vb[1] = pack2(vn[2], vn[3]);
#pragma unroll
                for (int ct = 0; ct < 4; ++ct) { oo[ct] = mfma16(fa[2 * ct], Vb[0], oo[ct]); oo[ct] = mfma16(fa[2 * ct + 1], Vb[1], oo[ct]); }
                __builtin_amdgcn_sched_barrier(0);
                LD_KT(fa, 4); __builtin_amdgcn_sched_barrier(0);
#pragma unroll
                for (int dd = 0; dd < 4; ++dd) { S[dd] = S[dd] * egl; S[dd] = mfma16(fb[2 * dd], Vb[0], S[dd]); S[dd] = mfma16(fb[2 * dd + 1], Vb[1], S[dd]); }
                __builtin_amdgcn_sched_barrier(0);
#pragma unroll
                for (int dd = 0; dd < 4; ++dd) { S[4 + dd] = S[4 + dd] * egl; S[4 + dd] = mfma16(fa[2 * dd], Vb[0], S[4 + dd]); S[4 + dd] = mfma16(fa[2 * dd + 1], Vb[1], S[4 + dd]); }
#undef LD_WQ
#undef LD_QK
#undef LD_KT
#undef MM_WQ
                if (step >= 4) { bf16_t* ost = (bf16_t*)(smem + SC_OST + (step & 1) * 2048);
#pragma unroll
                    for (int ct = 0; ct < 4; ++ct) { const unsigned w0 = pk2(oo[ct][0], oo[ct][1]), w1 = pk2(oo[ct][2], oo[ct][3]); const int c0 = ct * 16 + fq * 4;
                        ost[(c0 + 0) * 16 + fr] = (bf16_t)(w0 & 0xffff); ost[(c0 + 1) * 16 + fr] = (bf16_t)(w0 >> 16); ost[(c0 + 2) * 16 + fr] = (bf16_t)(w1 & 0xffff); ost[(c0 + 3) * 16 + fr] = (bf16_t)(w1 >> 16); }
                }
            }
            SC_BARRIER();
        }
    } else {
        u32x4 tA[9], tB[9], tC[9]; float eA = 0.f, eB = 0.f, eC = 0.f;
#define SC_LOAD(T, E, st) do { const int rn_ = scan_rec(b, h, dir, (st)); const unsigned char* rec_ = rec_ptr(a, rn_); \
        _Pragma("unroll") for (int it = 0; it < 9; ++it) { const int p = tid - 64 + it * 448; \
            if (p < SC_NP) { const unsigned char* src = p < 3584 ? rec_ + p * 16 : rec_ + REC_UT + e0 * 128 + (p - 3584) * 16; T[it] = *(const u32x4*)src; } } \
        if (tid == 64) E = EGL[rn_]; } while (0)
#define SC_WRITE(T, E, st) do { char* buf_ = smem + ((st) & 1) * SC_BUF; if (tid == 64) *(float*)(buf_ + SC_EGL) = E; \
        _Pragma("unroll") for (int it = 0; it < 9; ++it) { const int p = tid - 64 + it * 448; \
            if (p < SC_NP) { int off; \
                if (p < 2048) off = (p >> 10) * 18432 + ((p & 1023) >> 4) * 288 + (p & 15) * 16; \
                else if (p < 3584) { const int q = p - 2048; off = SC_KTT + (q >> 3) * 160 + (q & 7) * 16; } \
                else { const int q = p - 3584; off = SC_UT + (q >> 3) * 160 + (q & 7) * 16; } \
                *(u32x4*)(buf_ + off) = T[it]; } } } while (0)
#define SC_ITER(T, E, st) do { if ((st) <= NSTEP) { \
        if ((st) + 1 < NSTEP) SC_WRITE(T, E, (st) + 1); \
        if ((st) - 1 >= 4 && (st) - 1 < NSTEP && tid < 192) { const int ps = (st) - 1, n = ps - 4, chunk = dir ? 255 - n : n; const int q = tid - 64, c = q >> 1, hf = q & 1; \
            const size_t tok = (size_t)b * SEQL + chunk * 64 + (dir ? 63 - c : c); \
            *(u32x4*)(Ob + tok * 512 + h * 128 + e0 + hf * 8) = *(const u32x4*)(smem + SC_OST + (ps & 1) * 2048 + c * 32 + hf * 16); } \
        if ((st) + 4 < NSTEP) SC_LOAD(T, E, (st) + 4); \
        SC_BARRIER(); } } while (0)
        SC_LOAD(tA, eA, 0); SC_LOAD(tB, eB, 1); SC_LOAD(tC, eC, 2);
        for (int st = -1; st <= NSTEP; st += 3) { SC_ITER(tA, eA, st); SC_ITER(tB, eB, st + 1); SC_ITER(tC, eC, st + 2); }
#undef SC_ITER
#undef SC_WRITE
#undef SC_LOAD
    }
}
constexpr int SC_LEAD = 12;
DI void scan_prefetch(const Args& a, int chain, int phase_, int nph) {
    const int tid = tidx(); unsigned acc = 0u;
    unsigned* prog = (unsigned*)(a.ws + OFF_PROG) + chain * 16; int budget = 8192;
    for (int step = phase_; step < 260; step += nph) {
        while (budget > 0 && (int)__hip_atomic_load(prog, __ATOMIC_RELAXED, __HIP_MEMORY_SCOPE_AGENT) + SC_LEAD < step) { __builtin_amdgcn_s_sleep(8); --budget; }
        const unsigned char* rec = rec_ptr(a, chain * 260 + step);
        u32x4 v[9];
#pragma unroll
        for (int it = 0; it < 9; ++it) v[it] = *(const u32x4*)(rec + (size_t)(tid + it * 512) * 16);
#pragma unroll
        for (int it = 0; it < 9; ++it) acc ^= v[it].x ^ v[it].y ^ v[it].z ^ v[it].w;
    }
    if (acc == 0x9e3779b9u) ((unsigned*)(a.ws))[tid] = acc;
}
DI void phase4(const Args& a, char* smem) {
    const int G = (int)gridDim.x, NS = G >= 256 ? 128 : (G >= 2 ? G / 2 : 0), NPF = G >= 256 ? 32 : 0;
    if (NS == 0) { for (int u = 0; u < 128; ++u) scan_unit(a, smem, u);
        { const u32x4* src = (const u32x4*)(a.ws + OFF_ROPE); u32x4* dst = (u32x4*)(smem + AT_ROPE); for (int i = tidx(); i < 2048; i += 512) dst[i] = src[i]; } __syncthreads();
        for (int u = 0; u < N_ATT_UNITS; ++u) attn_unit(a, smem, u);
        __syncthreads(); for (int g = P0_WT_EARLY; g < P0_WT_GROUPS; ++g) p0_wt_group(a, smem, g); return; }
    if ((int)blockIdx.x < NS) {
        if (NS == 128) { const int blk = (int)blockIdx.x, xcd = blk & 7, j = blk >> 3; scan_unit(a, smem, ((xcd * 2 + (j >> 3)) << 3) | (j & 7)); }
        else for (int u = blockIdx.x; u < 128; u += NS) scan_unit(a, smem, u); }
    else if ((int)blockIdx.x < NS + NPF) { const int p = (int)blockIdx.x - NS, xcd = p & 7, j = p >> 3;
        scan_prefetch(a, xcd * 2 + (j & 1), j >> 1, 2); }
    else { const int NA = G - NS - NPF, ab = (int)blockIdx.x - NS - NPF;
        { const u32x4* src = (const u32x4*)(a.ws + OFF_ROPE); u32x4* dst = (u32x4*)(smem + AT_ROPE); for (int i = tidx(); i < 2048; i += 512) dst[i] = src[i]; }
        __syncthreads();
        for (int u = ab; u < N_ATT_UNITS; u += NA) attn_unit(a, smem, u);
        __syncthreads(); for (int g = P0_WT_EARLY + ab; g < P0_WT_GROUPS; g += NA) p0_wt_group(a, smem, g); }
}

DI void phase5(const Args& a) {
    const int lane = tidx() & 63, wid = tidx() >> 6;
    const bf16_t* Of = (const bf16_t*)(a.ws + OFF_O); const bf16_t* Obk = Of + (size_t)NLAT * 512; const bf16_t* Z = (const bf16_t*)(a.ws + OFF_Z);
    bf16_t* MIX = (bf16_t*)(a.ws + OFF_H);
    float ng[8];
#pragma unroll
    for (int e = 0; e < 8; ++e) ng[e] = a.gdn_norm_g[(lane & 15) * 8 + e];
    const int rs = (int)gridDim.x * 8;
    u32x4 nf, nb, nz;
    { const int row0 = blockIdx.x * 8 + wid; if (row0 < NLAT) { nf = *(const u32x4*)(Of + (size_t)row0 * 512 + lane * 8); nb = *(const u32x4*)(Obk + (size_t)row0 * 512 + lane * 8); nz = *(const u32x4*)(Z + (size_t)row0 * 512 + lane * 8); } }
    for (int row = blockIdx.x * 8 + wid; row < NLAT; row += rs) {
        float of[8], ob[8], z[8];
        unpack8(nf, of); unpack8(nb, ob); unpack8(nz, z);
        { const int nrow = row + rs; if (nrow < NLAT) { nf = *(const u32x4*)(Of + (size_t)nrow * 512 + lane * 8); nb = *(const u32x4*)(Obk + (size_t)nrow * 512 + lane * 8); nz = *(const u32x4*)(Z + (size_t)nrow * 512 + lane * 8); } }
        float ss = 0.f;
#pragma unroll
        for (int e = 0; e < 8; ++e) { of[e] += ob[e]; ss += of[e] * of[e]; }
        ss += __shfl_xor(ss, 1); ss += __shfl_xor(ss, 2); ss += __shfl_xor(ss, 4); ss += __shfl_xor(ss, 8);
        const float r = rsqrtf(ss * (1.f / 128.f) + EPS);
#pragma unroll
        for (int e = 0; e < 8; ++e) of[e] = of[e] * r * ng[e] * siluf(z[e]);
        *(u32x4*)(MIX + (size_t)row * DM + 512 + lane * 8) = pack8(of);
    }
}

template <bool IN_F32, bool OUT_F32> DI void rowpass(const Args& a, const void* xin_v, void* xout_v, const float* gate_base, int gate_bstride, const float* post_g,
                const float* next_g, const float* nsh_base, const float* nsc_base, int n_bstride, bool has_next) {
    const int lane = tidx() & 63, wid = tidx() >> 6;
    const bf16_t* Y = (const bf16_t*)(a.ws + OFF_Y); const float* SSQ = (const float*)(a.ws + OFF_SSQ); bf16_t* H = (bf16_t*)(a.ws + OFF_H);
    const int rs = (int)gridDim.x * 8;
    const float* xin = (const float*)xin_v; const bf16_t* xin16 = (const bf16_t*)xin_v; float* xout = (float*)xout_v; bf16_t* xout16 = (bf16_t*)xout_v;
    f32x4 xA[4], xB[4], xC[4]; u32x2 bA[4], bB[4], bC[4], yA[4], yB[4], yC[4]; float sA = 0.f, sB = 0.f, sC = 0.f;
#define RP_LOAD(XF, XB, Yv, S, r) do { _Pragma("unroll") for (int i = 0; i < 4; ++i) { const int k = i * 256 + lane * 4; \
        if constexpr (IN_F32) XF[i] = *(const f32x4*)(xin + (size_t)(r) * DM + k); else XB[i] = *(const u32x2*)(xin16 + (size_t)(r) * DM + k); \
        Yv[i] = *(const u32x2*)(Y + (size_t)(r) * DM + k); } \
        S = lane < 16 ? SSQ[(size_t)(r) * 16 + lane] : 0.f; } while (0)
    f32x4 gp[4], n1[4], n0[4]; int cur_b = -1;
#define RP_PARAMS(b) do { const float* gate = gate_base + (size_t)(b) * gate_bstride; \
        _Pragma("unroll") for (int i = 0; i < 4; ++i) { const int k = i * 256 + lane * 4; const f32x4 gv = *(const f32x4*)(gate + k), pg = *(const f32x4*)(post_g + k); gp[i] = gv * pg; \
            if (has_next) { const f32x4 g = *(const f32x4*)(next_g + k), s1 = *(const f32x4*)(nsh_base + (size_t)(b) * n_bstride + k), c1 = *(const f32x4*)(nsc_base + (size_t)(b) * n_bstride + k); \
                n1[i] = g * (c1 + 1.f); n0[i] = s1; } } } while (0)
#define RP_COMP(XF, XB, Yv, S, row) do { \
        const int b = (row) / SEQL; if (b != cur_b) { RP_PARAMS(b); cur_b = b; } \
        const float ry = rsqrtf(wave_sum(S) * (1.f / 1024.f) + EPS); \
        f32x4 v[4]; float ss = 0.f; \
        _Pragma("unroll") for (int i = 0; i < 4; ++i) { const int k = i * 256 + lane * 4; \
            const f32x4 yv = {bflo(Yv[i].x), bfhi(Yv[i].x), bflo(Yv[i].y), bfhi(Yv[i].y)}; \
            f32x4 xv; if constexpr (IN_F32) xv = XF[i]; else xv = (f32x4){bflo(XB[i].x), bfhi(XB[i].x), bflo(XB[i].y), bfhi(XB[i].y)}; \
            _Pragma("unroll") for (int e = 0; e < 4; ++e) { v[i][e] = xv[e] + gp[i][e] * (yv[e] * ry); ss += v[i][e] * v[i][e]; } \
            if constexpr (OUT_F32) *(f32x4*)(xout + (size_t)(row) * DM + k) = v[i]; else { u32x2 xw; xw.x = pk2(v[i][0], v[i][1]); xw.y = pk2(v[i][2], v[i][3]); *(u32x2*)(xout16 + (size_t)(row) * DM + k) = xw; } } \
        if (has_next) { \
            ss = wave_sum(ss); const float r = rsqrtf(ss * (1.f / 1024.f) + EPS); \
            _Pragma("unroll") for (int i = 0; i < 4; ++i) { const int k = i * 256 + lane * 4; float o[4]; \
                _Pragma("unroll") for (int e = 0; e < 4; ++e) o[e] = v[i][e] * r * n1[i][e] + n0[i][e]; \
                u32x2 w; w.x = pk2(o[0], o[1]); w.y = pk2(o[2], o[3]); *(u32x2*)(H + (size_t)(row) * DM + k) = w; } } } while (0)
    const int r0 = blockIdx.x * 8 + wid;
    if (r0 < NLAT) RP_LOAD(xA, bA, yA, sA, r0);
    if (r0 + rs < NLAT) RP_LOAD(xB, bB, yB, sB, r0 + rs);
    if (r0 + 2 * rs < NLAT) RP_LOAD(xC, bC, yC, sC, r0 + 2 * rs);
    for (int row = r0; row < NLAT; row += 3 * rs) {
        RP_COMP(xA, bA, yA, sA, row); if (row + 3 * rs < NLAT) RP_LOAD(xA, bA, yA, sA, row + 3 * rs);
        if (row + rs < NLAT) { RP_COMP(xB, bB, yB, sB, row + rs); if (row + 4 * rs < NLAT) RP_LOAD(xB, bB, yB, sB, row + 4 * rs); }
        if (row + 2 * rs < NLAT) { RP_COMP(xC, bC, yC, sC, row + 2 * rs); if (row + 5 * rs < NLAT) RP_LOAD(xC, bC, yC, sC, row + 5 * rs); }
    }
#undef RP_LOAD
#undef RP_COMP
#undef RP_PARAMS
}

DI void phase12(const Args& a) {
    const int lane = tidx() & 63, wid = tidx() >> 6;
    const bf16_t* CU = (const bf16_t*)(a.ws + OFF_BIG); const bf16_t* BG = CU + (size_t)NLAT * DM; bf16_t* MIX = (bf16_t*)(a.ws + OFF_H);
    float w0[2][8], w1[2][8], w2[2][8];
#pragma unroll
    for (int part = 0; part < 2; ++part)
#pragma unroll
        for (int e = 0; e < 8; ++e) { const int ch = part * 512 + lane * 8 + e; w0[part][e] = a.sc_conv_w[ch]; w1[part][e] = a.sc_conv_w[1024 + ch]; w2[part][e] = a.sc_conv_w[2048 + ch]; }
    const u32x4 zero4 = {0u, 0u, 0u, 0u};
    for (int blk = blockIdx.x * 8 + wid; blk < NLAT / 16; blk += gridDim.x * 8) {
        const int r0 = blk * 16, t0 = r0 & (SEQL - 1);
        u32x4 xp[2], xc[2], xn[2], xnn[2], bg[2], bgn[2], bgnn[2];
#pragma unroll
        for (int part = 0; part < 2; ++part) { const bf16_t* p = CU + (size_t)r0 * DM + part * 512 + lane * 8; const bf16_t* pb = BG + (size_t)r0 * DM + part * 512 + lane * 8;
            xc[part] = *(const u32x4*)p; xp[part] = t0 > 0 ? *(const u32x4*)(p - DM) : zero4; xn[part] = t0 + 1 < SEQL ? *(const u32x4*)(p + DM) : zero4;
            bg[part] = *(const u32x4*)pb; bgn[part] = *(const u32x4*)(pb + DM); }
        for (int i = 0; i < 16; ++i) {
            const int row = r0 + i, t = t0 + i;
#pragma unroll
            for (int part = 0; part < 2; ++part) { xnn[part] = (i < 15 && t + 2 < SEQL) ? *(const u32x4*)(CU + (size_t)(row + 2) * DM + part * 512 + lane * 8) : zero4;
                bgnn[part] = i < 14 ? *(const u32x4*)(BG + (size_t)(row + 2) * DM + part * 512 + lane * 8) : zero4; }
#pragma unroll
            for (int part = 0; part < 2; ++part) {
                float fc[8], fp[8], fn[8], fb[8], o[8]; unpack8(xc[part], fc); unpack8(xp[part], fp); unpack8(xn[part], fn); unpack8(bg[part], fb);
#pragma unroll
                for (int e = 0; e < 8; ++e) o[e] = fb[e] * (w0[part][e] * fp[e] + w1[part][e] * fc[e] + w2[part][e] * fn[e]);
                *(u32x4*)(MIX + (size_t)row * DM + part * 512 + lane * 8) = pack8(o);
            }
#pragma unroll
            for (int part = 0; part < 2; ++part) { xp[part] = xc[part]; xc[part] = xn[part]; xn[part] = xnn[part]; bg[part] = bgn[part]; bgn[part] = bgnn[part]; }
        }
    }
}

#ifndef ONLY_PH
#define ONLY_PH -1
#endif
#define PHASE_ON(n) ((ONLY_PH) < 0 || (ONLY_PH) == (n))
constexpr int N_PHASES = 18;
__global__ void __launch_bounds__(512, 2) fwd_megakernel(Args a) {
    extern __shared__ __attribute__((aligned(16))) char smem[];
    cg::grid_group grid = cg::this_grid();
    const float* MOD = (const float*)(a.ws + OFF_MOD);
    const bf16_t* WT = (const bf16_t*)(a.ws + OFF_WT);
    bf16_t* H = (bf16_t*)(a.ws + OFF_H);
    bf16_t* BIG = (bf16_t*)(a.ws + OFF_BIG);
    bf16_t* Y = (bf16_t*)(a.ws + OFF_Y); float* SSQ = (float*)(a.ws + OFF_SSQ);
    const int lo = a.ph_lo, hi = a.ph_hi;
#define IN(k) (PHASE_ON(k) && lo <= (k) && (k) < hi)
#define SEAM(k) do { if (lo <= (k) && (k) + 1 < hi) grid.sync(); } while (0)
#ifndef DBL
#define DBL 0u
#endif
#ifndef XSYNC
#define XSYNC 0
#endif
#define PH(k, ...) do { if (IN(k)) { __VA_ARGS__; if (((DBL) >> (k)) & 1u) { grid.sync(); __VA_ARGS__; } } SEAM(k); } while (0)
    PH(0, phase0(a, smem););
    PH(1, phase1(a, smem););
    PH(2, { EpiProj E; E.AT = (bf16_t*)((unsigned char*)a.out + OUT_ATT); E.P = (bf16_t*)(a.ws + OFF_PG); E.Z = (bf16_t*)(a.ws + OFF_Z); run_gemm(smem, H, WT + WT_IN, MROWS, NPROJ, 1024, E); });
    PH(4, phase3b(a, smem););
    PH(5, phase4(a, smem););
    PH(6, phase5(a););
    PH(7, { EpiY E; E.Y = Y; E.SSQ = SSQ; run_gemm(smem, H, WT + WT_OUT, NLAT, 1024, 1024, E); });
    PH(8, rowpass<true, false>(a, a.x, a.ws + OFF_X16, MOD + 2 * 1024, 6144, a.post_mix_g, a.pre_ffn_g, MOD + 3 * 1024, MOD + 4 * 1024, 6144, true););
    PH(9, { EpiAct E; E.O = BIG; run_gemm(smem, H, WT + WT_GU0, NLAT, 5632, 1024, E); });
    PH(10, { EpiY E; E.Y = Y; E.SSQ = SSQ; run_gemm(smem, BIG, WT + WT_DN0, NLAT, 1024, FF, E); });
    PH(11, rowpass<false, false>(a, a.ws + OFF_X16, a.ws + OFF_X16, MOD + 5 * 1024, 6144, a.post_ffn_g, a.pre_mix_g + 1024, MOD + 3 * 6144 + 0 * 1024, MOD + 3 * 6144 + 1 * 1024, 6144, true););
    PH(12, { EpiSc E; E.CU = BIG; E.BG = BIG + (size_t)NLAT * DM; run_gemm(smem, H, WT + WT_SCIN, NLAT, 3072, 1024, E); });
    PH(13, phase12(a););
    PH(14, { EpiY E; E.Y = Y; E.SSQ = SSQ; run_gemm(smem, H, WT + WT_SCOUT, NLAT, 1024, 1024, E); });
    PH(15, rowpass<false, false>(a, a.ws + OFF_X16, a.ws + OFF_X16, MOD + 3 * 6144 + 2 * 1024, 6144, a.post_mix_g + 1024, a.pre_ffn_g + 1024, MOD + 3 * 6144 + 3 * 1024, MOD + 3 * 6144 + 4 * 1024, 6144, true););
    PH(16, { EpiAct E; E.O = BIG; run_gemm(smem, H, WT + WT_GU1, NLAT, 5632, 1024, E); });
    PH(17, { EpiY E; E.Y = Y; E.SSQ = SSQ; run_gemm(smem, BIG, WT + WT_DN1, NLAT, 1024, FF, E); });
    PH(18, rowpass<false, true>(a, a.ws + OFF_X16, a.out, MOD + 3 * 6144 + 5 * 1024, 6144, a.post_ffn_g + 1024, nullptr, nullptr, nullptr, 0, false););
}

extern "C" void kernel_launch(void* const* d_in, const int* in_sizes, int n_in, void* d_out, int out_size, void* d_ws, size_t ws_size, hipStream_t stream) {
    static int grid = 0;
    if (grid == 0) {
        if (n_in != 23 || ws_size < WS_NEED) { fprintf(stderr, "kernel_launch: unexpected n_in %d / ws %zu\n", n_in, ws_size); grid = -1; return; }
        int dev = 0, cus = 0, per_cu = 0;
        hipGetDevice(&dev); hipDeviceGetAttribute(&cus, hipDeviceAttributeMultiprocessorCount, dev);
        hipFuncSetAttribute((const void*)fwd_megakernel, hipFuncAttributeMaxDynamicSharedMemorySize, LDS_BYTES);
        hipOccupancyMaxActiveBlocksPerMultiprocessor(&per_cu, (const void*)fwd_megakernel, 512, LDS_BYTES);
        if (per_cu < 1) { fprintf(stderr, "kernel_launch: occupancy query says %d blocks/CU\n", per_cu); per_cu = 1; }
        grid = cus * 1;
        (void)hipGetLastError();
    }
    if (grid < 0) return;
    Args a{};
    const float** f = (const float**)&a;
    for (int i = 0; i < 23; ++i) f[i] = (const float*)d_in[i];
    a.out = (float*)d_out; a.ws = (unsigned char*)d_ws; a.ph_lo = 0; a.ph_hi = N_PHASES + 1;
    void* args[] = {&a};
    hipError_t e = hipLaunchCooperativeKernel((const void*)fwd_megakernel, dim3(grid), dim3(512), args, LDS_BYTES, stream);
    if (e != hipSuccess) fprintf(stderr, "cooperative launch failed: %s (grid %d)\n", hipGetErrorString(e), grid);
}
```

```cpp
#include <hip/hip_runtime.h>
#include <hip/hip_cooperative_groups.h>
#include <cstdio>
#include <cstdint>
namespace cg = cooperative_groups;

__device__ __forceinline__ int tidx() { int t = (int)threadIdx.x; asm volatile("" : "+v"(t)); return t & 511; }
namespace pg8 {
#define PG8_LAS __attribute__((address_space(3)))
typedef unsigned short bf16_t;
typedef short bf16x8 __attribute__((ext_vector_type(8)));
typedef float f32x4 __attribute__((ext_vector_type(4)));
typedef unsigned u32x4 __attribute__((ext_vector_type(4)));
constexpr int BM = 256, BK = 64, HALF = 128, HTB = HALF * BK * 2  , STAGE_BYTES = 8 * HTB, NXCD = 8, WGM = 8;

__host__ __device__ __forceinline__ int lds_byte(int r, int c) { const int st = (r >> 4) * 2 + (c >> 5), rr = r & 15, cc = c & 31, ob = rr * 64 + cc * 2; return st * 1024 + (ob ^ (((ob >> 9) & 1) << 5)); }
__host__ __device__ __forceinline__ void stage_rc(int b, int& R, int& C) { const int st = b / 1024, sb = b % 1024, swz = sb ^ (((sb >> 9) & 1) << 5); R = (st >> 1) * 16 + swz / 64; C = (st & 1) * 32 + (swz % 64) / 2; }
__host__ __device__ __forceinline__ int perm32(int rho) { const int n = rho >> 4, i = rho & 15; return 8 * (i >> 2) + 4 * n + (i & 3); }

struct Unit { int pm, pn; };
struct Gemm { const bf16_t* A; const bf16_t* Bt; int M, N, K; };

struct StaticOrder {
    int nM, nN, nwg, G, c;
    __host__ __device__ void init(int M, int N, int G_, int c_) { nM = M / BM; nN = N / BM; nwg = nM * nN; G = G_; c = c_; }
    __host__ __device__ bool next(int i, Unit& u) const {
        const long L = (long)i * G + c; if (L >= nwg) return false;
        int wgid = (int)L; { const int q = nwg / NXCD, r = nwg % NXCD, xcd = wgid % NXCD, off = wgid / NXCD; wgid = (xcd < r ? xcd * (q + 1) : r * (q + 1) + (xcd - r) * q) + off; }
        const int nig = WGM * nN, gid = wgid / nig, fm = gid * WGM, gsz = (nM - fm) < WGM ? (nM - fm) : WGM;
        u.pm = fm + ((wgid % nig) % gsz); u.pn = (wgid % nig) / gsz; return true;
    }
    __device__ __forceinline__ void a_ready(const Unit&) const {}
    __device__ __forceinline__ void done(const Unit&) const {}
};

__device__ __forceinline__ unsigned cvt_pk_bf16(float lo, float hi) { unsigned r; asm volatile("v_cvt_pk_bf16_f32 %0, %1, %2" : "=v"(r) : "v"(lo), "v"(hi)); return r; }
template <class Epi, class Sched, bool ALIGN_EPI = false, bool SP2 = false>
__device__ __forceinline__ void gemm_phase(PG8_LAS unsigned char* lds, const Gemm g, const Sched& S, const Epi& E) {
    const int tid = tidx(), wid = __builtin_amdgcn_readfirstlane(tid >> 6), lane = tid & 63, wr = wid >> 2, wc = wid & 3, fr = lane & 15, fq = lane >> 4;
    const int K = g.K, nt = K / BK;
    unsigned voffA[2], voffB[2];
#pragma unroll
    for (int i = 0; i < 2; ++i) { int R, C; stage_rc(tid * 16 + i * 8192, R, C); const int Rb = Epi::PERM ? ((R & ~31) + perm32(R & 31)) : R;
        voffA[i] = (unsigned)(R * K + C) * 2u; voffB[i] = (unsigned)(Rb * K + C) * 2u; }
    const size_t kstep = (size_t)(BK * 2);
    const size_t hstep = (size_t)HALF * K * 2;
    const size_t tstep = 2 * hstep;
    const unsigned ldsw = (unsigned)wid * 1024u;
    const int aoff = lds_byte(wr * 64 + fr, fq * 8), boff = lds_byte(wc * 32 + fr, fq * 8);
#define PG8_SA(b, h) (((b) * 2 + (h)) * HTB)
#define PG8_SB(b, h) ((4 + (b) * 2 + (h)) * HTB)
#define PG8_STAGE(bufoff, gbase, voff) do { _Pragma("unroll") for (int _i = 0; _i < 2; ++_i) \
        __builtin_amdgcn_global_load_lds((const unsigned*)((const char*)(gbase) + (voff)[_i]), (PG8_LAS unsigned*)(lds + (bufoff) + ldsw + _i * 8192), 16, 0, 0); } while (0)
#define PG8_LDA(dst, b, h) do { _Pragma("unroll") for (int m = 0; m < 4; ++m) _Pragma("unroll") for (int k = 0; k < 2; ++k) dst[m][k] = *(const PG8_LAS bf16x8*)(lds + PG8_SA(b, h) + aoff + m * 2048 + k * 1024); } while (0)
#define PG8_LDB(dst, b, h) do { _Pragma("unroll") for (int n = 0; n < 2; ++n) _Pragma("unroll") for (int k = 0; k < 2; ++k) dst[n][k] = *(const PG8_LAS bf16x8*)(lds + PG8_SB(b, h) + boff + n * 2048 + k * 1024); } while (0)
#define PG8_MMA(ai, bj, At, Bt) do { __builtin_amdgcn_s_setprio(1); _Pragma("unroll") for (int m = 0; m < 4; ++m) _Pragma("unroll") for (int n = 0; n < 2; ++n) _Pragma("unroll") for (int k = 0; k < 2; ++k) \
        acc[ai][bj][m][n] = __builtin_amdgcn_mfma_f32_16x16x32_bf16(Bt[n][k], At[m][k], acc[ai][bj][m][n], 0, 0, 0); __builtin_amdgcn_s_setprio(0); } while (0)
#define PG8_WAIT_V(n) asm volatile("s_waitcnt vmcnt(" #n ")" ::: "memory")
#define PG8_WAIT_L(n) asm volatile("s_waitcnt lgkmcnt(" #n ")" ::: "memory")
#define PG8_BAR __builtin_amdgcn_s_barrier()
#define PG8_SCHED __builtin_amdgcn_sched_barrier(0)
    Unit cur, nxt; int ui = 0;
    if (!S.next(0, cur)) return;
    f32x4 acc[2][2][4][2];
#pragma unroll
    for (int a = 0; a < 2; ++a)
#pragma unroll
        for (int b = 0; b < 2; ++b)
#pragma unroll
            for (int m = 0; m < 4; ++m)
#pragma unroll
                for (int n = 0; n < 2; ++n) acc[a][b][m][n] = (f32x4){0.f, 0.f, 0.f, 0.f};
    bf16x8 At[4][2], B0[2][2], B1[2][2];
    const char* cA = (const char*)g.A + (size_t)cur.pm * tstep; const char* cB = (const char*)g.Bt + (size_t)cur.pn * tstep;
    S.a_ready(cur);
    if constexpr (SP2) {
        PG8_STAGE(PG8_SB(0, 0), cB, voffB); PG8_STAGE(PG8_SB(0, 1), cB + hstep, voffB); PG8_STAGE(PG8_SA(0, 0), cA, voffA); PG8_STAGE(PG8_SA(0, 1), cA + hstep, voffA);
        if (wr == 1) PG8_BAR;
        PG8_WAIT_V(2); PG8_BAR;
        PG8_STAGE(PG8_SB(1, 0), cB + kstep, voffB); PG8_STAGE(PG8_SA(1, 0), cA + kstep, voffA); PG8_STAGE(PG8_SB(1, 1), cB + hstep + kstep, voffB);
        PG8_WAIT_V(6); PG8_BAR;
    } else {
        PG8_STAGE(PG8_SB(0, 0), cB, voffB); PG8_STAGE(PG8_SA(0, 0), cA, voffA); PG8_STAGE(PG8_SB(0, 1), cB + hstep, voffB); PG8_STAGE(PG8_SA(0, 1), cA + hstep, voffA);
        if (wr == 1) PG8_BAR;
        PG8_WAIT_V(4); PG8_BAR;
        PG8_STAGE(PG8_SB(1, 0), cB + kstep, voffB); PG8_STAGE(PG8_SA(1, 0), cA + kstep, voffA); PG8_STAGE(PG8_SB(1, 1), cB + hstep + kstep, voffB);
        PG8_WAIT_V(6); PG8_BAR;
    }
    for (;;) {
        const bool has_next = S.next(ui + 1, nxt);
        const char* nA = has_next ? (const char*)g.A + (size_t)nxt.pm * tstep : cA; const char* nB = has_next ? (const char*)g.Bt + (size_t)nxt.pn * tstep : cB;
        for (int t = 0; t < nt; t += 2) {
            const bool last = (t == nt - 2);
            const char* a1 = cA + (size_t)(t + 1) * kstep;
            const char* a2 = last ? nA : cA + (size_t)(t + 2) * kstep; const char* b2 = last ? nB : cB + (size_t)(t + 2) * kstep;
            const char* a3 = a2 + kstep; const char* b3 = b2 + kstep;
            if (last && has_next) S.a_ready(nxt);
            if constexpr (SP2) {
            PG8_LDB(B0, 0, 0); PG8_LDB(B1, 0, 1); PG8_SCHED; PG8_LDA(At, 0, 0); PG8_STAGE(PG8_SA(1, 1), a1 + hstep, voffA);
            PG8_WAIT_V(8); PG8_WAIT_L(0); PG8_BAR; PG8_MMA(0, 0, At, B0); PG8_MMA(0, 1, At, B1); PG8_BAR; PG8_SCHED;
            PG8_LDA(At, 0, 1); PG8_STAGE(PG8_SB(0, 0), b2, voffB); PG8_STAGE(PG8_SB(0, 1), b2 + hstep, voffB); PG8_STAGE(PG8_SA(0, 0), a2, voffA);
            PG8_WAIT_V(8); PG8_WAIT_L(0); PG8_BAR; PG8_MMA(1, 0, At, B0); PG8_MMA(1, 1, At, B1); PG8_BAR; PG8_SCHED;
            PG8_LDB(B0, 1, 0); PG8_LDB(B1, 1, 1); PG8_SCHED; PG8_LDA(At, 1, 0); PG8_STAGE(PG8_SA(0, 1), a2 + hstep, voffA);
            PG8_WAIT_V(8); PG8_WAIT_L(0); PG8_BAR; PG8_MMA(0, 0, At, B0); PG8_MMA(0, 1, At, B1); PG8_BAR; PG8_SCHED;
            PG8_LDA(At, 1, 1); PG8_STAGE(PG8_SB(1, 0), b3, voffB); PG8_STAGE(PG8_SB(1, 1), b3 + hstep, voffB); PG8_STAGE(PG8_SA(1, 0), a3, voffA);
            PG8_WAIT_V(8); PG8_WAIT_L(0); PG8_BAR; PG8_MMA(1, 0, At, B0); PG8_MMA(1, 1, At, B1); PG8_BAR; PG8_SCHED;
            } else {
            PG8_LDB(B0, 0, 0); PG8_SCHED; PG8_LDA(At, 0, 0); PG8_STAGE(PG8_SA(1, 1), a1 + hstep, voffA);
            PG8_WAIT_L(8); PG8_BAR; PG8_WAIT_L(0); PG8_MMA(0, 0, At, B0); PG8_BAR; PG8_SCHED;
            PG8_LDB(B1, 0, 1); PG8_STAGE(PG8_SB(0, 0), b2, voffB);
            PG8_BAR; PG8_WAIT_L(0); PG8_MMA(0, 1, At, B1); PG8_BAR;
            PG8_LDA(At, 0, 1); PG8_STAGE(PG8_SA(0, 0), a2, voffA);
            PG8_BAR; PG8_WAIT_L(0); PG8_MMA(1, 0, At, B0); PG8_BAR; PG8_SCHED;
            PG8_STAGE(PG8_SB(0, 1), b2 + hstep, voffB);
            PG8_WAIT_V(6); PG8_BAR; PG8_MMA(1, 1, At, B1); PG8_BAR;
            PG8_LDB(B0, 1, 0); PG8_SCHED; PG8_LDA(At, 1, 0); PG8_STAGE(PG8_SA(0, 1), a2 + hstep, voffA);
            PG8_WAIT_L(8); PG8_BAR; PG8_WAIT_L(0); PG8_MMA(0, 0, At, B0); PG8_BAR; PG8_SCHED;
            PG8_LDB(B1, 1, 1); PG8_STAGE(PG8_SB(1, 0), b3, voffB);
            PG8_BAR; PG8_WAIT_L(0); PG8_MMA(0, 1, At, B1); PG8_BAR;
            PG8_LDA(At, 1, 1); PG8_STAGE(PG8_SA(1, 0), a3, voffA);
            PG8_BAR; PG8_WAIT_L(0); PG8_MMA(1, 0, At, B0); PG8_BAR; PG8_SCHED;
            PG8_STAGE(PG8_SB(1, 1), b3 + hstep, voffB);
            PG8_WAIT_V(6); PG8_BAR; PG8_MMA(1, 1, At, B1); PG8_BAR;
            }
        }
        if constexpr (ALIGN_EPI) { if (wr == 0) PG8_BAR; }
        if constexpr (!Epi::AFTER_DRAIN) { E(acc, cur, wr, wc, fr, fq); S.done(cur); }
        if (!has_next) break;
#pragma unroll
        for (int a = 0; a < 2; ++a)
#pragma unroll
            for (int b = 0; b < 2; ++b)
#pragma unroll
                for (int m = 0; m < 4; ++m)
#pragma unroll
                    for (int n = 0; n < 2; ++n) acc[a][b][m][n] = (f32x4){0.f, 0.f, 0.f, 0.f};
        cur = nxt; cA = nA; cB = nB; ++ui;
        if constexpr (ALIGN_EPI) { if (wr == 1) PG8_BAR; }
    }
    PG8_WAIT_V(0);
    if constexpr (!ALIGN_EPI) { if (wr == 0) PG8_BAR; }
    PG8_BAR;
    if constexpr (Epi::AFTER_DRAIN) { E.fused(acc, cur, wr, wc, fr, fq, lds, wid, lane); S.done(cur); }
#undef PG8_SA
#undef PG8_SB
#undef PG8_STAGE
#undef PG8_LDA
#undef PG8_LDB
#undef PG8_MMA
#undef PG8_WAIT_V
#undef PG8_WAIT_L
#undef PG8_BAR
#undef PG8_SCHED
}
}

using pg8::bf16_t; using pg8::bf16x8; using pg8::f32x4; using pg8::u32x4;
typedef unsigned u32x2 __attribute__((ext_vector_type(2)));
#define DI __device__ __forceinline__
#define LAS __attribute__((address_space(3)))
constexpr int DM = 1024, SEQL = 16384, NB = 2, NLAT = NB * SEQL, CTXL = 256, NCTX = NB * CTXL, MROWS = NLAT + NCTX;
constexpr int FF = 2816, NPROJ = 2816, PG_LD = 1536, ATT_LD = 768, HYIN = 2832;
constexpr size_t OUT_ATT = (size_t)40 << 20;
constexpr int NCHUNK = MROWS / 64;
constexpr int NREC = NCHUNK * 4 * 2;
constexpr int REC_BYTES = 73728, REC_W = 0, REC_QG = 16384, REC_KTT = 32768, REC_QK = 49152, REC_UT = 57344;
constexpr int REC_IN_WS = 3640;
constexpr float EPS = 1e-6f;
constexpr int LDS_BYTES = 163840;
constexpr size_t MiB = 1u << 20;
constexpr size_t OFF_MOD = 1 * MiB, OFF_ROPE = OFF_MOD + 512 * 1024, OFF_EGL = OFF_ROPE + 256 * 1024, OFF_AB = 2 * MiB, OFF_SSQ = 5 * MiB, OFF_WT = 8 * MiB;
constexpr size_t OFF_H = 58 * MiB, OFF_Z = 124 * MiB, OFF_QN = 157 * MiB, OFF_KN = 190 * MiB, OFF_VN = 223 * MiB, OFF_BIG = 256 * MiB, OFF_Y = 124 * MiB, OFF_O = 190 * MiB, OFF_X16 = 190 * MiB, OFF_PG = 157 * MiB;
constexpr size_t WS_NEED = 512 * MiB;
constexpr size_t OFF_PROG = OFF_EGL + 32 * 1024;
constexpr size_t WT_IN = 0, WT_OUT = WT_IN + (size_t)2816 * 1024, WT_GU0 = WT_OUT + (size_t)1024 * 1024, WT_DN0 = WT_GU0 + (size_t)5632 * 1024, WT_SCIN = WT_DN0 + (size_t)1024 * 2816,
                 WT_SCOUT = WT_SCIN + (size_t)3072 * 1024, WT_GU1 = WT_SCOUT + (size_t)1024 * 1024, WT_DN1 = WT_GU1 + (size_t)5632 * 1024, WT_END = WT_DN1 + (size_t)1024 * 2816;

struct Args {
    const float* x; const float* c; const float* ctx; const float* c_ctx; const float* ada_w; const float* ada_b; const float* pre_mix_g; const float* post_mix_g; const float* pre_ffn_g; const float* post_ffn_g;
    const float* hy_w_in; const float* hy_w_out; const float* attn_sink; const float* gdn_conv_w; const float* gdn_a_log; const float* gdn_dt_bias; const float* gdn_norm_g;
    const float* sc_w_in; const float* sc_conv_w; const float* sc_w_out; const float* ffn_w_gate; const float* ffn_w_up; const float* ffn_w_down;
    float* out; unsigned char* ws; int ph_lo, ph_hi;
};

DI unsigned f2bf(float f) { unsigned u = __float_as_uint(f); return (u + 0x7fffu + ((u >> 16) & 1u)) >> 16; }
typedef float f32x2_t __attribute__((ext_vector_type(2)));
typedef __bf16 bf16x2_t __attribute__((ext_vector_type(2)));
DI unsigned pk2(float lo, float hi) { f32x2_t v = {lo, hi}; bf16x2_t b = __builtin_convertvector(v, bf16x2_t); return __builtin_bit_cast(unsigned, b); }
DI float bflo(unsigned u) { return __uint_as_float(u << 16); }
DI float bfhi(unsigned u) { return __uint_as_float(u & 0xffff0000u); }
DI float bf1(bf16_t h) { return __uint_as_float(((unsigned)h) << 16); }
DI float wave_sum(float v) {
#pragma unroll
    for (int o = 32; o; o >>= 1) v += __shfl_xor(v, o);
    return v;
}
DI float siluf(float x) { return x * __builtin_amdgcn_rcpf(1.f + __expf(-x)); }
DI f32x4 mfma16(bf16x8 a, bf16x8 b, f32x4 c) { return __builtin_amdgcn_mfma_f32_16x16x32_bf16(a, b, c, 0, 0, 0); }
DI bf16x8 pack2(f32x4 a, f32x4 b) { u32x4 p; p.x = pk2(a[0], a[1]); p.y = pk2(a[2], a[3]); p.z = pk2(b[0], b[1]); p.w = pk2(b[2], b[3]); return __builtin_bit_cast(bf16x8, p); }
DI bf16x8 ldf16(const char* p) { return *(const bf16x8*)p; }
DI bf16x8 ldf8x2(const char* p) { u32x2 lo = *(const u32x2*)p; u32x2 hi = *(const u32x2*)(p + 32); u32x4 v; v.x = lo.x; v.y = lo.y; v.z = hi.x; v.w = hi.y; return __builtin_bit_cast(bf16x8, v); }
DI void unpack8(u32x4 v, float (&f)[8]) { f[0] = bflo(v.x); f[1] = bfhi(v.x); f[2] = bflo(v.y); f[3] = bfhi(v.y); f[4] = bflo(v.z); f[5] = bfhi(v.z); f[6] = bflo(v.w); f[7] = bfhi(v.w); }
DI u32x4 pack8(const float (&f)[8]) { u32x4 v; v.x = pk2(f[0], f[1]); v.y = pk2(f[2], f[3]); v.z = pk2(f[4], f[5]); v.w = pk2(f[6], f[7]); return v; }

DI unsigned char* rec_ptr(const Args& a, int r) { return r < REC_IN_WS ? a.ws + OFF_BIG + (size_t)r * REC_BYTES : (unsigned char*)a.out + (size_t)(r - REC_IN_WS) * REC_BYTES; }

struct EpiProj {
    static constexpr bool PERM = true, AFTER_DRAIN = false;
    bf16_t* AT; bf16_t* P; bf16_t* Z;
    DI void operator()(const f32x4 (&acc)[2][2][4][2], const pg8::Unit& u, int wr, int wc, int fr, int fq) const {
        const int row0 = u.pm * 256 + wr * 64 + fr; bf16_t* base; int ld, colt;
        if (u.pn < 3) { base = AT; ld = ATT_LD; colt = u.pn * 256; } else if (u.pn < 9) { base = P; ld = PG_LD; colt = (u.pn - 3) * 256; } else { base = Z; ld = 512; colt = (u.pn - 9) * 256; }
        const int col0 = colt + wc * 32 + 8 * fq;
#pragma unroll
        for (int ai = 0; ai < 2; ++ai)
#pragma unroll
            for (int m = 0; m < 4; ++m) { bf16_t* rowp = base + (size_t)(row0 + ai * 128 + m * 16) * ld + col0;
#pragma unroll
                for (int bj = 0; bj < 2; ++bj) { const f32x4 v0 = acc[ai][bj][m][0], v1 = acc[ai][bj][m][1]; u32x4 w;
                    w.x = pg8::cvt_pk_bf16(v0[0], v0[1]); w.y = pg8::cvt_pk_bf16(v0[2], v0[3]); w.z = pg8::cvt_pk_bf16(v1[0], v1[1]); w.w = pg8::cvt_pk_bf16(v1[2], v1[3]);
                    *(u32x4*)(rowp + bj * 128) = w; } }
    }
};
struct EpiAct {
    static constexpr bool PERM = true, AFTER_DRAIN = false;
    bf16_t* O;
    DI void operator()(const f32x4 (&acc)[2][2][4][2], const pg8::Unit& u, int wr, int wc, int fr, int fq) const {
        const int row0 = u.pm * 256 + wr * 64 + fr, col0 = u.pn * 128 + wc * 32 + 8 * fq;
#pragma unroll
        for (int ai = 0; ai < 2; ++ai)
#pragma unroll
            for (int m = 0; m < 4; ++m) { bf16_t* rowp = O + (size_t)(row0 + ai * 128 + m * 16) * FF + col0; float v[8];
#pragma unroll
                for (int n = 0; n < 2; ++n)
#pragma unroll
                    for (int e = 0; e < 4; ++e) v[4 * n + e] = siluf(acc[ai][0][m][n][e]) * acc[ai][1][m][n][e];
                u32x4 w; w.x = pg8::cvt_pk_bf16(v[0], v[1]); w.y = pg8::cvt_pk_bf16(v[2], v[3]); w.z = pg8::cvt_pk_bf16(v[4], v[5]); w.w = pg8::cvt_pk_bf16(v[6], v[7]);
                *(u32x4*)rowp = w; }
    }
};
struct EpiSc {
    static constexpr bool PERM = true, AFTER_DRAIN = false;
    bf16_t* CU; bf16_t* BG;
    DI void operator()(const f32x4 (&acc)[2][2][4][2], const pg8::Unit& u, int wr, int wc, int fr, int fq) const {
        const int row0 = u.pm * 256 + wr * 64 + fr;
        if (u.pn < 8) {
            const int col0 = u.pn * 128 + wc * 32 + 8 * fq;
#pragma unroll
            for (int ai = 0; ai < 2; ++ai)
#pragma unroll
                for (int m = 0; m < 4; ++m) { bf16_t* rowp = CU + (size_t)(row0 + ai * 128 + m * 16) * DM + col0; float v[8];
#pragma unroll
                    for (int n = 0; n < 2; ++n)
#pragma unroll
                        for (int e = 0; e < 4; ++e) v[4 * n + e] = acc[ai][0][m][n][e] * acc[ai][1][m][n][e];
                    u32x4 w; w.x = pg8::cvt_pk_bf16(v[0], v[1]); w.y = pg8::cvt_pk_bf16(v[2], v[3]); w.z = pg8::cvt_pk_bf16(v[4], v[5]); w.w = pg8::cvt_pk_bf16(v[6], v[7]);
                    *(u32x4*)rowp = w; }
        } else {
            const int col0 = (u.pn - 8) * 256 + wc * 32 + 8 * fq;
#pragma unroll
            for (int ai = 0; ai < 2; ++ai)
#pragma unroll
                for (int m = 0; m < 4; ++m) { bf16_t* rowp = BG + (size_t)(row0 + ai * 128 + m * 16) * DM + col0;
#pragma unroll
                    for (int bj = 0; bj < 2; ++bj) { const f32x4 v0 = acc[ai][bj][m][0], v1 = acc[ai][bj][m][1]; u32x4 w;
                        w.x = pg8::cvt_pk_bf16(v0[0], v0[1]); w.y = pg8::cvt_pk_bf16(v0[2], v0[3]); w.z = pg8::cvt_pk_bf16(v1[0], v1[1]); w.w = pg8::cvt_pk_bf16(v1[2], v1[3]);
                        *(u32x4*)(rowp + bj * 128) = w; } }
        }
    }
};
struct EpiY {
    static constexpr bool PERM = true, AFTER_DRAIN = false;
    bf16_t* Y; float* SSQ;
    DI void operator()(const f32x4 (&acc)[2][2][4][2], const pg8::Unit& u, int wr, int wc, int fr, int fq) const {
        const int row0 = u.pm * 256 + wr * 64 + fr, col0 = u.pn * 256 + wc * 32 + 8 * fq;
#pragma unroll
        for (int ai = 0; ai < 2; ++ai)
#pragma unroll
            for (int m = 0; m < 4; ++m) { const int row = row0 + ai * 128 + m * 16; bf16_t* rowp = Y + (size_t)row * DM + col0; float s = 0.f;
#pragma unroll
                for (int bj = 0; bj < 2; ++bj) { const f32x4 v0 = acc[ai][bj][m][0], v1 = acc[ai][bj][m][1]; u32x4 w;
                    w.x = pg8::cvt_pk_bf16(v0[0], v0[1]); w.y = pg8::cvt_pk_bf16(v0[2], v0[3]); w.z = pg8::cvt_pk_bf16(v1[0], v1[1]); w.w = pg8::cvt_pk_bf16(v1[2], v1[3]);
                    *(u32x4*)(rowp + bj * 128) = w;
                    s += v0[0] * v0[0] + v0[1] * v0[1] + v0[2] * v0[2] + v0[3] * v0[3] + v1[0] * v1[0] + v1[1] * v1[1] + v1[2] * v1[2] + v1[3] * v1[3]; }
                s += __shfl_xor(s, 16); s += __shfl_xor(s, 32);
                if (fq == 0) SSQ[(size_t)row * 16 + u.pn * 4 + wc] = s; }
    }
};

template <class Epi> DI void run_gemm(char* smem, const bf16_t* A, const bf16_t* Bt, int M, int N, int K, const Epi& E) {
    pg8::Gemm g; g.A = A; g.Bt = Bt; g.M = M; g.N = N; g.K = K;
    pg8::StaticOrder S; S.init(M, N, (int)gridDim.x, (int)blockIdx.x);
    pg8::gemm_phase<Epi, pg8::StaticOrder, false, true>((PG8_LAS unsigned char*)smem, g, S, E);
    __syncthreads();
}

DI void p0_ada_unit(const Args& a, char* smem, int u) {
    const int l = u / 96, col0 = (u % 96) * 64, tid = tidx();
    float* sc = (float*)smem;
    float* red = (float*)(smem + 12288);
    for (int i = tid; i < 3072; i += 512) { const int cd = i >> 10, k = i & 1023; const float v = cd < 2 ? a.c[cd * DM + k] : a.c_ctx[k]; sc[i] = siluf(v); }
    __syncthreads();
    const int col = tid & 63, kq = tid >> 6;
    const float* W = a.ada_w + (size_t)l * DM * 6144 + col0 + col;
    float s0 = 0.f, s1 = 0.f, s2 = 0.f;
    for (int k0 = kq * 128; k0 < kq * 128 + 128; k0 += 16) { float w[16];
#pragma unroll
        for (int j = 0; j < 16; ++j) w[j] = W[(size_t)(k0 + j) * 6144];
#pragma unroll
        for (int j = 0; j < 16; ++j) { s0 += sc[k0 + j] * w[j]; s1 += sc[1024 + k0 + j] * w[j]; s2 += sc[2048 + k0 + j] * w[j]; } }
    red[(kq * 3 + 0) * 64 + col] = s0; red[(kq * 3 + 1) * 64 + col] = s1; red[(kq * 3 + 2) * 64 + col] = s2;
    __syncthreads();
    if (tid < 192) { const int cd = tid >> 6, cc = tid & 63; float s = 0.f;
        for (int q = 0; q < 8; ++q) s += red[(q * 3 + cd) * 64 + cc];
        float* MOD = (float*)(a.ws + OFF_MOD);
        MOD[((size_t)l * 3 + cd) * 6144 + col0 + cc] = s + a.ada_b[l * 6144 + col0 + cc]; }
    __syncthreads();
}
DI void p0_rope_unit(const Args& a) {
    if (tidx() < 16) __hip_atomic_store((unsigned*)(a.ws + OFF_PROG) + tidx() * 16, 0u, __ATOMIC_RELAXED, __HIP_MEMORY_SCOPE_AGENT);
    float2* R = (float2*)(a.ws + OFF_ROPE);
    for (int i = tidx(); i < 4096; i += 512) { const int p = i >> 4, f = i & 15;
        const float inv = powf(10000.f, -(float)f / 16.f); const float ang = (float)p * inv;
        R[i] = make_float2(cosf(ang), sinf(ang)); }
}
struct WtTile { const float* src; bf16_t* dst; int ldn, K, scol0, n0, k0; };
DI WtTile p0_wt_desc(const Args& a, int t) {
    bf16_t* WT = (bf16_t*)(a.ws + OFF_WT);
    const int T_IN = 44 * 16, T_OUT = 16 * 16, T_GU = 88 * 16, T_DN = 16 * 44, T_SCIN = 48 * 16, T_SCOUT = 16 * 16;
    int m = 0; int rem = t;
    if (rem >= T_IN) { rem -= T_IN; m = 1;
      if (rem >= T_OUT) { rem -= T_OUT; m = 2;
        if (rem >= T_GU) { rem -= T_GU; m = 3;
          if (rem >= T_DN) { rem -= T_DN; m = 4;
            if (rem >= T_SCIN) { rem -= T_SCIN; m = 5;
              if (rem >= T_SCOUT) { rem -= T_SCOUT; m = 6;
                if (rem >= T_GU) { rem -= T_GU; m = 7; } } } } } } }
    WtTile d; int nb, kb;
    if (m == 0) { d.K = 1024; nb = rem / 16; kb = rem % 16; d.src = a.hy_w_in; d.ldn = HYIN; d.scol0 = nb * 64; d.dst = WT + WT_IN; }
    else if (m == 1) { d.K = 1024; nb = rem / 16; kb = rem % 16; d.src = a.hy_w_out; d.ldn = 1024; d.scol0 = nb * 64; d.dst = WT + WT_OUT; }
    else if (m == 2 || m == 6) { const int l = m == 2 ? 0 : 1; d.K = 1024; nb = rem / 16; kb = rem % 16; const int n0 = nb * 64, pn = n0 >> 8, sg = (n0 >> 7) & 1, i0 = n0 & 127;
        d.src = (sg ? a.ffn_w_up : a.ffn_w_gate) + (size_t)l * DM * FF; d.ldn = FF; d.scol0 = pn * 128 + i0; d.dst = WT + (l ? WT_GU1 : WT_GU0); }
    else if (m == 3 || m == 7) { const int l = m == 3 ? 0 : 1; d.K = 2816; nb = rem / 44; kb = rem % 44; d.src = a.ffn_w_down + (size_t)l * FF * DM; d.ldn = 1024; d.scol0 = nb * 64; d.dst = WT + (l ? WT_DN1 : WT_DN0); }
    else if (m == 4) { d.K = 1024; nb = rem / 16; kb = rem % 16; const int n0 = nb * 64; d.src = a.sc_w_in; d.ldn = 3072; d.dst = WT + WT_SCIN;
        if (n0 < 2048) { const int pn = n0 >> 8, sg = (n0 >> 7) & 1, i0 = n0 & 127; d.scol0 = (sg ? 2048 : 1024) + pn * 128 + i0; } else d.scol0 = n0 - 2048; }
    else { d.K = 1024; nb = rem / 16; kb = rem % 16; d.src = a.sc_w_out; d.ldn = 1024; d.scol0 = nb * 64; d.dst = WT + WT_SCOUT; }
    d.n0 = nb * 64; d.k0 = kb * 64; return d;
}
constexpr int P0_WT_TILES = 44 * 16 + 16 * 16 + 88 * 16 + 16 * 44 + 48 * 16 + 16 * 16 + 88 * 16 + 16 * 44;
constexpr int P0_WT_GROUPS = P0_WT_TILES / 4, P0_WT_EARLY = 44 * 16 / 4;
DI void p0_wt_group(const Args& a, char* smem, int g) {
    const int tid = tidx(); float* T = (float*)smem;
    f32x4 v0[4], v1[4];
#pragma unroll
    for (int j = 0; j < 4; ++j) { const WtTile d = p0_wt_desc(a, g * 4 + j); const int k = tid >> 3, ns = (tid & 7) * 8; const float* p = d.src + (size_t)(d.k0 + k) * d.ldn + d.scol0 + ns;
        v0[j] = *(const f32x4*)p; v1[j] = *(const f32x4*)(p + 4); }
#pragma unroll
    for (int j = 0; j < 4; ++j) { const int k = tid >> 3, ns = (tid & 7) * 8; float* t = T + j * 4160 + k * 65 + ns;
        t[0] = v0[j][0]; t[1] = v0[j][1]; t[2] = v0[j][2]; t[3] = v0[j][3]; t[4] = v1[j][0]; t[5] = v1[j][1]; t[6] = v1[j][2]; t[7] = v1[j][3]; }
    __syncthreads();
#pragma unroll
    for (int j = 0; j < 4; ++j) { const WtTile d = p0_wt_desc(a, g * 4 + j); const int n = tid >> 3, ks = (tid & 7) * 8; float f[8];
#pragma unroll
        for (int e = 0; e < 8; ++e) f[e] = T[j * 4160 + (ks + e) * 65 + n];
        *(u32x4*)(d.dst + (size_t)(d.n0 + n) * d.K + d.k0 + ks) = pack8(f); }
    __syncthreads();
}
DI void phase0(const Args& a, char* smem) {
    for (int u = blockIdx.x; u < 193 + P0_WT_EARLY; u += gridDim.x) {
        if (u < 192) p0_ada_unit(a, smem, u); else if (u == 192) p0_rope_unit(a); else p0_wt_group(a, smem, u - 193);
    }
}

DI void phase1(const Args& a, char* smem) {
    float* WAB = (float*)smem;
    const int tid = tidx(), lane = tid & 63, wid = tid >> 6;
    for (int i = tid; i < 16384; i += 512) { const int k = i >> 4, j = i & 15; WAB[j * 1024 + k] = a.hy_w_in[(size_t)k * HYIN + 2816 + j]; }
    __syncthreads();
    const float* MOD = (const float*)(a.ws + OFF_MOD);
    bf16_t* H = (bf16_t*)(a.ws + OFF_H); float* AB = (float*)(a.ws + OFF_AB);
    f32x4 m1[4], m0[4]; int cur_cd = -1;
    const int rs = (int)gridDim.x * 8;
    f32x4 nv[4];
    { const int row0 = blockIdx.x * 8 + wid; if (row0 < MROWS) { const float* src0 = row0 < NLAT ? a.x + (size_t)row0 * DM : a.ctx + (size_t)(row0 - NLAT) * DM;
#pragma unroll
        for (int i = 0; i < 4; ++i) nv[i] = *(const f32x4*)(src0 + i * 256 + lane * 4); } }
    for (int row = blockIdx.x * 8 + wid; row < MROWS; row += rs) {
        const int cd = row < NLAT ? row / SEQL : 2;
        if (cd != cur_cd) { const float* sh = MOD + (size_t)cd * 6144, *scl = sh + 1024;
#pragma unroll
            for (int i = 0; i < 4; ++i) { const int k = i * 256 + lane * 4; const f32x4 g = *(const f32x4*)(a.pre_mix_g + k), s1 = *(const f32x4*)(sh + k), c1 = *(const f32x4*)(scl + k); m1[i] = g * (c1 + 1.f); m0[i] = s1; }
            cur_cd = cd; }
        f32x4 v[4]; float ss = 0.f;
#pragma unroll
        for (int i = 0; i < 4; ++i) { v[i] = nv[i]; ss += v[i][0] * v[i][0] + v[i][1] * v[i][1] + v[i][2] * v[i][2] + v[i][3] * v[i][3]; }
        { const int nrow = row + rs; if (nrow < MROWS) { const float* srcn = nrow < NLAT ? a.x + (size_t)nrow * DM : a.ctx + (size_t)(nrow - NLAT) * DM;
#pragma unroll
            for (int i = 0; i < 4; ++i) nv[i] = *(const f32x4*)(srcn + i * 256 + lane * 4); } }
        ss = wave_sum(ss); const float r = rsqrtf(ss * (1.f / 1024.f) + EPS);
#pragma unroll
        for (int i = 0; i < 4; ++i) { const int k = i * 256 + lane * 4;
#pragma unroll
            for (int e = 0; e < 4; ++e) v[i][e] = v[i][e] * r * m1[i][e] + m0[i][e];
            u32x2 w; w.x = pk2(v[i][0], v[i][1]); w.y = pk2(v[i][2], v[i][3]); *(u32x2*)(H + (size_t)row * DM + k) = w; }
        float p[16];
#pragma unroll
        for (int j = 0; j < 16; ++j) { float sj = 0.f;
#pragma unroll
            for (int i = 0; i < 4; ++i) { const f32x4 w = *(const f32x4*)(WAB + j * 1024 + i * 256 + lane * 4); sj += v[i][0] * w[0] + v[i][1] * w[1] + v[i][2] * w[2] + v[i][3] * w[3]; }
            p[j] = sj; __builtin_amdgcn_sched_barrier(0); }
        float q8[8], q4[4], q2[2], q1;
        { const bool hi = (lane & 32) != 0;
#pragma unroll
          for (int t = 0; t < 8; ++t) { const float snd = hi ? p[t] : p[t + 8], kp = hi ? p[t + 8] : p[t]; q8[t] = kp + __shfl_xor(snd, 32); } }
        { const bool hi = (lane & 16) != 0;
#pragma unroll
          for (int t = 0; t < 4; ++t) { const float snd = hi ? q8[t] : q8[t + 4], kp = hi ? q8[t + 4] : q8[t]; q4[t] = kp + __shfl_xor(snd, 16); } }
        { const bool hi = (lane & 8) != 0;
#pragma unroll
          for (int t = 0; t < 2; ++t) { const float snd = hi ? q4[t] : q4[t + 2], kp = hi ? q4[t + 2] : q4[t]; q2[t] = kp + __shfl_xor(snd, 8); } }
        { const bool hi = (lane & 4) != 0; const float snd = hi ? q2[0] : q2[1], kp = hi ? q2[1] : q2[0]; q1 = kp + __shfl_xor(snd, 4); }
        q1 += __shfl_xor(q1, 2); q1 += __shfl_xor(q1, 1);
        if ((lane & 3) == 0) AB[(size_t)row * 16 + (lane >> 2)] = q1;
    }
    __syncthreads();
}

DI void conv_rows(const Args& a) {
    const int lane = tidx() & 63, wid = tidx() >> 6;
    const bf16_t* P = (const bf16_t*)(a.ws + OFF_BIG);
    bf16_t* QN = (bf16_t*)(a.ws + OFF_QN); bf16_t* KN = (bf16_t*)(a.ws + OFF_KN); bf16_t* VN = (bf16_t*)(a.ws + OFF_VN);
    float w0[3][8], w1[3][8], w2[3][8];
#pragma unroll
    for (int part = 0; part < 3; ++part)
#pragma unroll
        for (int e = 0; e < 8; ++e) { const int ch = part * 512 + lane * 8 + e; w0[part][e] = a.gdn_conv_w[ch]; w1[part][e] = a.gdn_conv_w[1536 + ch]; w2[part][e] = a.gdn_conv_w[3072 + ch]; }
    const u32x4 zero4 = {0u, 0u, 0u, 0u};
    for (int blk = blockIdx.x * 8 + wid; blk < MROWS / 16; blk += gridDim.x * 8) {
        const int r0 = blk * 16;
        int t0, len; if (r0 < NLAT) { t0 = r0 & (SEQL - 1); len = SEQL; } else { t0 = (r0 - NLAT) & (CTXL - 1); len = CTXL; }
        u32x4 xp[3], xc[3], xn[3], xnn[3];
#pragma unroll
        for (int part = 0; part < 3; ++part) { const bf16_t* p = P + (size_t)r0 * PG_LD + part * 512 + lane * 8;
            xc[part] = *(const u32x4*)p; xp[part] = t0 > 0 ? *(const u32x4*)(p - PG_LD) : zero4; xn[part] = t0 + 1 < len ? *(const u32x4*)(p + PG_LD) : zero4; }
        for (int i = 0; i < 16; ++i) {
            const int row = r0 + i, t = t0 + i;
#pragma unroll
            for (int part = 0; part < 3; ++part) xnn[part] = (i < 15 && t + 2 < len) ? *(const u32x4*)(P + (size_t)(row + 2) * PG_LD + part * 512 + lane * 8) : zero4;
#pragma unroll
            for (int part = 0; part < 3; ++part) {
                float fc[8], fp[8], fn[8]; unpack8(xc[part], fc); unpack8(xp[part], fp); unpack8(xn[part], fn);
                float y[8]; float ss = 0.f;
#pragma unroll
                for (int e = 0; e < 8; ++e) { const float cv = w0[part][e] * fp[e] + w1[part][e] * fc[e] + w2[part][e] * fn[e]; y[e] = siluf(cv); ss += y[e] * y[e]; }
                if (part < 2) {
                    ss += __shfl_xor(ss, 1); ss += __shfl_xor(ss, 2); ss += __shfl_xor(ss, 4); ss += __shfl_xor(ss, 8);
                    const float r = rsqrtf(ss + EPS) * (part == 0 ? 0.08838834764831845f : 1.f);
#pragma unroll
                    for (int e = 0; e < 8; ++e) y[e] *= r;
                }
                bf16_t* dst = (part == 0 ? QN : part == 1 ? KN : VN) + (size_t)row * 512 + lane * 8;
                *(u32x4*)dst = pack8(y);
            }
#pragma unroll
            for (int part = 0; part < 3; ++part) { xp[part] = xc[part]; xc[part] = xn[part]; xn[part] = xnn[part]; }
        }
    }
}

constexpr int AT_QS = 0, AT_KS = 36864, AT_VT = AT_KS + 320 * 144, AT_VT_STRIDE = 656, AT_ROPE = AT_VT + 64 * 656;
static_assert(AT_ROPE + 32768 <= LDS_BYTES, "attention LDS map");
constexpr int N_ATT_UNITS = 1024;
DI int vt_pos(int i) { return (i & ~31) + ((i >> 2) & 3) * 8 + ((i >> 4) & 1) * 4 + (i & 3); }
DI void attn_load_kv(const Args& a, char* smem, const bf16_t* P, long grow0, int tpos0, int tlen, int nrows, int kvh, bool rope) {
    const int tid = tidx();
    const float2* R = (const float2*)(smem + AT_ROPE);
    u32x4 ka[3], kb[3], vv[5];
#pragma unroll
    for (int it = 0; it < 3; ++it) { const int idx = tid + it * 512, i = idx >> 2, q = idx & 3, t = tpos0 + i; const bool ok = idx < nrows * 4 && t >= 0 && t < tlen;
        ka[it] = (u32x4){0u, 0u, 0u, 0u}; kb[it] = (u32x4){0u, 0u, 0u, 0u};
        if (ok) { const bf16_t* p = P + (grow0 + i) * ATT_LD + 512 + kvh * 64 + q * 8; ka[it] = *(const u32x4*)p; kb[it] = *(const u32x4*)(p + 32); } }
#pragma unroll
    for (int it = 0; it < 5; ++it) { const int idx = tid + it * 512, q = idx / nrows, i = idx - q * nrows, t = tpos0 + i; const bool ok = idx < nrows * 8 && t >= 0 && t < tlen;
        vv[it] = (u32x4){0u, 0u, 0u, 0u};
        if (ok) vv[it] = *(const u32x4*)(P + (grow0 + i) * ATT_LD + 640 + kvh * 64 + q * 8); }
#pragma unroll
    for (int it = 0; it < 3; ++it) { const int idx = tid + it * 512, i = idx >> 2, q = idx & 3, t = tpos0 + i;
        if (idx < nrows * 4) {
            float x1[8], x2[8]; unpack8(ka[it], x1); unpack8(kb[it], x2);
            if (rope && t >= 0 && t < tlen) { const int pp = (q < 2) ? (t >> 6) : (t & 63); const float2* rp = R + pp * 16 + (q & 1) * 8;
#pragma unroll
                for (int e = 0; e < 8; ++e) { const float2 cs = rp[e]; const float o1 = x1[e] * cs.x - x2[e] * cs.y, o2 = x2[e] * cs.x + x1[e] * cs.y; x1[e] = o1; x2[e] = o2; } }
            *(u32x4*)(smem + AT_KS + i * 144 + q * 16) = pack8(x1);
            *(u32x4*)(smem + AT_KS + i * 144 + 64 + q * 16) = pack8(x2); } }
#pragma unroll
    for (int it = 0; it < 5; ++it) { const int idx = tid + it * 512, q = idx / nrows, i = idx - q * nrows;
        if (idx < nrows * 8) { const u32x4 v = vv[it];
            bf16_t* vt = (bf16_t*)(smem + AT_VT) + vt_pos(i); const int d0 = q * 8;
            vt[(d0 + 0) * 328] = (bf16_t)(v.x & 0xffff); vt[(d0 + 1) * 328] = (bf16_t)(v.x >> 16);
            vt[(d0 + 2) * 328] = (bf16_t)(v.y & 0xffff); vt[(d0 + 3) * 328] = (bf16_t)(v.y >> 16);
            vt[(d0 + 4) * 328] = (bf16_t)(v.z & 0xffff); vt[(d0 + 5) * 328] = (bf16_t)(v.z >> 16);
            vt[(d0 + 6) * 328] = (bf16_t)(v.w & 0xffff); vt[(d0 + 7) * 328] = (bf16_t)(v.w >> 16); } }
}
DI void attn_unit(const Args& a, char* smem, int u) {
    const int b = u >> 9, kvh = (u >> 8) & 1, qb = u & 255, q0 = qb * 64;
    const int tid = tidx(), lane = tid & 63, wid = tid >> 6, fr = lane & 15, fq = lane >> 4;
    const bf16_t* P = (const bf16_t*)((const unsigned char*)a.out + OUT_ATT);
    const float2* R = (const float2*)(smem + AT_ROPE);
    bf16_t* MIX = (bf16_t*)(a.ws + OFF_H);
    constexpr float QSCALE = 0.125f * 1.4426950408889634f;
#pragma unroll
    for (int it = 0; it < 2; ++it) { const int idx = tid + it * 512, hr = idx >> 2, q = idx & 3, g = hr >> 6, r = hr & 63; const int t = q0 + r;
      const bf16_t* p = P + ((size_t)b * SEQL + t) * ATT_LD + (kvh * 4 + g) * 64 + q * 8; float x1[8], x2[8];
      unpack8(*(const u32x4*)p, x1); unpack8(*(const u32x4*)(p + 32), x2);
      const int pp = (q < 2) ? (t >> 6) : (t & 63); const float2* rp = R + pp * 16 + (q & 1) * 8;
#pragma unroll
      for (int e = 0; e < 8; ++e) { const float2 cs = rp[e]; const float o1 = (x1[e] * cs.x - x2[e] * cs.y) * QSCALE, o2 = (x2[e] * cs.x + x1[e] * cs.y) * QSCALE; x1[e] = o1; x2[e] = o2; }
      *(u32x4*)(smem + AT_QS + hr * 144 + q * 16) = pack8(x1); *(u32x4*)(smem + AT_QS + hr * 144 + 64 + q * 16) = pack8(x2); }
    const int g = wid >> 1, qs = wid & 1, hq = kvh * 4 + g;
    const int qi0 = q0 + qs * 32 + fr;
    float m_run[2], l_run[2];
    m_run[0] = m_run[1] = a.attn_sink[hq] * 1.4426950408889634f; l_run[0] = l_run[1] = (fq == 0) ? 1.f : 0.f;
    f32x4 O[2][4];
#pragma unroll
    for (int j = 0; j < 2; ++j)
#pragma unroll
        for (int dt = 0; dt < 4; ++dt) O[j][dt] = (f32x4){0.f, 0.f, 0.f, 0.f};
    bf16x8 Qf[2][2];
#pragma unroll
    for (int pass = 0; pass < 2; ++pass) {
        if (pass == 0) attn_load_kv(a, smem, P, (long)b * SEQL + q0 - 128, q0 - 128, SEQL, 320, kvh, true);
        else attn_load_kv(a, smem, P, (long)NLAT + b * CTXL, 0, CTXL, 256, kvh, false);
        __syncthreads();
        if (pass == 0) {
#pragma unroll
            for (int j = 0; j < 2; ++j) { const char* qp = smem + AT_QS + (g * 64 + qs * 32 + j * 16 + fr) * 144 + fq * 16; Qf[j][0] = ldf16(qp); Qf[j][1] = ldf16(qp + 64); } }
        const int ngrp = pass == 0 ? 5 : 4;
#pragma unroll 1
        for (int kk = 0; kk < ngrp; ++kk) {
            f32x4 sc[2][4];
            { const char* kp = smem + AT_KS + (kk * 64 + fr) * 144 + fq * 16;
#pragma unroll
              for (int kt = 0; kt < 4; ++kt) { const bf16x8 k0 = ldf16(kp + kt * 16 * 144), k1 = ldf16(kp + kt * 16 * 144 + 64);
#pragma unroll
                  for (int j = 0; j < 2; ++j) { f32x4 z = {0.f, 0.f, 0.f, 0.f}; z = mfma16(k0, Qf[j][0], z); sc[j][kt] = mfma16(k1, Qf[j][1], z); } } }
            const int kbase = q0 - 128 + kk * 64;
            const bool need_mask = pass == 0 && (kk == 0 || kk == 4 || kbase < 0 || kbase + 64 > SEQL);
            if (need_mask) {
#pragma unroll
                for (int j = 0; j < 2; ++j) { const int qi = qi0 + j * 16;
#pragma unroll
                    for (int kt = 0; kt < 4; ++kt)
#pragma unroll
                        for (int r = 0; r < 4; ++r) { const int k = kbase + kt * 16 + fq * 4 + r; const bool v = k >= 0 && k < SEQL && (qi - k) <= 128 && (k - qi) <= 128; sc[j][kt][r] = v ? sc[j][kt][r] : -1e30f; } }
            }
            bf16x8 Pb[2][2];
#pragma unroll
            for (int j = 0; j < 2; ++j) {
                float mx = m_run[j];
#pragma unroll
                for (int kt = 0; kt < 4; ++kt) mx = fmaxf(fmaxf(mx, fmaxf(sc[j][kt][0], sc[j][kt][1])), fmaxf(sc[j][kt][2], sc[j][kt][3]));
                mx = fmaxf(mx, __shfl_xor(mx, 16)); mx = fmaxf(mx, __shfl_xor(mx, 32));
                const float alpha = __builtin_amdgcn_exp2f(m_run[j] - mx); m_run[j] = mx;
                float ps = 0.f;
#pragma unroll
                for (int kt = 0; kt < 4; ++kt)
#pragma unroll
                    for (int r = 0; r < 4; ++r) { const float pv = __builtin_amdgcn_exp2f(sc[j][kt][r] - mx); sc[j][kt][r] = pv; ps += pv; }
                l_run[j] = l_run[j] * alpha + ps;
                Pb[j][0] = pack2(sc[j][0], sc[j][1]); Pb[j][1] = pack2(sc[j][2], sc[j][3]);
#pragma unroll
                for (int dt = 0; dt < 4; ++dt) O[j][dt] = O[j][dt] * alpha;
            }
            { const char* vp = smem + AT_VT + fr * AT_VT_STRIDE + (kk * 64 + fq * 8) * 2;
#pragma unroll
              for (int dt = 0; dt < 4; ++dt)
#pragma unroll
                  for (int kp = 0; kp < 2; ++kp) { const bf16x8 vf = ldf16(vp + dt * 16 * AT_VT_STRIDE + kp * 64);
                      O[0][dt] = mfma16(vf, Pb[0][kp], O[0][dt]); O[1][dt] = mfma16(vf, Pb[1][kp], O[1][dt]); } }
        }
        __syncthreads();
    }
#pragma unroll
    for (int j = 0; j < 2; ++j) {
        float l = l_run[j]; l += __shfl_xor(l, 16); l += __shfl_xor(l, 32);
        const float inv = 1.f / l;
        bf16_t* op = MIX + ((size_t)b * SEQL + qi0 + j * 16) * DM + hq * 64 + fq * 4;
#pragma unroll
        for (int dt = 0; dt < 4; ++dt) { u32x2 w; w.x = pk2(O[j][dt][0] * inv, O[j][dt][1] * inv); w.y = pk2(O[j][dt][2] * inv, O[j][dt][3] * inv); *(u32x2*)(op + dt * 16) = w; }
    }
}
DI void phase3a(const Args& a, char* smem) { conv_rows(a); }

constexpr int PR_Q = 0, PR_K = 17408, PR_KT = 34816, PR_KB = 53248, PR_VT = 71680, PR_AS = 90112, PR_TS = 107520, PR_TB = 124928, PR_GC = 134144, PR_BETA = 134400;
DI float softplusf(float x) { return fmaxf(x, 0.f) + log1pf(expf(-fabsf(x))); }
struct PrepIn { u32x4 x[2][3], ed[2][3]; float av[2], bv[2]; };
constexpr int PR_GC2 = 153152, PR_BETA2 = 153664;
constexpr int PR_GP = 153088;
constexpr int PR_CW = 134656;
DI void prep_load(const Args& a, int p, PrepIn& in) {
    const int h = p & 3, cidx = p >> 2, base = cidx * 64;
    const int tid = tidx(), lane = tid & 63;
    const bf16_t* PG = (const bf16_t*)(a.ws + OFF_PG);
    const float* AB = (const float*)(a.ws + OFF_AB);
    int t0, len; if (base < NLAT) { t0 = base & (SEQL - 1); len = SEQL; } else { t0 = (base - NLAT) & (CTXL - 1); len = CTXL; }
    const u32x4 zero4 = {0u, 0u, 0u, 0u};
    const bool ev = (lane == 0 && t0 > 0) || (lane == 63 && t0 + 64 < len);
    const int etok = lane == 0 ? base - 1 : base + 64;
#pragma unroll
    for (int it = 0; it < 2; ++it) { const int q = (tid >> 6) + it * 8; const int tok = base + lane;
#pragma unroll
        for (int part = 0; part < 3; ++part) { const int col = part * 512 + h * 128 + q * 8;
            in.x[it][part] = *(const u32x4*)(PG + (size_t)tok * PG_LD + col);
            in.ed[it][part] = ev ? *(const u32x4*)(PG + (size_t)etok * PG_LD + col) : zero4; } }
#pragma unroll
    for (int d = 0; d < 2; ++d) { const int tok = d ? base + 63 - lane : base + lane; in.av[d] = AB[(size_t)tok * 16 + d * 4 + h]; in.bv[d] = AB[(size_t)tok * 16 + 8 + d * 4 + h]; }
}
DI u32x4 shfl4_up(u32x4 v) { u32x4 r; r.x = __shfl_up(v.x, 1); r.y = __shfl_up(v.y, 1); r.z = __shfl_up(v.z, 1); r.w = __shfl_up(v.w, 1); return r; }
DI u32x4 shfl4_dn(u32x4 v) { u32x4 r; r.x = __shfl_down(v.x, 1); r.y = __shfl_down(v.y, 1); r.z = __shfl_down(v.z, 1); r.w = __shfl_down(v.w, 1); return r; }
#define LDS_BARRIER() do { asm volatile("s_waitcnt lgkmcnt(0)" ::: "memory"); __builtin_amdgcn_s_barrier(); asm volatile("" ::: "memory"); } while (0)
DI void prep_pair(const Args& a, char* smem, int p, int dmask, const PrepIn& in) {
    const int h = p & 3, cidx = p >> 2;
    const int tid = tidx(), lane = tid & 63, wid = tid >> 6, fr = lane & 15, fq = lane >> 4;
    float* gcs = (float*)(smem + PR_GC2); float* betas = (float*)(smem + PR_BETA2);
    const float* CW = (const float*)(smem + PR_CW); float* SSP = (float*)(smem + PR_AS);
    u32x4 qvv[2], kvv[2], vvv[2];
    { float yv[2][3][8];
#pragma unroll
      for (int it = 0; it < 2; ++it) { const int idx = tid + it * 512, rr = idx & 63, q = idx >> 6;
#pragma unroll
        for (int part = 0; part < 3; ++part) { float fc[8], fp[8], fn[8];
            const u32x4 xc = in.x[it][part], up = shfl4_up(xc), dn = shfl4_dn(xc), ed = in.ed[it][part];
            unpack8(xc, fc); unpack8(lane == 0 ? ed : up, fp); unpack8(lane == 63 ? ed : dn, fn);
            const float* cw = CW + part * 512 + h * 128 + q * 8; float ss = 0.f;
#pragma unroll
            for (int e = 0; e < 8; ++e) { const float cv = cw[e] * fp[e] + cw[1536 + e] * fc[e] + cw[3072 + e] * fn[e]; const float y = siluf(cv); yv[it][part][e] = y; ss += y * y; }
            if (part < 2) SSP[(part * 64 + rr) * 16 + q] = ss; } }
      if (wid < 2 && ((dmask >> wid) & 1)) {
          const int d = wid; const float* GP = (const float*)(smem + PR_GP);
          const float av = d ? in.av[1] : in.av[0], bv = d ? in.bv[1] : in.bv[0];
          float gv = GP[d * 4 + h] * softplusf(av + GP[8 + d * 4 + h]);
#pragma unroll
          for (int o = 1; o < 64; o <<= 1) { const float t = __shfl_up(gv, o); if (lane >= o) gv += t; }
          gcs[d * 64 + lane] = gv; betas[d * 64 + lane] = 1.f / (1.f + expf(-bv));
          if (lane == 63) { int bb, st; if (cidx < 512) { bb = cidx >> 8; const int n = cidx & 255; st = 4 + (d ? 255 - n : n); } else { bb = (cidx - 512) >> 2; const int n = (cidx - 512) & 3; st = d ? 3 - n : n; }
              ((float*)(a.ws + OFF_EGL))[((bb * 4 + h) * 2 + d) * 260 + st] = expf(gv); }
      }
      LDS_BARRIER();
#pragma unroll
      for (int it = 0; it < 2; ++it) { const int rr = lane;
        float sq = 0.f, sk = 0.f;
#pragma unroll
        for (int j = 0; j < 16; ++j) { sq += SSP[rr * 16 + j]; sk += SSP[(64 + rr) * 16 + j]; }
        const float rq = rsqrtf(sq + EPS) * 0.08838834764831845f, rk = rsqrtf(sk + EPS);
#pragma unroll
        for (int e = 0; e < 8; ++e) { yv[it][0][e] *= rq; yv[it][1][e] *= rk; }
        qvv[it] = pack8(yv[it][0]); kvv[it] = pack8(yv[it][1]); vvv[it] = pack8(yv[it][2]); }
      LDS_BARRIER();
    }
#pragma unroll 1
  for (int dir = 0; dir < 2; ++dir) {
    if (!((dmask >> dir) & 1)) continue;
    int slot_;
    { int bb, st; if (cidx < 512) { bb = cidx >> 8; const int n = cidx & 255; st = 4 + (dir ? 255 - n : n); } else { bb = (cidx - 512) >> 2; const int n = (cidx - 512) & 3; st = dir ? 3 - n : n; }
      slot_ = ((bb * 4 + h) * 2 + dir) * 260 + st; }
    const int slot = slot_;
    unsigned char* rec = rec_ptr(a, slot);
    const float* gc = gcs + dir * 64; const float* beta = betas + dir * 64;
#pragma unroll
    for (int it = 0; it < 2; ++it) {
        const int idx = tid + it * 512, q = idx >> 6, rr = dir ? 63 - lane : lane;
        const u32x4 qv = qvv[it], kv = kvv[it], vv = vvv[it];
        *(u32x4*)(smem + PR_Q + rr * 272 + q * 16) = qv; *(u32x4*)(smem + PR_K + rr * 272 + q * 16) = kv;
        float kf[8], vf[8]; unpack8(kv, kf); unpack8(vv, vf);
        const float bt = beta[rr], be = bt * __expf(gc[rr]);
        bf16_t* kt = (bf16_t*)(smem + PR_KT) + (q * 8) * 72 + rr; bf16_t* kb = (bf16_t*)(smem + PR_KB) + (q * 8) * 72 + rr; bf16_t* vt = (bf16_t*)(smem + PR_VT) + (q * 8) * 72 + rr;
#pragma unroll
        for (int e = 0; e < 8; ++e) { kt[e * 72] = (bf16_t)f2bf(kf[e]); kb[e * 72] = (bf16_t)f2bf(kf[e] * be); vt[e * 72] = (bf16_t)f2bf(vf[e] * bt); }
    }
    LDS_BARRIER();
    float* As = (float*)(smem + PR_AS); float* Ts = (float*)(smem + PR_TS);
#pragma unroll
    for (int tt = 0; tt < 2; ++tt) {
        const int t = wid * 2 + tt, mt = t >> 2, nt = t & 3;
        f32x4 kk = {0.f, 0.f, 0.f, 0.f}, qk = {0.f, 0.f, 0.f, 0.f};
#pragma unroll
        for (int ks = 0; ks < 4; ++ks) {
            const bf16x8 am = ldf16(smem + PR_K + (mt * 16 + fr) * 272 + ks * 64 + fq * 16);
            const bf16x8 bk = ldf16(smem + PR_K + (nt * 16 + fr) * 272 + ks * 64 + fq * 16);
            const bf16x8 bq = ldf16(smem + PR_Q + (nt * 16 + fr) * 272 + ks * 64 + fq * 16);
            kk = mfma16(am, bk, kk); qk = mfma16(am, bq, qk);
        }
        const int i = nt * 16 + fr; const float gi = gc[i], bi = beta[i];
        f32x4 av; u32x2 qw; float qv[4];
#pragma unroll
        for (int j4 = 0; j4 < 4; ++j4) { const int j = mt * 16 + fq * 4 + j4; const float dg = gi - gc[j];
            const float edg = __expf(dg); av[j4] = (i > j) ? bi * kk[j4] * edg : 0.f; qv[j4] = (i >= j) ? qk[j4] * edg : 0.f; }
        *(f32x4*)(As + i * 68 + mt * 16 + fq * 4) = av;
        qw.x = pk2(qv[0], qv[1]); qw.y = pk2(qv[2], qv[3]);
        *(u32x2*)(rec + REC_QK + (i * 64 + (mt >> 1) * 32 + fq * 8 + (mt & 1) * 4) * 2) = qw;
    }
    LDS_BARRIER();
    if (wid == 0) {
        const int bI = lane >> 4, c = lane & 15; float x[16];
#pragma unroll
        for (int i = 0; i < 16; ++i) { float sacc = (i == c) ? 1.f : 0.f; const float* ar = As + (bI * 16 + i) * 68 + bI * 16;
#pragma unroll
            for (int j = 0; j < i; ++j) sacc -= ar[j] * x[j];
            x[i] = sacc; }
#pragma unroll
        for (int i = 0; i < 16; ++i) Ts[(bI * 16 + i) * 68 + bI * 16 + c] = x[i];
    }
    LDS_BARRIER();
    { float* scr = (float*)(smem + PR_TB) + wid * 16 * 17;
#pragma unroll
      for (int bI = 1; bI < 4; ++bI) {
          if (wid < bI) { const int bJ = wid; f32x4 racc = {0.f, 0.f, 0.f, 0.f};
              for (int bK = bJ; bK < bI; ++bK) {
#pragma unroll
                  for (int kk = 0; kk < 4; ++kk) { const float av = As[(bI * 16 + fr) * 68 + bK * 16 + kk * 4 + fq], bv = Ts[(bK * 16 + kk * 4 + fq) * 68 + bJ * 16 + fr];
                      racc = __builtin_amdgcn_mfma_f32_16x16x4f32(av, bv, racc, 0, 0, 0); } }
#pragma unroll
              for (int j = 0; j < 4; ++j) scr[(fq * 4 + j) * 17 + fr] = racc[j];
              asm volatile("s_waitcnt lgkmcnt(0)" ::: "memory"); __builtin_amdgcn_wave_barrier();
              f32x4 tacc = {0.f, 0.f, 0.f, 0.f};
#pragma unroll
              for (int kk = 0; kk < 4; ++kk) { const float av = Ts[(bI * 16 + fr) * 68 + bI * 16 + kk * 4 + fq], bv = scr[(kk * 4 + fq) * 17 + fr];
                  tacc = __builtin_amdgcn_mfma_f32_16x16x4f32(av, bv, tacc, 0, 0, 0); }
#pragma unroll
              for (int j = 0; j < 4; ++j) Ts[(bI * 16 + fq * 4 + j) * 68 + bJ * 16 + fr] = -tacc[j];
          }
          LDS_BARRIER();
      } }
    for (int idx = tid; idx < 2048; idx += 512) { const int i = idx >> 5, j2 = (idx & 31) * 2; const bool up = (j2 >> 4) > (i >> 4);
        *(unsigned*)(smem + PR_TB + i * 144 + j2 * 2) = up ? 0u : pk2(Ts[i * 68 + j2], Ts[i * 68 + j2 + 1]); }
    LDS_BARRIER();
#pragma unroll
    for (int tt = 0; tt < 4; ++tt) {
        const int t = wid * 4 + tt;
        { const int ct = t & 3, et = t >> 2; f32x4 acc = {0.f, 0.f, 0.f, 0.f};
#pragma unroll
          for (int ks = 0; ks < 2; ++ks) acc = mfma16(ldf16(smem + PR_TB + (ct * 16 + fr) * 144 + ks * 64 + fq * 16), ldf16(smem + PR_VT + (et * 16 + fr) * 144 + ks * 64 + fq * 16), acc);
          u32x2 w; w.x = pk2(acc[0], acc[1]); w.y = pk2(acc[2], acc[3]);
          *(u32x2*)(rec + REC_UT + ((et * 16 + fr) * 64 + ct * 16 + fq * 4) * 2) = w; }
        { const int ct = t & 3, dt = t >> 2; f32x4 acc = {0.f, 0.f, 0.f, 0.f};
#pragma unroll
          for (int ks = 0; ks < 2; ++ks) acc = mfma16(ldf16(smem + PR_KB + (dt * 16 + fr) * 144 + ks * 64 + fq * 16), ldf16(smem + PR_TB + (ct * 16 + fr) * 144 + ks * 64 + fq * 16), acc);
          u32x2 w; w.x = pk2(acc[0], acc[1]); w.y = pk2(acc[2], acc[3]);
          *(u32x2*)(rec + REC_W + ((ct * 16 + fr) * 128 + (dt >> 1) * 32 + fq * 8 + (dt & 1) * 4) * 2) = w; }
    }
    const float glast = gc[63];
    for (int idx = tid; idx < 1024; idx += 512) {
        { const int rr = idx >> 4, q = idx & 15; float f[8]; unpack8(*(const u32x4*)(smem + PR_Q + rr * 272 + q * 16), f); const float e = __expf(gc[rr]);
#pragma unroll
          for (int j = 0; j < 8; ++j) f[j] *= e;
          const int p0 = (q >> 2) * 32 + ((q >> 1) & 1) * 4; u32x2 w0, w1; w0.x = pk2(f[0], f[1]); w0.y = pk2(f[2], f[3]); w1.x = pk2(f[4], f[5]); w1.y = pk2(f[6], f[7]);
          *(u32x2*)(rec + REC_QG + (rr * 128 + p0 + ((2 * q) & 3) * 8) * 2) = w0; *(u32x2*)(rec + REC_QG + (rr * 128 + p0 + ((2 * q + 1) & 3) * 8) * 2) = w1; }
        { const int d = idx >> 3, q = idx & 7; float f[8]; unpack8(*(const u32x4*)(smem + PR_KT + d * 144 + q * 16), f);
#pragma unroll
          for (int j = 0; j < 8; ++j) f[j] *= __expf(glast - gc[q * 8 + j]);
          const int p0 = (q >> 2) * 32 + ((q >> 1) & 1) * 4; u32x2 w0, w1; w0.x = pk2(f[0], f[1]); w0.y = pk2(f[2], f[3]); w1.x = pk2(f[4], f[5]); w1.y = pk2(f[6], f[7]);
          *(u32x2*)(rec + REC_KTT + (d * 64 + p0 + ((2 * q) & 3) * 8) * 2) = w0; *(u32x2*)(rec + REC_KTT + (d * 64 + p0 + ((2 * q + 1) & 3) * 8) * 2) = w1; }
    }
    LDS_BARRIER();
  }
}
DI bool prep_item(int i, int G, int b, int& p, int& dmask) {
    constexpr int NPAIR = NREC / 2; const int nmain = NPAIR / G;
    if (i < nmain) { p = i * G + b; dmask = 3; return true; }
    const int u = (i - nmain) * G + b, left = NPAIR - nmain * G;
    if (u < 2 * left) { p = nmain * G + (u >> 1); dmask = 1 << (u & 1); return true; }
    return false;
}
DI void phase3b(const Args& a, char* smem) {
    const int G = (int)gridDim.x, b = (int)blockIdx.x;
    { float* CWs = (float*)(smem + PR_CW); for (int i = tidx(); i < 4608; i += 512) CWs[i] = a.gdn_conv_w[i];
      float* GPs = (float*)(smem + PR_GP); if (tidx() < 8) { GPs[tidx()] = -expf(a.gdn_a_log[tidx()]); GPs[8 + tidx()] = a.gdn_dt_bias[tidx()]; } }
    __syncthreads();
    PrepIn cur, nxt; int p, dm, pn, dmn;
    bool have = prep_item(0, G, b, p, dm);
    if (have) prep_load(a, p, cur);
    for (int i = 0; have; ++i) {
        const bool hn = prep_item(i + 1, G, b, pn, dmn);
        if (hn) prep_load(a, pn, nxt);
        prep_pair(a, smem, p, dm, cur);
        cur = nxt; p = pn; dm = dmn; have = hn;
    }
}

constexpr int SC_W = 0, SC_QG = 18432, SC_KTT = 36864, SC_QK = 57344, SC_UT = 67584, SC_EGL = 70144, SC_BUF = 70160, SC_NP = 3712, SC_OST = 2 * 70160;
DI int scan_rec(int b, int h, int dir, int step) { return ((b * 4 + h) * 2 + dir) * 260 + step; }
#define SC_BARRIER() do { asm volatile("s_waitcnt lgkmcnt(0)" ::: "memory"); __builtin_amdgcn_s_barrier(); asm volatile("" ::: "memory"); } while (0)
DI void scan_unit(const Args& a, char* smem, int u) {
    const int sl = u & 7, chain = u >> 3, dir = chain & 1, h = (chain >> 1) & 3, b = chain >> 3, e0 = sl * 16;
    const int tid = tidx(), lane = tid & 63, wid = __builtin_amdgcn_readfirstlane(tid >> 6), fr = lane & 15, fq = lane >> 4;
    const float* EGL = (const float*)(a.ws + OFF_EGL);
    bf16_t* Ob = (bf16_t*)(a.ws + OFF_O) + (size_t)dir * NLAT * 512;
    constexpr int NSTEP = 260;
    if (wid == 0) {
        f32x4 S[8];
#pragma unroll
        for (int i = 0; i < 8; ++i) S[i] = (f32x4){0.f, 0.f, 0.f, 0.f};
        for (int step = -1; step <= NSTEP; ++step) {
            if (step >= 0 && step < NSTEP) {
                const char* buf = smem + (step & 1) * SC_BUF;
                const float egl = *(const float*)(buf + SC_EGL);
                if (sl == 0 && lane == 0) __hip_atomic_store((unsigned*)(a.ws + OFF_PROG) + chain * 16, (unsigned)step, __ATOMIC_RELAXED, __HIP_MEMORY_SCOPE_AGENT);
                const char* pw = buf + SC_W + fr * 288 + fq * 16; const char* pq = buf + SC_QG + fr * 288 + fq * 16;
                const char* pk = buf + SC_QK + fr * 160 + fq * 16; const char* pt = buf + SC_KTT + fr * 160 + fq * 16;
                bf16x8 fa[8], fb[8];
#define LD_WQ(F, ct) do { _Pragma("unroll") for (int kk = 0; kk < 4; ++kk) { F[kk] = ldf16(pw + (ct) * 16 * 288 + kk * 64); F[4 + kk] = ldf16(pq + (ct) * 16 * 288 + kk * 64); } } while (0)
#define LD_QK(F) do { _Pragma("unroll") for (int ct = 0; ct < 4; ++ct) { F[2 * ct] = ldf16(pk + ct * 16 * 160); F[2 * ct + 1] = ldf16(pk + ct * 16 * 160 + 64); } } while (0)
#define LD_KT(F, d0) do { _Pragma("unroll") for (int dd = 0; dd < 4; ++dd) { F[2 * dd] = ldf16(pt + ((d0) + dd) * 16 * 160); F[2 * dd + 1] = ldf16(pt + ((d0) + dd) * 16 * 160 + 64); } } while (0)
#define MM_WQ(F, ct) do { f32x4 acc = {0.f, 0.f, 0.f, 0.f}, accq = {0.f, 0.f, 0.f, 0.f}; \
        _Pragma("unroll") for (int kk = 0; kk < 4; ++kk) { acc = mfma16(F[kk], Sb[kk], acc); accq = mfma16(F[4 + kk], Sb[kk], accq); } \
        vn[ct][0] = bflo(uu[ct].x) - acc[0]; vn[ct][1] = bfhi(uu[ct].x) - acc[1]; vn[ct][2] = bflo(uu[ct].y) - acc[2]; vn[ct][3] = bfhi(uu[ct].y) - acc[3]; oo[ct] = accq; } while (0)
                LD_WQ(fa, 0);
                u32x2 uu[4];
#pragma unroll
                for (int ct = 0; ct < 4; ++ct) uu[ct] = *(const u32x2*)(buf + SC_UT + fr * 160 + (ct * 16 + fq * 4) * 2);
                bf16x8 Sb[4];
#pragma unroll
                for (int kk = 0; kk < 4; ++kk) Sb[kk] = pack2(S[2 * kk], S[2 * kk + 1]);
                f32x4 vn[4], oo[4];
                LD_WQ(fb, 1); __builtin_amdgcn_sched_barrier(0);
                MM_WQ(fa, 0); __builtin_amdgcn_sched_barrier(0);
                LD_WQ(fa, 2); __builtin_amdgcn_sched_barrier(0);
                MM_WQ(fb, 1); __builtin_amdgcn_sched_barrier(0);
                LD_WQ(fb, 3); __builtin_amdgcn_sched_barrier(0);
                MM_WQ(fa, 2); __builtin_amdgcn_sched_barrier(0);
                LD_QK(fa); __builtin_amdgcn_sched_barrier(0);
                MM_WQ(fb, 3); __builtin_amdgcn_sched_barrier(0);
                LD_KT(fb, 0); __builtin_amdgcn_sched_barrier(0);
                bf16x8 Vb[2]; Vb[0] = pack2(vn[0], vn[1]); Vb[1] = pack2(vn[2], vn[3]);
#pragma unroll
                for (int ct = 0; ct < 4; ++ct) { oo[ct] = mfma16(fa[2 * ct], Vb[0], oo[ct]); oo[ct] = mfma16(fa[2 * ct + 1], Vb[1], oo[ct]); }
                __builtin_amdgcn_sched_barrier(0);
                LD_KT(fa, 4); __builtin_amdgcn_sched_barrier(0);
#pragma unroll
                for (int dd = 0; dd < 4; ++dd) { S[dd] = S[dd] * egl; S[dd] = mfma16(fb[2 * dd], Vb[0], S[dd]); S[dd] = mfma16(fb[2 * dd + 1], Vb[1], S[dd]); }
                __builtin_amdgcn_sched_barrier(0);
#pragma unroll
                for (int dd = 0; dd < 4; ++dd) { S[4 + dd] = S[4 + dd] * egl; S[4 + dd] = mfma16(fa[2 * dd], Vb[0], S[4 + dd]); S[4 + dd] = mfma16(fa[2 * dd + 1], Vb[1], S[4 + dd]); }
#undef LD_WQ
#undef LD_QK
#undef LD_KT
#undef MM_WQ
                if (step >= 4) { bf16_t* ost = (bf16_t*)(smem + SC_OST + (step & 1) * 2048);
#pragma unroll
                    for (int ct = 0; ct < 4; ++ct) { const unsigned w0 = pk2(oo[ct][0], oo[ct][1]), w1 = pk2(oo[ct][2], oo[ct][3]); const int c0 = ct * 16 + fq * 4;
                        ost[(c0 + 0) * 16 + fr] = (bf16_t)(w0 & 0xffff); ost[(c0 + 1) * 16 + fr] = (bf16_t)(w0 >> 16); ost[(c0 + 2) * 16 + fr] = (bf16_t)(w1 & 0xffff); ost[(c0 + 3) * 16 + fr] = (bf16_t)(w1 >> 16); }
                }
            }
            SC_BARRIER();
        }
    } else {
        u32x4 tA[9], tB[9], tC[9]; float eA = 0.f, eB = 0.f, eC = 0.f;
#define SC_LOAD(T, E, st) do { const int rn_ = scan_rec(b, h, dir, (st)); const unsigned char* rec_ = rec_ptr(a, rn_); \
        _Pragma("unroll") for (int it = 0; it < 9; ++it) { const int p = tid - 64 + it * 448; \
            if (p < SC_NP) { const unsigned char* src = p < 3584 ? rec_ + p * 16 : rec_ + REC_UT + e0 * 128 + (p - 3584) * 16; T[it] = *(const u32x4*)src; } } \
        if (tid == 64) E = EGL[rn_]; } while (0)
#define SC_WRITE(T, E, st) do { char* buf_ = smem + ((st) & 1) * SC_BUF; if (tid == 64) *(float*)(buf_ + SC_EGL) = E; \
        _Pragma("unroll") for (int it = 0; it < 9; ++it) { const int p = tid - 64 + it * 448; \
            if (p < SC_NP) { int off; \
                if (p < 2048) off = (p >> 10) * 18432 + ((p & 1023) >> 4) * 288 + (p & 15) * 16; \
                else if (p < 3584) { const int q = p - 2048; off = SC_KTT + (q >> 3) * 160 + (q & 7) * 16; } \
                else { const int q = p - 3584; off = SC_UT + (q >> 3) * 160 + (q & 7) * 16; } \
                *(u32x4*)(buf_ + off) = T[it]; } } } while (0)
#define SC_ITER(T, E, st) do { if ((st) <= NSTEP) { \
        if ((st) + 1 < NSTEP) SC_WRITE(T, E, (st) + 1); \
        if ((st) - 1 >= 4 && (st) - 1 < NSTEP && tid < 192) { const int ps = (st) - 1, n = ps - 4, chunk = dir ? 255 - n : n; const int q = tid - 64, c = q >> 1, hf = q & 1; \
            const size_t tok = (size_t)b * SEQL + chunk * 64 + (dir ? 63 - c : c); \
            *(u32x4*)(Ob + tok * 512 + h * 128 + e0 + hf * 8) = *(const u32x4*)(smem + SC_OST + (ps & 1) * 2048 + c * 32 + hf * 16); } \
        if ((st) + 4 < NSTEP) SC_LOAD(T, E, (st) + 4); \
        SC_BARRIER(); } } while (0)
        SC_LOAD(tA, eA, 0); SC_LOAD(tB, eB, 1); SC_LOAD(tC, eC, 2);
        for (int st = -1; st <= NSTEP; st += 3) { SC_ITER(tA, eA, st); SC_ITER(tB, eB, st + 1); SC_ITER(tC, eC, st + 2); }
#undef SC_ITER
#undef SC_WRITE
#undef SC_LOAD
    }
}
constexpr int SC_LEAD = 12;
DI void scan_prefetch(const Args& a, int chain, int phase_, int nph) {
    const int tid = tidx(); unsigned acc = 0u;
    unsigned* prog = (unsigned*)(a.ws + OFF_PROG) + chain * 16; int budget = 8192;
    for (int step = phase_; step < 260; step += nph) {
        while (budget > 0 && (int)__hip_atomic_load(prog, __ATOMIC_RELAXED, __HIP_MEMORY_SCOPE_AGENT) + SC_LEAD < step) { __builtin_amdgcn_s_sleep(8); --budget; }
        const unsigned char* rec = rec_ptr(a, chain * 260 + step);
        u32x4 v[9];
#pragma unroll
        for (int it = 0; it < 9; ++it) v[it] = *(const u32x4*)(rec + (size_t)(tid + it * 512) * 16);
#pragma unroll
        for (int it = 0; it < 9; ++it) acc ^= v[it].x ^ v[it].y ^ v[it].z ^ v[it].w;
    }
    if (acc == 0x9e3779b9u) ((unsigned*)(a.ws))[tid] = acc;
}
DI void phase4(const Args& a, char* smem) {
    const int G = (int)gridDim.x, NS = G >= 256 ? 128 : (G >= 2 ? G / 2 : 0), NPF = G >= 256 ? 32 : 0;
    if (NS == 0) { for (int u = 0; u < 128; ++u) scan_unit(a, smem, u);
        { const u32x4* src = (const u32x4*)(a.ws + OFF_ROPE); u32x4* dst = (u32x4*)(smem + AT_ROPE); for (int i = tidx(); i < 2048; i += 512) dst[i] = src[i]; } __syncthreads();
        for (int u = 0; u < N_ATT_UNITS; ++u) attn_unit(a, smem, u);
        __syncthreads(); for (int g = P0_WT_EARLY; g < P0_WT_GROUPS; ++g) p0_wt_group(a, smem, g); return; }
    if ((int)blockIdx.x < NS) {
        if (NS == 128) { const int blk = (int)blockIdx.x, xcd = blk & 7, j = blk >> 3; scan_unit(a, smem, ((xcd * 2 + (j >> 3)) << 3) | (j & 7)); }
        else for (int u = blockIdx.x; u < 128; u += NS) scan_unit(a, smem, u); }
    else if ((int)blockIdx.x < NS + NPF) { const int p = (int)blockIdx.x - NS, xcd = p & 7, j = p >> 3;
        scan_prefetch(a, xcd * 2 + (j & 1), j >> 1, 2); }
    else { const int NA = G - NS - NPF, ab = (int)blockIdx.x - NS - NPF;
        { const u32x4* src = (const u32x4*)(a.ws + OFF_ROPE); u32x4* dst = (u32x4*)(smem + AT_ROPE); for (int i = tidx(); i < 2048; i += 512) dst[i] = src[i]; }
        __syncthreads();
        for (int u = ab; u < N_ATT_UNITS; u += NA) attn_unit(a, smem, u);
        __syncthreads(); for (int g = P0_WT_EARLY + ab; g < P0_WT_GROUPS; g += NA) p0_wt_group(a, smem, g); }
}

DI void phase5(const Args& a) {
    const int lane = tidx() & 63, wid = tidx() >> 6;
    const bf16_t* Of = (const bf16_t*)(a.ws + OFF_O); const bf16_t* Obk = Of + (size_t)NLAT * 512; const bf16_t* Z = (const bf16_t*)(a.ws + OFF_Z);
    bf16_t* MIX = (bf16_t*)(a.ws + OFF_H);
    float ng[8];
#pragma unroll
    for (int e = 0; e < 8; ++e) ng[e] = a.gdn_norm_g[(lane & 15) * 8 + e];
    const int rs = (int)gridDim.x * 8;
    u32x4 nf, nb, nz;
    { const int row0 = blockIdx.x * 8 + wid; if (row0 < NLAT) { nf = *(const u32x4*)(Of + (size_t)row0 * 512 + lane * 8); nb = *(const u32x4*)(Obk + (size_t)row0 * 512 + lane * 8); nz = *(const u32x4*)(Z + (size_t)row0 * 512 + lane * 8); } }
    for (int row = blockIdx.x * 8 + wid; row < NLAT; row += rs) {
        float of[8], ob[8], z[8];
        unpack8(nf, of); unpack8(nb, ob); unpack8(nz, z);
        { const int nrow = row + rs; if (nrow < NLAT) { nf = *(const u32x4*)(Of + (size_t)nrow * 512 + lane * 8); nb = *(const u32x4*)(Obk + (size_t)nrow * 512 + lane * 8); nz = *(const u32x4*)(Z + (size_t)nrow * 512 + lane * 8); } }
        float ss = 0.f;
#pragma unroll
        for (int e = 0; e < 8; ++e) { of[e] += ob[e]; ss += of[e] * of[e]; }
        ss += __shfl_xor(ss, 1); ss += __shfl_xor(ss, 2); ss += __shfl_xor(ss, 4); ss += __shfl_xor(ss, 8);
        const float r = rsqrtf(ss * (1.f / 128.f) + EPS);
#pragma unroll
        for (int e = 0; e < 8; ++e) of[e] = of[e] * r * ng[e] * siluf(z[e]);
        *(u32x4*)(MIX + (size_t)row * DM + 512 + lane * 8) = pack8(of);
    }
}

template <bool IN_F32, bool OUT_F32> DI void rowpass(const Args& a, const void* xin_v, void* xout_v, const float* gate_base, int gate_bstride, const float* post_g,
                const float* next_g, const float* nsh_base, const float* nsc_base, int n_bstride, bool has_next) {
    const int lane = tidx() & 63, wid = tidx() >> 6;
    const bf16_t* Y = (const bf16_t*)(a.ws + OFF_Y); const float* SSQ = (const float*)(a.ws + OFF_SSQ); bf16_t* H = (bf16_t*)(a.ws + OFF_H);
    const int rs = (int)gridDim.x * 8;
    const float* xin = (const float*)xin_v; const bf16_t* xin16 = (const bf16_t*)xin_v; float* xout = (float*)xout_v; bf16_t* xout16 = (bf16_t*)xout_v;
    f32x4 xA[4], xB[4], xC[4]; u32x2 bA[4], bB[4], bC[4], yA[4], yB[4], yC[4]; float sA = 0.f, sB = 0.f, sC = 0.f;
#define RP_LOAD(XF, XB, Yv, S, r) do { _Pragma("unroll") for (int i = 0; i < 4; ++i) { const int k = i * 256 + lane * 4; \
        if constexpr (IN_F32) XF[i] = *(const f32x4*)(xin + (size_t)(r) * DM + k); else XB[i] = *(const u32x2*)(xin16 + (size_t)(r) * DM + k); \
        Yv[i] = *(const u32x2*)(Y + (size_t)(r) * DM + k); } \
        S = lane < 16 ? SSQ[(size_t)(r) * 16 + lane] : 0.f; } while (0)
    f32x4 gp[4], n1[4], n0[4]; int cur_b = -1;
#define RP_PARAMS(b) do { const float* gate = gate_base + (size_t)(b) * gate_bstride; \
        _Pragma("unroll") for (int i = 0; i < 4; ++i) { const int k = i * 256 + lane * 4; const f32x4 gv = *(const f32x4*)(gate + k), pg = *(const f32x4*)(post_g + k); gp[i] = gv * pg; \
            if (has_next) { const f32x4 g = *(const f32x4*)(next_g + k), s1 = *(const f32x4*)(nsh_base + (size_t)(b) * n_bstride + k), c1 = *(const f32x4*)(nsc_base + (size_t)(b) * n_bstride + k); \
                n1[i] = g * (c1 + 1.f); n0[i] = s1; } } } while (0)
#define RP_COMP(XF, XB, Yv, S, row) do { \
        const int b = (row) / SEQL; if (b != cur_b) { RP_PARAMS(b); cur_b = b; } \
        const float ry = rsqrtf(wave_sum(S) * (1.f / 1024.f) + EPS); \
        f32x4 v[4]; float ss = 0.f; \
        _Pragma("unroll") for (int i = 0; i < 4; ++i) { const int k = i * 256 + lane * 4; \
            const f32x4 yv = {bflo(Yv[i].x), bfhi(Yv[i].x), bflo(Yv[i].y), bfhi(Yv[i].y)}; \
            f32x4 xv; if constexpr (IN_F32) xv = XF[i]; else xv = (f32x4){bflo(XB[i].x), bfhi(XB[i].x), bflo(XB[i].y), bfhi(XB[i].y)}; \
            _Pragma("unroll") for (int e = 0; e < 4; ++e) { v[i][e] = xv[e] + gp[i][e] * (yv[e] * ry); ss += v[i][e] * v[i][e]; } \
            if constexpr (OUT_F32) *(f32x4*)(xout + (size_t)(row) * DM + k) = v[i]; else { u32x2 xw; xw.x = pk2(v[i][0], v[i][1]); xw.y = pk2(v[i][2], v[i][3]); *(u32x2*)(xout16 + (size_t)(row) * DM + k) = xw; } } \
        if (has_next) { \
            ss = wave_sum(ss); const float r = rsqrtf(ss * (1.f / 1024.f) + EPS); \
            _Pragma("unroll") for (int i = 0; i < 4; ++i) { const int k = i * 256 + lane * 4; float o[4]; \
                _Pragma("unroll") for (int e = 0; e < 4; ++e) o[e] = v[i][e] * r * n1[i][e] + n0[i][e]; \
                u32x2 w; w.x = pk2(o[0], o[1]); w.y = pk2(o[2], o[3]); *(u32x2*)(H + (size_t)(row) * DM + k) = w; } } } while (0)
    const int r0 = blockIdx.x * 8 + wid;
    if (r0 < NLAT) RP_LOAD(xA, bA, yA, sA, r0);
    if (r0 + rs < NLAT) RP_LOAD(xB, bB, yB, sB, r0 + rs);
    if (r0 + 2 * rs < NLAT) RP_LOAD(xC, bC, yC, sC, r0 + 2 * rs);
    for (int row = r0; row < NLAT; row += 3 * rs) {
        RP_COMP(xA, bA, yA, sA, row); if (row + 3 * rs < NLAT) RP_LOAD(xA, bA, yA, sA, row + 3 * rs);
        if (row + rs < NLAT) { RP_COMP(xB, bB, yB, sB, row + rs); if (row + 4 * rs < NLAT) RP_LOAD(xB, bB, yB, sB, row + 4 * rs); }
        if (row + 2 * rs < NLAT) { RP_COMP(xC, bC, yC, sC, row + 2 * rs); if (row + 5 * rs < NLAT) RP_LOAD(xC, bC, yC, sC, row + 5 * rs); }
    }
#undef RP_LOAD
#undef RP_COMP
#undef RP_PARAMS
}

DI void phase12(const Args& a) {
    const int lane = tidx() & 63, wid = tidx() >> 6;
    const bf16_t* CU = (const bf16_t*)(a.ws + OFF_BIG); const bf16_t* BG = CU + (size_t)NLAT * DM; bf16_t* MIX = (bf16_t*)(a.ws + OFF_H);
    float w0[2][8], w1[2][8], w2[2][8];
#pragma unroll
    for (int part = 0; part < 2; ++part)
#pragma unroll
        for (int e = 0; e < 8; ++e) { const int ch = part * 512 + lane * 8 + e; w0[part][e] = a.sc_conv_w[ch]; w1[part][e] = a.sc_conv_w[1024 + ch]; w2[part][e] = a.sc_conv_w[2048 + ch]; }
    const u32x4 zero4 = {0u, 0u, 0u, 0u};
    for (int blk = blockIdx.x * 8 + wid; blk < NLAT / 16; blk += gridDim.x * 8) {
        const int r0 = blk * 16, t0 = r0 & (SEQL - 1);
        u32x4 xp[2], xc[2], xn[2], xnn[2], bg[2], bgn[2], bgnn[2];
#pragma unroll
        for (int part = 0; part < 2; ++part) { const bf16_t* p = CU + (size_t)r0 * DM + part * 512 + lane * 8; const bf16_t* pb = BG + (size_t)r0 * DM + part * 512 + lane * 8;
            xc[part] = *(const u32x4*)p; xp[part] = t0 > 0 ? *(const u32x4*)(p - DM) : zero4; xn[part] = t0 + 1 < SEQL ? *(const u32x4*)(p + DM) : zero4;
            bg[part] = *(const u32x4*)pb; bgn[part] = *(const u32x4*)(pb + DM); }
        for (int i = 0; i < 16; ++i) {
            const int row = r0 + i, t = t0 + i;
#pragma unroll
            for (int part = 0; part < 2; ++part) { xnn[part] = (i < 15 && t + 2 < SEQL) ? *(const u32x4*)(CU + (size_t)(row + 2) * DM + part * 512 + lane * 8) : zero4;
                bgnn[part] = i < 14 ? *(const u32x4*)(BG + (size_t)(row + 2) * DM + part * 512 + lane * 8) : zero4; }
#pragma unroll
            for (int part = 0; part < 2; ++part) {
                float fc[8], fp[8], fn[8], fb[8], o[8]; unpack8(xc[part], fc); unpack8(xp[part], fp); unpack8(xn[part], fn); unpack8(bg[part], fb);
#pragma unroll
                for (int e = 0; e < 8; ++e) o[e] = fb[e] * (w0[part][e] * fp[e] + w1[part][e] * fc[e] + w2[part][e] * fn[e]);
                *(u32x4*)(MIX + (size_t)row * DM + part * 512 + lane * 8) = pack8(o);
            }
#pragma unroll
            for (int part = 0; part < 2; ++part) { xp[part] = xc[part]; xc[part] = xn[part]; xn[part] = xnn[part]; bg[part] = bgn[part]; bgn[part] = bgnn[part]; }
        }
    }
}

#ifndef ONLY_PH
#define ONLY_PH -1
#endif
#define PHASE_ON(n) ((ONLY_PH) < 0 || (ONLY_PH) == (n))
constexpr int N_PHASES = 18;
__global__ void __launch_bounds__(512, 2) fwd_megakernel(Args a) {
    extern __shared__ __attribute__((aligned(16))) char smem[];
    cg::grid_group grid = cg::this_grid();
    const float* MOD = (const float*)(a.ws + OFF_MOD);
    const bf16_t* WT = (const bf16_t*)(a.ws + OFF_WT);
    bf16_t* H = (bf16_t*)(a.ws + OFF_H);
    bf16_t* BIG = (bf16_t*)(a.ws + OFF_BIG);
    bf16_t* Y = (bf16_t*)(a.ws + OFF_Y); float* SSQ = (float*)(a.ws + OFF_SSQ);
    const int lo = a.ph_lo, hi = a.ph_hi;
#define IN(k) (PHASE_ON(k) && lo <= (k) && (k) < hi)
#define SEAM(k) do { if (lo <= (k) && (k) + 1 < hi) grid.sync(); } while (0)
#ifndef DBL
#define DBL 0u
#endif
#ifndef XSYNC
#define XSYNC 0
#endif
#define PH(k, ...) do { if (IN(k)) { __VA_ARGS__; if (((DBL) >> (k)) & 1u) { grid.sync(); __VA_ARGS__; } } SEAM(k); } while (0)
    PH(0, phase0(a, smem););
    PH(1, phase1(a, smem););
    PH(2, { EpiProj E; E.AT = (bf16_t*)((unsigned char*)a.out + OUT_ATT); E.P = (bf16_t*)(a.ws + OFF_PG); E.Z = (bf16_t*)(a.ws + OFF_Z); run_gemm(smem, H, WT + WT_IN, MROWS, NPROJ, 1024, E); });
    PH(4, phase3b(a, smem););
    PH(5, phase4(a, smem););
    PH(6, phase5(a););
    PH(7, { EpiY E; E.Y = Y; E.SSQ = SSQ; run_gemm(smem, H, WT + WT_OUT, NLAT, 1024, 1024, E); });
    PH(8, rowpass<true, false>(a, a.x, a.ws + OFF_X16, MOD + 2 * 1024, 6144, a.post_mix_g, a.pre_ffn_g, MOD + 3 * 1024, MOD + 4 * 1024, 6144, true););
    PH(9, { EpiAct E; E.O = BIG; run_gemm(smem, H, WT + WT_GU0, NLAT, 5632, 1024, E); });
    PH(10, { EpiY E; E.Y = Y; E.SSQ = SSQ; run_gemm(smem, BIG, WT + WT_DN0, NLAT, 1024, FF, E); });
    PH(11, rowpass<false, false>(a, a.ws + OFF_X16, a.ws + OFF_X16, MOD + 5 * 1024, 6144, a.post_ffn_g, a.pre_mix_g + 1024, MOD + 3 * 6144 + 0 * 1024, MOD + 3 * 6144 + 1 * 1024, 6144, true););
    PH(12, { EpiSc E; E.CU = BIG; E.BG = BIG + (size_t)NLAT * DM; run_gemm(smem, H, WT + WT_SCIN, NLAT, 3072, 1024, E); });
    PH(13, phase12(a););
    PH(14, { EpiY E; E.Y = Y; E.SSQ = SSQ; run_gemm(smem, H, WT + WT_SCOUT, NLAT, 1024, 1024, E); });
    PH(15, rowpass<false, false>(a, a.ws + OFF_X16, a.ws + OFF_X16, MOD + 3 * 6144 + 2 * 1024, 6144, a.post_mix_g + 1024, a.pre_ffn_g + 1024, MOD + 3 * 6144 + 3 * 1024, MOD + 3 * 6144 + 4 * 1024, 6144, true););
    PH(16, { EpiAct E; E.O = BIG; run_gemm(smem, H, WT + WT_GU1, NLAT, 5632, 1024, E); });
    PH(17, { EpiY E; E.Y = Y; E.SSQ = SSQ; run_gemm(smem, BIG, WT + WT_DN1, NLAT, 1024, FF, E); });
    PH(18, rowpass<false, true>(a, a.ws + OFF_X16, a.out, MOD + 3 * 6144 + 5 * 1024, 6144, a.post_ffn_g + 1024, nullptr, nullptr, nullptr, 0, false););
}

extern "C" void kernel_launch(void* const* d_in, const int* in_sizes, int n_in, void* d_out, int out_size, void* d_ws, size_t ws_size, hipStream_t stream) {
    static int grid = 0;
    if (grid == 0) {
        if (n_in != 23 || ws_size < WS_NEED) { fprintf(stderr, "kernel_launch: unexpected n_in %d / ws %zu\n", n_in, ws_size); grid = -1; return; }
        int dev = 0, cus = 0, per_cu = 0;
        hipGetDevice(&dev); hipDeviceGetAttribute(&cus, hipDeviceAttributeMultiprocessorCount, dev);
        hipFuncSetAttribute((const void*)fwd_megakernel, hipFuncAttributeMaxDynamicSharedMemorySize, LDS_BYTES);
        hipOccupancyMaxActiveBlocksPerMultiprocessor(&per_cu, (const void*)fwd_megakernel, 512, LDS_BYTES);
        if (per_cu < 1) { fprintf(stderr, "kernel_launch: occupancy query says %d blocks/CU\n", per_cu); per_cu = 1; }
        grid = cus * 1;
        (void)hipGetLastError();
    }
    if (grid < 0) return;
    Args a{};
    const float** f = (const float**)&a;
    for (int i = 0; i < 23; ++i) f[i] = (const float*)d_in[i];
    a.out = (float*)d_out; a.ws = (unsigned char*)d_ws; a.ph_lo = 0; a.ph_hi = N_PHASES + 1;
    void* args[] = {&a};
    hipError_t e = hipLaunchCooperativeKernel((const void*)fwd_megakernel, dim3(grid), dim3(512), args, LDS_BYTES, stream);
    if (e != hipSuccess) fprintf(stderr, "cooperative launch failed: %s (grid %d)\n", hipGetErrorString(e), grid);
}
```
